# Optimizing an MI355X kernel written in HIP

```python
import jax, jax.numpy as jnp
from jax import lax
import numpy as np

D_MODEL = 1024
BATCH = 8
SEQ = 4096
DEPTH = 2

GRID_W = 64
CTX_LEN = 256
N_EVEN = (DEPTH + 1) // 2
N_ODD = DEPTH // 2
EPS = 1e-6
A_CH = D_MODEL // 2
CONV_K = 31
B_CH = D_MODEL // 2
B_HEADS = 8
B_HD = B_CH // B_HEADS
CHUNK = 128
IN_E = 2 * A_CH + 2 * B_CH
QK_NOPE = 128
QK_ROPE = 64
V_HD = 128
MLA_HEADS = D_MODEL // V_HD
Q_RANK = 384
KV_RANK = 256
IN_O = Q_RANK + KV_RANK + QK_ROPE
ROPE_AXIS = QK_ROPE // 2
ROPE_FREQS = ROPE_AXIS // 2
ROPE_BASE = 10000.0
Q_BLOCK = 128
ATTN_SCALE = (QK_NOPE + QK_ROPE) ** -0.5
D_FF = 2816
N_EXPERTS = 8
TOP_K = 2
D_EXPERT = 3584

kernel_name = 'hybrid_conv_gmlp_mla_moe_dit'


def _rmsnorm(x, g):
    xf = x.astype(jnp.float32)
    y = xf * lax.rsqrt(jnp.mean(xf * xf, axis=-1, keepdims=True) + EPS)
    return (y * g.astype(jnp.float32)).astype(x.dtype)


def _layernorm(x, g, b):
    xf = x.astype(jnp.float32)
    mu = jnp.mean(xf, axis=-1, keepdims=True)
    var = jnp.mean(jnp.square(xf - mu), axis=-1, keepdims=True)
    y = (xf - mu) * lax.rsqrt(var + EPS)
    return (y * g.astype(jnp.float32) + b.astype(jnp.float32)).astype(x.dtype)


def _modulate(h, shift, scale):
    return h * (1 + scale[:, None, :]) + shift[:, None, :]


def _swiglu(h, w1, w3, w2):
    return (jax.nn.silu(h @ w1) * (h @ w3)) @ w2


def _rope2d(x, cos, sin):
    xs = x.reshape(*x.shape[:-1], 2, 2, ROPE_FREQS)
    x1, x2 = xs[..., 0, :], xs[..., 1, :]
    c = cos[None, :, None].astype(x.dtype)
    s = sin[None, :, None].astype(x.dtype)
    out = jnp.stack([x1 * c - x2 * s, x1 * s + x2 * c], axis=-2)
    return out.reshape(x.shape)


def _conv_gmlp_mixer(h, w_in, conv_w, conv_b, ln_a_g, ln_a_b, ln_v_g, ln_v_b, w_s, b_s, w_out):
    b, t, _ = h.shape
    z = h @ w_in
    a_val, a_gate, u, v = jnp.split(z, 4, axis=-1)
    a = a_val * jax.nn.sigmoid(a_gate)
    a = lax.conv_general_dilated(
        a, conv_w.reshape(CONV_K, 1, A_CH).astype(a.dtype), window_strides=(1,),
        padding=[(CONV_K // 2, CONV_K // 2)], dimension_numbers=('NWC', 'WIO', 'NWC'),
        feature_group_count=A_CH) + conv_b
    a = jax.nn.silu(_layernorm(a, ln_a_g, ln_a_b))
    u = jax.nn.gelu(u)
    v = _layernorm(jax.nn.gelu(v), ln_v_g, ln_v_b).reshape(b, t // CHUNK, CHUNK, B_HEADS, B_HD)
    sv = jnp.einsum('hij,bnjhd->bnihd', w_s, v) + b_s.T[None, None, :, :, None]
    bo = u * sv.reshape(b, t, B_CH)
    return jnp.concatenate([a, bo], axis=-1) @ w_out


def _mla_q(q_lat, g_q, w_uq, rope):
    b, t, _ = q_lat.shape
    q = (_rmsnorm(q_lat, g_q) @ w_uq).reshape(b, t, MLA_HEADS, QK_NOPE + QK_ROPE)
    if rope is not None:
        q = jnp.concatenate([q[..., :QK_NOPE], _rope2d(q[..., QK_NOPE:], *rope)], axis=-1)
    return q


def _mla_kv(kv_lat, k_pe, g_kv, w_ukv, rope):
    b, t, _ = kv_lat.shape
    kv = (_rmsnorm(kv_lat, g_kv) @ w_ukv).reshape(b, t, MLA_HEADS, QK_NOPE + V_HD)
    k_pe = k_pe[:, :, None, :]
    if rope is not None:
        k_pe = _rope2d(k_pe, *rope)
    k = jnp.concatenate([kv[..., :QK_NOPE], jnp.broadcast_to(k_pe, (b, t, MLA_HEADS, QK_ROPE))], axis=-1)
    return k, kv[..., QK_NOPE:]


def _attend(q, k, v):
    b, tq, h, dq = q.shape
    nb = tq // Q_BLOCK
    qb = jnp.moveaxis(q.reshape(b, nb, Q_BLOCK, h, dq), 1, 0)

    def block(qblk):
        s = jnp.einsum('bqhd,bkhd->bhqk', qblk, k).astype(jnp.float32) * ATTN_SCALE
        p = jax.nn.softmax(s, axis=-1).astype(v.dtype)
        return jnp.einsum('bhqk,bkhd->bqhd', p, v)

    o = lax.map(block, qb)
    return jnp.moveaxis(o, 0, 1).reshape(b, tq, h * v.shape[-1])


def _moe(h, router, w1, w3, w2):
    b, t, d = h.shape
    hf = h.reshape(b * t, d)
    logits = (hf @ router).astype(jnp.float32)
    top_v, top_i = lax.top_k(logits, TOP_K)
    top_w = jax.nn.softmax(top_v, axis=-1)
    gates = jnp.sum(jax.nn.one_hot(top_i, N_EXPERTS, dtype=jnp.float32) * top_w[..., None], axis=-2).astype(h.dtype)
    y = jnp.zeros_like(hf)
    for e in range(N_EXPERTS):
        y = y + gates[:, e:e + 1] * _swiglu(hf, w1[e], w3[e], w2[e])
    return y.reshape(b, t, d)


def setup_inputs(seed: int = 0) -> dict:
    key = jax.random.key(seed)
    ks = iter(jax.random.split(key, 64))

    def nrm(shape, s=1.0):
        return jax.random.normal(next(ks), shape, jnp.float32) * s

    def gain(shape):
        return 1.0 + nrm(shape, 0.02)

    D = D_MODEL
    return {
        'x': nrm((BATCH, SEQ, D)),
        'c': nrm((BATCH, D)),
        'ctx': nrm((BATCH, CTX_LEN, D)),
        'c_ctx': nrm((D,)),
        'w_ada': nrm((DEPTH, D, 6 * D), 0.5 * D ** -0.5),
        'b_ada': nrm((DEPTH, 6 * D), 0.02),
        'norm_g': gain((DEPTH, 2, D)),
        'e_w_in': nrm((N_EVEN, D, IN_E), D ** -0.5),
        'e_conv_w': nrm((N_EVEN, CONV_K, A_CH), CONV_K ** -0.5),
        'e_conv_b': nrm((N_EVEN, A_CH), 0.02),
        'e_ln_a_g': gain((N_EVEN, A_CH)),
        'e_ln_a_b': nrm((N_EVEN, A_CH), 0.02),
        'e_ln_v_g': gain((N_EVEN, B_CH)),
        'e_ln_v_b': nrm((N_EVEN, B_CH), 0.02),
        'e_w_s': nrm((N_EVEN, B_HEADS, CHUNK, CHUNK), CHUNK ** -0.5),
        'e_b_s': gain((N_EVEN, B_HEADS, CHUNK)),
        'e_w_out': nrm((N_EVEN, A_CH + B_CH, D), (A_CH + B_CH) ** -0.5),
        'e_ffn_w1': nrm((N_EVEN, D, D_FF), D ** -0.5),
        'e_ffn_w3': nrm((N_EVEN, D, D_FF), D ** -0.5),
        'e_ffn_w2': nrm((N_EVEN, D_FF, D), D_FF ** -0.5),
        'o_w_in': nrm((N_ODD, D, IN_O), D ** -0.5),
        'o_g_q': gain((N_ODD, Q_RANK)),
        'o_g_kv': gain((N_ODD, KV_RANK)),
        'o_w_uq': nrm((N_ODD, Q_RANK, MLA_HEADS * (QK_NOPE + QK_ROPE)), Q_RANK ** -0.5),
        'o_w_ukv': nrm((N_ODD, KV_RANK, MLA_HEADS * (QK_NOPE + V_HD)), KV_RANK ** -0.5),
        'o_w_o': nrm((N_ODD, MLA_HEADS * V_HD, D), (MLA_HEADS * V_HD) ** -0.5),
        'o_router': nrm((N_ODD, D, N_EXPERTS), D ** -0.5),
        'o_exp_w1': nrm((N_ODD, N_EXPERTS, D, D_EXPERT), D ** -0.5),
        'o_exp_w3': nrm((N_ODD, N_EXPERTS, D, D_EXPERT), D ** -0.5),
        'o_exp_w2': nrm((N_ODD, N_EXPERTS, D_EXPERT, D), D_EXPERT ** -0.5),
        'final_g': gain((D,)),
    }


def reference(x, c, ctx, c_ctx, w_ada, b_ada, norm_g,
              e_w_in, e_conv_w, e_conv_b, e_ln_a_g, e_ln_a_b, e_ln_v_g, e_ln_v_b,
              e_w_s, e_b_s, e_w_out, e_ffn_w1, e_ffn_w3, e_ffn_w2,
              o_w_in, o_g_q, o_g_kv, o_w_uq, o_w_ukv, o_w_o,
              o_router, o_exp_w1, o_exp_w3, o_exp_w2, final_g):
    b, t, _ = x.shape
    rows = t // GRID_W
    row = jnp.repeat(jnp.arange(rows), GRID_W).astype(jnp.float32)
    col = jnp.tile(jnp.arange(GRID_W), rows).astype(jnp.float32)
    inv_freq = ROPE_BASE ** (-jnp.arange(ROPE_FREQS, dtype=jnp.float32) / ROPE_FREQS)
    ang = jnp.stack([row[:, None] * inv_freq, col[:, None] * inv_freq], axis=1)
    rope = (jnp.cos(ang), jnp.sin(ang))

    silu_c = jax.nn.silu(c)
    silu_cc = jax.nn.silu(c_ctx)[None]

    for i in range(DEPTH):
        last = i == DEPTH - 1
        j = i // 2
        mx = jnp.split(silu_c @ w_ada[i] + b_ada[i], 6, axis=-1)
        mc = jnp.split(silu_cc @ w_ada[i] + b_ada[i], 6, axis=-1)
        hx = _modulate(_rmsnorm(x, norm_g[i, 0]), mx[0], mx[1])
        hc = _modulate(_rmsnorm(ctx, norm_g[i, 0]), mc[0], mc[1])

        if i % 2 == 0:
            params = (e_w_in[j], e_conv_w[j], e_conv_b[j], e_ln_a_g[j], e_ln_a_b[j],
                      e_ln_v_g[j], e_ln_v_b[j], e_w_s[j], e_b_s[j], e_w_out[j])
            x = x + mx[2][:, None] * _conv_gmlp_mixer(hx, *params)
            if not last:
                ctx = ctx + mc[2][:, None] * _conv_gmlp_mixer(hc, *params)
        else:
            zx = hx @ o_w_in[j]
            q_lat_x, kv_lat_x, kpe_x = jnp.split(zx, [Q_RANK, Q_RANK + KV_RANK], axis=-1)
            if last:
                zc = hc @ o_w_in[j][:, Q_RANK:]
                kv_lat_c, kpe_c = jnp.split(zc, [KV_RANK], axis=-1)
            else:
                zc = hc @ o_w_in[j]
                q_lat_c, kv_lat_c, kpe_c = jnp.split(zc, [Q_RANK, Q_RANK + KV_RANK], axis=-1)
            k_c, v_c = _mla_kv(kv_lat_c, kpe_c, o_g_kv[j], o_w_ukv[j], None)
            k_x, v_x = _mla_kv(kv_lat_x, kpe_x, o_g_kv[j], o_w_ukv[j], rope)
            q_x = _mla_q(q_lat_x, o_g_q[j], o_w_uq[j], rope)
            att_x = _attend(q_x, jnp.concatenate([k_c, k_x], axis=1), jnp.concatenate([v_c, v_x], axis=1))
            x = x + mx[2][:, None] * (att_x @ o_w_o[j])
            if not last:
                q_c = _mla_q(q_lat_c, o_g_q[j], o_w_uq[j], None)
                att_c = _attend(q_c, k_c, v_c)
                ctx = ctx + mc[2][:, None] * (att_c @ o_w_o[j])

        if i % 2 == 0:
            ffn = lambda h: _swiglu(h, e_ffn_w1[j], e_ffn_w3[j], e_ffn_w2[j])
        else:
            ffn = lambda h: _moe(h, o_router[j], o_exp_w1[j], o_exp_w3[j], o_exp_w2[j])
        hx = _modulate(_rmsnorm(x, norm_g[i, 1]), mx[3], mx[4])
        x = x + mx[5][:, None] * ffn(hx)
        if not last:
            hc = _modulate(_rmsnorm(ctx, norm_g[i, 1]), mc[3], mc[4])
            ctx = ctx + mc[5][:, None] * ffn(hc)

    return _rmsnorm(x, final_g)
```

```cpp
#include <hip/hip_runtime.h>
#include <cstdio>
#include <cstdint>
#ifndef DROPMASK
#define DROPMASK 0
#endif

__device__ __forceinline__ int fresh_lane() { int l; asm volatile("v_mbcnt_lo_u32_b32 %0, -1, 0\n\tv_mbcnt_hi_u32_b32 %0, -1, %0" : "=v"(l)); return l; }
namespace pg8 {
#define PG8_LAS __attribute__((address_space(3)))
typedef unsigned short bf16_t;
typedef short bf16x8 __attribute__((ext_vector_type(8)));
typedef float f32x4 __attribute__((ext_vector_type(4)));
typedef unsigned u32x4 __attribute__((ext_vector_type(4)));
constexpr int BM = 256, BK = 64, HALF = 128, HTB = HALF * BK * 2  , STAGE_BYTES = 8 * HTB, NXCD = 8, WGM = 8;

__host__ __device__ __forceinline__ int lds_byte(int r, int c) { const int st = (r >> 4) * 2 + (c >> 5), rr = r & 15, cc = c & 31, ob = rr * 64 + cc * 2; return st * 1024 + (ob ^ (((ob >> 9) & 1) << 5)); }
__host__ __device__ __forceinline__ void stage_rc(int b, int& R, int& C) { const int st = b / 1024, sb = b % 1024, swz = sb ^ (((sb >> 9) & 1) << 5); R = (st >> 1) * 16 + swz / 64; C = (st & 1) * 32 + (swz % 64) / 2; }
__host__ __device__ __forceinline__ int perm32(int rho) { const int n = rho >> 4, i = rho & 15; return 8 * (i >> 2) + 4 * n + (i & 3); }

struct Unit { int pm, pn; };
struct Gemm { const bf16_t* A; const bf16_t* Bt; int M, N, K; };

struct StaticOrder {
    int nM, nN, nwg, G, c;
    __host__ __device__ void init(int M, int N, int G_, int c_) { nM = M / BM; nN = N / BM; nwg = nM * nN; G = G_; c = c_; }
    __host__ __device__ bool next(int i, Unit& u) const {
        const long L = (long)i * G + c; if (L >= nwg) return false;
        int wgid = (int)L; { const int q = nwg / NXCD, r = nwg % NXCD, xcd = wgid % NXCD, off = wgid / NXCD; wgid = (xcd < r ? xcd * (q + 1) : r * (q + 1) + (xcd - r) * q) + off; }
        const int nig = WGM * nN, gid = wgid / nig, fm = gid * WGM, gsz = (nM - fm) < WGM ? (nM - fm) : WGM;
        u.pm = fm + ((wgid % nig) % gsz); u.pn = (wgid % nig) / gsz; return true;
    }
    __device__ __forceinline__ int arow(const Unit&, int) const { return 0; }
};

__device__ __forceinline__ unsigned cvt_pk_bf16(float lo, float hi) { unsigned r; asm volatile("v_cvt_pk_bf16_f32 %0, %1, %2" : "=v"(r) : "v"(lo), "v"(hi)); return r; }
__device__ __forceinline__ u32x4 pack8(const f32x4 a, const f32x4 b) { u32x4 w; w.x = cvt_pk_bf16(a[0], a[1]); w.y = cvt_pk_bf16(a[2], a[3]); w.z = cvt_pk_bf16(b[0], b[1]); w.w = cvt_pk_bf16(b[2], b[3]); return w; }

template <class Epi, class Sched, bool ALIGN_EPI = false, bool GATHER = false>
__device__ __forceinline__ void gemm_phase(PG8_LAS unsigned char* lds, const Gemm g, const Sched& S, const Epi& E, int wave_id) {
    const int wid = __builtin_amdgcn_readfirstlane(wave_id), tid = wid * 64 + fresh_lane(), lane = tid & 63, wr = wid >> 2, wc = wid & 3, fr = lane & 15, fq = lane >> 4;
    const int K = g.K, nt = K / BK;
    unsigned voffA[2], voffB[2]; int RA[2], CA[2];
#pragma unroll
    for (int i = 0; i < 2; ++i) { int R, C; stage_rc(tid * 16 + i * 8192, R, C); const int Rb = Epi::PERM ? ((R & ~31) + perm32(R & 31)) : R;
        RA[i] = R; CA[i] = C; voffA[i] = (unsigned)(R * K + C) * 2u; voffB[i] = (unsigned)(Rb * K + C) * 2u; }
    const size_t kstep = (size_t)(BK * 2);
    const size_t hstep = (size_t)HALF * K * 2;
    const size_t tstep = 2 * hstep;
    const unsigned ldsw = (unsigned)wid * 1024u;
    const int aoff = lds_byte(wr * 64 + fr, fq * 8), boff = lds_byte(wc * 32 + fr, fq * 8);
#define PG8_SA(b, h) (((b) * 2 + (h)) * HTB)
#define PG8_SB(b, h) ((4 + (b) * 2 + (h)) * HTB)
#define PG8_GLDS(gp, loff) __builtin_amdgcn_global_load_lds((const unsigned*)(gp), (PG8_LAS unsigned*)(lds + (loff)), 16, 0, 0)
#define PG8_STAGE(bufoff, gbase, voff) do { _Pragma("unroll") for (int _i = 0; _i < 2; ++_i) PG8_GLDS((const char*)(gbase) + (voff)[_i], (bufoff) + ldsw + _i * 8192); } while (0)
#define PG8_STAGE_A(bufoff, ptr_ng, ptr_g, h, nx) do { if constexpr (GATHER) { const unsigned _o0 = (nx) ? gn[h][0] : gc[h][0], _o1 = (nx) ? gn[h][1] : gc[h][1]; \
        PG8_GLDS((const char*)(ptr_g) + _o0, (bufoff) + ldsw); PG8_GLDS((const char*)(ptr_g) + _o1, (bufoff) + ldsw + 8192); } \
    else { PG8_STAGE(bufoff, (const char*)(ptr_ng) + (h) * hstep, voffA); } } while (0)
#define PG8_MAP(u, go) do { _Pragma("unroll") for (int _h = 0; _h < 2; ++_h) _Pragma("unroll") for (int _i = 0; _i < 2; ++_i) go[_h][_i] = ((unsigned)S.arow(u, _h * HALF + RA[_i]) * (unsigned)K + (unsigned)CA[_i]) * 2u; } while (0)
#define PG8_LDA(dst, b, h) do { _Pragma("unroll") for (int m = 0; m < 4; ++m) _Pragma("unroll") for (int k = 0; k < 2; ++k) dst[m][k] = *(const PG8_LAS bf16x8*)(lds + PG8_SA(b, h) + aoff + m * 2048 + k * 1024); } while (0)
#define PG8_LDB(dst, b, h) do { _Pragma("unroll") for (int n = 0; n < 2; ++n) _Pragma("unroll") for (int k = 0; k < 2; ++k) dst[n][k] = *(const PG8_LAS bf16x8*)(lds + PG8_SB(b, h) + boff + n * 2048 + k * 1024); } while (0)
#define PG8_MMA(ai, bj, At, Bt) do { __builtin_amdgcn_s_setprio(1); _Pragma("unroll") for (int m = 0; m < 4; ++m) _Pragma("unroll") for (int n = 0; n < 2; ++n) _Pragma("unroll") for (int k = 0; k < 2; ++k) \
        acc[ai][bj][m][n] = __builtin_amdgcn_mfma_f32_16x16x32_bf16(Bt[n][k], At[m][k], acc[ai][bj][m][n], 0, 0, 0); __builtin_amdgcn_s_setprio(0); } while (0)
#define PG8_WAIT_V(n) asm volatile("s_waitcnt vmcnt(" #n ")" ::: "memory")
#define PG8_WAIT_L(n) asm volatile("s_waitcnt lgkmcnt(" #n ")" ::: "memory")
#define PG8_BAR __builtin_amdgcn_s_barrier()
#define PG8_SCHED __builtin_amdgcn_sched_barrier(0)
    Unit cur, nxt; int ui = 0;
    if (!S.next(0, cur)) return;
    f32x4 acc[2][2][4][2];
#pragma unroll
    for (int a = 0; a < 2; ++a)
#pragma unroll
        for (int b = 0; b < 2; ++b)
#pragma unroll
            for (int m = 0; m < 4; ++m)
#pragma unroll
                for (int n = 0; n < 2; ++n) acc[a][b][m][n] = (f32x4){0.f, 0.f, 0.f, 0.f};
    bf16x8 At[4][2], B0[2][2], B1[2][2];
    unsigned gc[2][2] = {{0u, 0u}, {0u, 0u}}, gn[2][2] = {{0u, 0u}, {0u, 0u}};
    if constexpr (GATHER) { PG8_MAP(cur, gc); }
    const char* const gA = (const char*)g.A;
    const char* cA = GATHER ? gA : gA + (size_t)cur.pm * tstep; const char* cB = (const char*)g.Bt + (size_t)cur.pn * tstep;
    PG8_STAGE(PG8_SB(0, 0), cB, voffB); PG8_STAGE(PG8_SB(0, 1), cB + hstep, voffB); PG8_STAGE_A(PG8_SA(0, 0), cA, gA, 0, false); PG8_STAGE_A(PG8_SA(0, 1), cA, gA, 1, false);
    if (wr == 1) PG8_BAR;
    PG8_WAIT_V(2); PG8_BAR;
    PG8_STAGE(PG8_SB(1, 0), cB + kstep, voffB); PG8_STAGE_A(PG8_SA(1, 0), cA + kstep, gA + kstep, 0, false); PG8_STAGE(PG8_SB(1, 1), cB + hstep + kstep, voffB);
    PG8_WAIT_V(6); PG8_BAR;
    for (;;) {
        const bool has_next = S.next(ui + 1, nxt);
        if constexpr (GATHER) { if (has_next) { PG8_MAP(nxt, gn); } else {
#pragma unroll
            for (int h = 0; h < 2; ++h)
#pragma unroll
                for (int i = 0; i < 2; ++i) gn[h][i] = gc[h][i]; } }
        const char* nA = GATHER ? gA : (has_next ? gA + (size_t)nxt.pm * tstep : cA); const char* nB = has_next ? (const char*)g.Bt + (size_t)nxt.pn * tstep : cB;
#pragma unroll 1
        for (int t = 0; t < nt; t += 2) {
            const bool last = (t == nt - 2);
            const char* a1 = cA + (size_t)(t + 1) * kstep;
            const char* a2 = last ? nA : cA + (size_t)(t + 2) * kstep; const char* b2 = last ? nB : cB + (size_t)(t + 2) * kstep;
            const char* a3 = a2 + kstep; const char* b3 = b2 + kstep;
            PG8_LDB(B0, 0, 0); PG8_LDB(B1, 0, 1); PG8_SCHED; PG8_LDA(At, 0, 0); PG8_STAGE_A(PG8_SA(1, 1), a1, a1, 1, false);
            PG8_WAIT_V(8); PG8_WAIT_L(0); PG8_BAR; PG8_MMA(0, 0, At, B0); PG8_MMA(0, 1, At, B1); PG8_BAR; PG8_SCHED;
            PG8_LDA(At, 0, 1); PG8_STAGE(PG8_SB(0, 0), b2, voffB); PG8_STAGE(PG8_SB(0, 1), b2 + hstep, voffB); PG8_STAGE_A(PG8_SA(0, 0), a2, a2, 0, last);
            PG8_WAIT_V(8); PG8_WAIT_L(0); PG8_BAR; PG8_MMA(1, 0, At, B0); PG8_MMA(1, 1, At, B1); PG8_BAR; PG8_SCHED;
            PG8_LDB(B0, 1, 0); PG8_LDB(B1, 1, 1); PG8_SCHED; PG8_LDA(At, 1, 0); PG8_STAGE_A(PG8_SA(0, 1), a2, a2, 1, last);
            PG8_WAIT_V(8); PG8_WAIT_L(0); PG8_BAR; PG8_MMA(0, 0, At, B0); PG8_MMA(0, 1, At, B1); PG8_BAR; PG8_SCHED;
            PG8_LDA(At, 1, 1); PG8_STAGE(PG8_SB(1, 0), b3, voffB); PG8_STAGE(PG8_SB(1, 1), b3 + hstep, voffB); PG8_STAGE_A(PG8_SA(1, 0), a3, a3, 0, last);
            PG8_WAIT_V(8); PG8_WAIT_L(0); PG8_BAR; PG8_MMA(1, 0, At, B0); PG8_MMA(1, 1, At, B1); PG8_BAR; PG8_SCHED;
        }
        if constexpr (ALIGN_EPI) { if (wr == 0) PG8_BAR; }
        E(acc, cur, wr, wc, fr, fq);
        if (!has_next) break;
#pragma unroll
        for (int a = 0; a < 2; ++a)
#pragma unroll
            for (int b = 0; b < 2; ++b)
#pragma unroll
                for (int m = 0; m < 4; ++m)
#pragma unroll
                    for (int n = 0; n < 2; ++n) acc[a][b][m][n] = (f32x4){0.f, 0.f, 0.f, 0.f};
        cur = nxt; cA = nA; cB = nB; ++ui;
        if constexpr (GATHER) {
#pragma unroll
            for (int h = 0; h < 2; ++h)
#pragma unroll
                for (int i = 0; i < 2; ++i) gc[h][i] = gn[h][i]; }
        if constexpr (ALIGN_EPI) { if (wr == 1) PG8_BAR; }
    }
    PG8_WAIT_V(0);
    if constexpr (!ALIGN_EPI) { if (wr == 0) PG8_BAR; }
    PG8_BAR;
#undef PG8_SA
#undef PG8_SB
#undef PG8_GLDS
#undef PG8_STAGE
#undef PG8_STAGE_A
#undef PG8_MAP
#undef PG8_LDA
#undef PG8_LDB
#undef PG8_MMA
#undef PG8_WAIT_V
#undef PG8_WAIT_L
#undef PG8_BAR
#undef PG8_SCHED
}
}
constexpr int NWAVES = 8;
constexpr int DM = 1024, NB = 8, SEQ = 4096, CTXL = 256;
constexpr int NLAT = NB * SEQ, NCTX = NB * CTXL, MALL = NLAT + NCTX;
constexpr int ACH = 512, BCH = 512, CONVK = 31, CHUNK = 128;
constexpr int DFF = 2816, NEXP = 8, DEXP = 3584;
constexpr int QRANK = 384, KVRANK = 256, ROPE = 64, INO = 704, INO_PAD = 768, NHEAD = 8, QKD = 192, VHD = 128;
constexpr int SKV = CTXL + SEQ;
constexpr float EPS = 1e-6f;
constexpr float ATTN_SCALE = 0.07216878364870322f;
constexpr int NSLICE = 2, SLICE_TOK = NLAT / NSLICE, LIST_CAP = SLICE_TOK;
constexpr int MODW = 6 * DM;

constexpr size_t MiB = 1u << 20;
constexpr size_t WS_CTL = 0, CTL_ZERO_BYTES = 1 * MiB;
constexpr size_t WS_MOD = 1 * MiB;
constexpr size_t WS_ROPE = 1 * MiB + 512 * 1024;
constexpr size_t WS_TOKG = 1 * MiB + 768 * 1024;
constexpr size_t WS_LIST = 2 * MiB;
constexpr size_t WS_WIN = 4 * MiB, WS_WOUT = 8 * MiB, WS_W13 = 10 * MiB, WS_W2 = 21 * MiB, WS_WINO = 27 * MiB, WS_WUQ = 29 * MiB, WS_WUKV = 31 * MiB, WS_WO = 32 * MiB;
constexpr size_t WS_WSB = 3 * MiB;
constexpr size_t WS_EW13 = 34 * MiB, WS_EW2 = 146 * MiB, WS_ARENA = 202 * MiB;
static_assert(WS_W2 + (size_t)DM * DFF * 2 <= WS_WINO && WS_WINO + (size_t)INO_PAD * DM * 2 <= WS_WUQ && WS_WUQ + (size_t)1536 * QRANK * 2 <= WS_WUKV && WS_WUKV + (size_t)2048 * KVRANK * 2 <= WS_WO && WS_WO + (size_t)DM * DM * 2 <= 34 * MiB && WS_LIST + (size_t)NSLICE * NEXP * LIST_CAP * 4 <= WS_WSB, "weight map");
static_assert(WS_EW13 + (size_t)NEXP * 2 * DEXP * DM * 2 == WS_EW2 && WS_EW2 + (size_t)NEXP * DM * DEXP * 2 == WS_ARENA, "expert weight map");
constexpr size_t AR_XC = 0, AR_H = 8, AR_AG = 76, AR_UG = 110, AR_VG = 144, AR_ACT = 76, AR_Z = 76, AR_QN = 127, AR_KVN = 151, AR_KPE = 168, AR_Q = 173, AR_KN = 0, AR_V = 269, AR_ATT = 68;
constexpr size_t AR_H4 = 0, AR_Y = 64, AR_ACTE = 128, AR_END = 366;
constexpr size_t WS_END = WS_ARENA + AR_END * MiB;
static_assert(AR_ACT * MiB + (size_t)MALL * DFF * 2 <= AR_V * MiB && AR_ACTE * MiB + (size_t)MALL * DEXP * 2 <= AR_END * MiB, "arena");
constexpr int CW_TMO = 0, CW_CODE = 1, CW_BAR = 4096, CW_CNT = 16384;

constexpr int RING_OFF = 0, RING_BYTES = 139264;
constexpr int LDSCTL_OFF = RING_BYTES, MISC_OFF = LDSCTL_OFF + 320, MOET_OFF = LDSCTL_OFF + 512;
constexpr int LDS_BYTES = 147456;

#define GAS __attribute__((address_space(1)))
#define LAS __attribute__((address_space(3)))
typedef unsigned short bf16;
typedef unsigned v4u __attribute__((ext_vector_type(4)));
typedef unsigned v2u __attribute__((ext_vector_type(2)));
typedef float f32x4 __attribute__((ext_vector_type(4)));
typedef float f32x2 __attribute__((ext_vector_type(2)));
typedef short bf16x8 __attribute__((ext_vector_type(8)));
typedef GAS unsigned gu32;
#define RLX_AGENT __ATOMIC_RELAXED, __HIP_MEMORY_SCOPE_AGENT
#define LDS_WAIT() asm volatile("s_waitcnt lgkmcnt(0)" ::: "memory")
#define VM_WAIT() asm volatile("s_waitcnt vmcnt(0)" ::: "memory")
using pg8::cvt_pk_bf16; using pg8::pack8;
__device__ __forceinline__ float bf_lo(unsigned w) { return __builtin_bit_cast(float, w << 16); }
__device__ __forceinline__ float bf_hi(unsigned w) { return __builtin_bit_cast(float, w & 0xffff0000u); }
__device__ __forceinline__ float fsigmoid(float x) { return __builtin_amdgcn_rcpf(1.0f + __builtin_amdgcn_exp2f(-1.4426950408889634f * x)); }
__device__ __forceinline__ float fsilu(float x) { return x * fsigmoid(x); }
__device__ __forceinline__ float fgelu(float x) { const float u = 0.7978845608028654f * (x + 0.044715f * x * x * x); return x * fsigmoid(2.0f * u); }
template <int K> __device__ __forceinline__ float lane_xor(float v) { return __builtin_bit_cast(float, __builtin_amdgcn_ds_swizzle(__builtin_bit_cast(int, v), (K << 10) | 0x1f)); }
__device__ __forceinline__ float wave_sum(float v) {
    v += lane_xor<1>(v); v += lane_xor<2>(v); v += lane_xor<4>(v); v += lane_xor<8>(v); v += lane_xor<16>(v);
    return __builtin_bit_cast(float, __builtin_amdgcn_readlane(__builtin_bit_cast(int, v), 0)) + __builtin_bit_cast(float, __builtin_amdgcn_readlane(__builtin_bit_cast(int, v), 32));
}

#define XB_TMO      128
#define XB_XCNT(j)  (256  + 64 * (j))
#define XB_XSUB(j)  (1280 + 64 * (j))
#define XB_XGEN(j)  (2304 + 64 * (j))
#define XB_TOP      3328
#define XB_TOPGEN   3392
#define XCD_BAR_WORDS 3456
#define XB_SPIN_CAP (1u << 18)

__device__ __forceinline__ unsigned xb_ld(unsigned* p)              { return __hip_atomic_load(p, __ATOMIC_RELAXED, __HIP_MEMORY_SCOPE_AGENT); }
__device__ __forceinline__ unsigned xb_add(unsigned* p, unsigned v) { return __hip_atomic_fetch_add(p, v, __ATOMIC_RELAXED, __HIP_MEMORY_SCOPE_AGENT); }
__device__ __forceinline__ unsigned xb_xcc_id() { return (unsigned)__builtin_amdgcn_s_getreg((3 << 11) | 20) & 0xFu; }
#define XB_SPIN(cond, bar) do { unsigned _sp = 0; while (cond) { __builtin_amdgcn_s_sleep(1); \
    if ((++_sp & 255u) == 0u) { if (xb_ld(&(bar)[XB_TMO])) break; if (_sp > XB_SPIN_CAP) { atomicAdd(&(bar)[XB_TMO], 1u); break; } } } } while (0)

struct XcdBarrier {
    unsigned* bar; unsigned x;
    volatile LAS unsigned* st;
};

__device__ __forceinline__ XcdBarrier xcd_barrier_post(unsigned* bar, volatile LAS unsigned* st) {
    XcdBarrier b; b.bar = bar; b.x = xb_xcc_id(); b.st = st;
    if (threadIdx.x == 0) (void)xb_add(&bar[XB_XCNT(b.x)], 1u);
    return b;
}
__device__ __forceinline__ void xcd_barrier_complete(unsigned* bar, unsigned x, unsigned& nloc, unsigned& nx) {
    const unsigned G = gridDim.x * gridDim.y * gridDim.z;
    unsigned sum, cnt, mine, sp = 0u;
    for (;;) {
        sum = 0u; cnt = 0u; mine = 0u;
#pragma unroll
        for (unsigned j = 0; j < 16; ++j) { const unsigned c = xb_ld(&bar[XB_XCNT(j)]); sum += c; cnt += (c > 0u) ? 1u : 0u; mine = (j == x) ? c : mine; }
        if (sum == G) break;
        __builtin_amdgcn_s_sleep(1);
        if ((++sp & 255u) == 0u) { if (xb_ld(&bar[XB_TMO])) break; if (sp > XB_SPIN_CAP) { atomicAdd(&bar[XB_TMO], 1u); break; } }
    }
    nloc = mine > 0u ? mine : 1u; nx = cnt > 0u ? cnt : 1u;
}

__device__ __forceinline__ void xcd_barrier(const XcdBarrier& b, int wave_id) {
    const bool t0 = (wave_id == 0) && (fresh_lane() == 0);
    asm volatile("s_waitcnt vmcnt(0)" ::: "memory");
    __syncthreads();
    if (t0) {
        unsigned* bar = b.bar;
        __builtin_amdgcn_s_waitcnt(0);
        unsigned nloc = b.st[0], nx = b.st[1];
        if (nloc == 0u) { xcd_barrier_complete(bar, b.x, nloc, nx); b.st[0] = nloc; b.st[1] = nx; }
        const unsigned old = xb_add(&bar[XB_XSUB(b.x)], 1u);
        const unsigned gen = old / nloc;
        if (old + 1u == (gen + 1u) * nloc) {
            __builtin_amdgcn_fence(__ATOMIC_RELEASE, "agent");
            asm volatile("s_waitcnt vmcnt(0)" ::: "memory");
            const unsigned og = xb_add(&bar[XB_TOP], 1u);
            const unsigned tg = og / nx;
            if (og + 1u == (tg + 1u) * nx) xb_add(&bar[XB_TOPGEN], 1u);
            else XB_SPIN(xb_ld(&bar[XB_TOPGEN]) == tg, bar);
            __builtin_amdgcn_fence(__ATOMIC_ACQUIRE, "agent");
            xb_add(&bar[XB_XGEN(b.x)], 1u);
            asm volatile("s_waitcnt vmcnt(0)" ::: "memory");
        } else {
            XB_SPIN(xb_ld(&bar[XB_XGEN(b.x)]) == gen, bar);
            __builtin_amdgcn_fence(__ATOMIC_ACQUIRE, "agent");
            asm volatile("s_waitcnt vmcnt(0)" ::: "memory");
        }
    }
    __syncthreads();
}
namespace epi {
using pg8::Unit; using pg8::f32x4; using pg8::u32x4; using pg8::bf16_t; using pg8::HALF; using pg8::BM;
#define EPI_ST16(base, off, val) (*(u32x4*)((char*)(base) + (unsigned)(off)) = (val))
struct EpiMixIn {
    static constexpr bool PERM = true;
    bf16_t *AG, *UG, *VG;
    __device__ __forceinline__ void operator()(const f32x4 (&acc)[2][2][4][2], const Unit& u, int wr, int wc, int fr, int fq) const {
        const int cw = wc * 32 + 8 * fq;
        if (u.pn < 4) {
            char* tb = (char*)(AG + (size_t)u.pm * (BM * ACH)); const unsigned lo = (unsigned)((wr * 64 + fr) * ACH + u.pn * 128 + cw) * 2u;
#pragma unroll
            for (int ai = 0; ai < 2; ++ai)
#pragma unroll
                for (int m = 0; m < 4; ++m) { f32x4 o0, o1;
#pragma unroll
                    for (int e = 0; e < 4; ++e) { o0[e] = acc[ai][0][m][0][e] * fsigmoid(acc[ai][1][m][0][e]); o1[e] = acc[ai][0][m][1][e] * fsigmoid(acc[ai][1][m][1][e]); }
                    EPI_ST16(tb + (ai * HALF + m * 16) * ACH * 2, lo, pack8(o0, o1)); }
        } else {
            char* tb = (char*)(((u.pn < 6) ? UG : VG) + (size_t)u.pm * (BM * BCH)); const unsigned lo = (unsigned)((wr * 64 + fr) * BCH + (u.pn & 1) * 256 + cw) * 2u;
#pragma unroll
            for (int ai = 0; ai < 2; ++ai)
#pragma unroll
                for (int m = 0; m < 4; ++m)
#pragma unroll
                    for (int bj = 0; bj < 2; ++bj) { f32x4 o0, o1;
#pragma unroll
                        for (int e = 0; e < 4; ++e) { o0[e] = fgelu(acc[ai][bj][m][0][e]); o1[e] = fgelu(acc[ai][bj][m][1][e]); }
                        EPI_ST16(tb + ((ai * HALF + m * 16) * BCH + bj * HALF) * 2, lo, pack8(o0, o1)); }
        }
    }
};
struct EpiSwiGlu {
    static constexpr bool PERM = true;
    bf16_t* O; int ldc, npn;
    __device__ __forceinline__ void operator()(const f32x4 (&acc)[2][2][4][2], const Unit& u, int wr, int wc, int fr, int fq) const {
        char* tb = (char*)(O + (size_t)u.pm * BM * ldc); const unsigned lo = (unsigned)((wr * 64 + fr) * ldc + (u.pn % npn) * 128 + wc * 32 + 8 * fq) * 2u;
#pragma unroll
        for (int ai = 0; ai < 2; ++ai)
#pragma unroll
            for (int m = 0; m < 4; ++m) { f32x4 o0, o1;
#pragma unroll
                for (int e = 0; e < 4; ++e) { o0[e] = fsilu(acc[ai][0][m][0][e]) * acc[ai][1][m][0][e]; o1[e] = fsilu(acc[ai][0][m][1][e]) * acc[ai][1][m][1][e]; }
                EPI_ST16(tb + (size_t)(ai * HALF + m * 16) * ldc * 2, lo, pack8(o0, o1)); }
    }
};
struct EpiPlain {
    static constexpr bool PERM = true;
    bf16_t* O; int ldc;
    __device__ __forceinline__ void operator()(const f32x4 (&acc)[2][2][4][2], const Unit& u, int wr, int wc, int fr, int fq) const {
        char* tb = (char*)(O + (size_t)u.pm * BM * ldc + u.pn * BM); const unsigned lo = (unsigned)((wr * 64 + fr) * ldc + wc * 32 + 8 * fq) * 2u;
#pragma unroll
        for (int ai = 0; ai < 2; ++ai)
#pragma unroll
            for (int m = 0; m < 4; ++m)
#pragma unroll
                for (int bj = 0; bj < 2; ++bj) EPI_ST16(tb + ((size_t)(ai * HALF + m * 16) * ldc + bj * HALF) * 2, lo, pack8(acc[ai][bj][m][0], acc[ai][bj][m][1]));
    }
};
struct EpiResid {
    static constexpr bool PERM = false;
    const float *srcL, *srcC; float *dstL, *dstC; const float* gate; float mul;
    __device__ __forceinline__ void operator()(const f32x4 (&acc)[2][2][4][2], const Unit& u, int wr, int wc, int fr, int fq) const {
        const bool lat = u.pm < NLAT / BM; const int bi = lat ? (u.pm >> 4) : 8;
        const size_t tb = (size_t)(lat ? u.pm : u.pm - NLAT / BM) * (BM * DM) + u.pn * BM;
        const char* src = (const char*)((lat ? srcL : srcC) + tb); char* dst = (char*)((lat ? dstL : dstC) + tb); const float* gp = gate + bi * MODW + u.pn * BM;
        const unsigned lo = (unsigned)((wr * 64 + fr) * DM + wc * 32 + 4 * fq) * 4u, lg = (unsigned)(wc * 32 + 4 * fq) * 4u;
        f32x4 gv[2][2];
#pragma unroll
        for (int bj = 0; bj < 2; ++bj)
#pragma unroll
            for (int n = 0; n < 2; ++n) gv[bj][n] = *(const f32x4*)((const char*)gp + (bj * HALF + n * 16) * 4 + lg) * mul;
#pragma unroll
        for (int ai = 0; ai < 2; ++ai)
#pragma unroll
            for (int m = 0; m < 4; ++m) {
#pragma unroll
                for (int bj = 0; bj < 2; ++bj)
#pragma unroll
                    for (int n = 0; n < 2; ++n) { const int co = ((ai * HALF + m * 16) * DM + bj * HALF + n * 16) * 4;
                        const f32x4 bs = *(const f32x4*)(src + co + lo); *(f32x4*)(dst + co + lo) = bs + gv[bj][n] * acc[ai][bj][m][n]; }
                if (m & 1) asm volatile("" ::: "memory"); }
    }
};
struct EpiQ {
    static constexpr bool PERM = true;
    bf16_t* Q; const float* rope;
    __device__ __forceinline__ void operator()(const f32x4 (&acc)[2][2][4][2], const Unit& u, int wr, int wc, int fr, int fq) const {
        const int b = u.pm >> 4, t0 = (u.pm & 15) * BM, rl = wr * 64 + fr;
        if (u.pn < 4) {
#pragma unroll
            for (int bj = 0; bj < 2; ++bj) { char* tb = (char*)(Q + ((size_t)(b * NHEAD + 2 * u.pn + bj) * SEQ + t0) * QKD); const unsigned lo = (unsigned)(rl * QKD + wc * 32 + 8 * fq) * 2u;
#pragma unroll
                for (int ai = 0; ai < 2; ++ai)
#pragma unroll
                    for (int m = 0; m < 4; ++m) EPI_ST16(tb + (ai * HALF + m * 16) * QKD * 2, lo, pack8(acc[ai][bj][m][0], acc[ai][bj][m][1])); }
        } else {
            const int h = 4 * (u.pn - 4) + wc, a = fq >> 1, f0 = 8 * (fq & 1);
            char* tb = (char*)(Q + ((size_t)(b * NHEAD + h) * SEQ + t0) * QKD + 128); const unsigned lo = (unsigned)(rl * QKD + a * 32 + f0) * 2u;
#pragma unroll
            for (int ai = 0; ai < 2; ++ai)
#pragma unroll
                for (int m = 0; m < 4; ++m) { const int t = t0 + rl + ai * HALF + m * 16, pos = a ? (t & 63) : (t >> 6);
                    const char* cs = (const char*)rope + (unsigned)((pos * 16 + f0) * 8); f32x4 o1[2], o2[2];
#pragma unroll
                    for (int n = 0; n < 2; ++n) { const f32x4 c0 = *(const f32x4*)(cs + n * 32), c1 = *(const f32x4*)(cs + n * 32 + 16);
                        const f32x4 x1 = acc[ai][0][m][n], x2 = acc[ai][1][m][n];
                        o1[n][0] = x1[0] * c0[0] - x2[0] * c0[1]; o2[n][0] = x1[0] * c0[1] + x2[0] * c0[0];
                        o1[n][1] = x1[1] * c0[2] - x2[1] * c0[3]; o2[n][1] = x1[1] * c0[3] + x2[1] * c0[2];
                        o1[n][2] = x1[2] * c1[0] - x2[2] * c1[1]; o2[n][2] = x1[2] * c1[1] + x2[2] * c1[0];
                        o1[n][3] = x1[3] * c1[2] - x2[3] * c1[3]; o2[n][3] = x1[3] * c1[3] + x2[3] * c1[2]; }
                    EPI_ST16(tb + (ai * HALF + m * 16) * QKD * 2, lo, pack8(o1[0], o1[1])); EPI_ST16(tb + (ai * HALF + m * 16) * QKD * 2 + 32, lo, pack8(o2[0], o2[1]));
                    asm volatile("" ::: "memory"); }
        }
    }
};
struct EpiKV {
    static constexpr bool PERM = true;
    bf16_t *KN, *V;
    __device__ __forceinline__ void operator()(const f32x4 (&acc)[2][2][4][2], const Unit& u, int wr, int wc, int fr, int fq) const {
        const bool lat = u.pm < NLAT / BM; const int b = lat ? (u.pm >> 4) : (u.pm - NLAT / BM), key0 = lat ? CTXL + (u.pm & 15) * BM : 0;
        const size_t te = ((size_t)(b * NHEAD + u.pn) * SKV + key0) * VHD; char* kb = (char*)(KN + te); char* vb = (char*)(V + te);
        const unsigned lo = (unsigned)((wr * 64 + fr) * VHD + wc * 32 + 8 * fq) * 2u;
#pragma unroll
        for (int ai = 0; ai < 2; ++ai)
#pragma unroll
            for (int m = 0; m < 4; ++m) { EPI_ST16(kb + (ai * HALF + m * 16) * VHD * 2, lo, pack8(acc[ai][0][m][0], acc[ai][0][m][1])); EPI_ST16(vb + (ai * HALF + m * 16) * VHD * 2, lo, pack8(acc[ai][1][m][0], acc[ai][1][m][1])); }
    }
};
struct EpiMoeDown {
    static constexpr bool PERM = true;
    bf16_t* Y; const unsigned* list; const LAS int* tab;
    __device__ __forceinline__ void operator()(const f32x4 (&acc)[2][2][4][2], const Unit& u, int wr, int wc, int fr, int fq) const {
        const int e = u.pn >> 2, pnl = u.pn & 3, cnt = tab[16 + e], s0 = (u.pm - tab[e]) * BM + wr * 64 + fr; const unsigned cb = (unsigned)(pnl * BM + wc * 32 + 8 * fq) * 2u;
        const char* lp = (const char*)(list + e * LIST_CAP);
#pragma unroll
        for (int ai = 0; ai < 2; ++ai)
#pragma unroll
            for (int m = 0; m < 4; ++m) { const int slot = s0 + ai * HALF + m * 16;
                if (slot < cnt) { const unsigned ent = *(const unsigned*)(lp + (unsigned)slot * 4u), ro = ent * (unsigned)(DM * 2) + cb;
#pragma unroll
                    for (int bj = 0; bj < 2; ++bj) EPI_ST16(Y, ro + bj * HALF * 2, pack8(acc[ai][bj][m][0], acc[ai][bj][m][1])); } }
    }
};
}
struct MoeOrder {
    pg8::StaticOrder so; int nN; const LAS int* tab; const unsigned* list; int tok0;
    __device__ __forceinline__ bool next(int i, pg8::Unit& u) const {
        if (!so.next(i, u)) return false;
        int e = 0;
#pragma unroll
        for (int k = 1; k < NEXP; ++k) e += (u.pm >= tab[k]) ? 1 : 0;
        u.pn += e * nN; return true;
    }
    __device__ __forceinline__ int arow(const pg8::Unit& u, int r) const {
        const int e = u.pn / nN, cnt = tab[16 + e], slot = (u.pm - tab[e]) * pg8::BM + r;
        const unsigned ent = list[e * LIST_CAP + (slot < cnt ? slot : 0)];
        return tok0 + (int)(ent >> 1);
    }
};
struct Args { const float* in[31]; float* out; unsigned char* ws; };
struct Frame {
    LAS unsigned char* lds; volatile LAS unsigned* MISC; gu32* ctl;
    int tid, lane, wave, vcu, G;
};
enum { I_X = 0, I_C, I_CTX, I_CCTX, I_WADA, I_BADA, I_NORMG, I_EWIN, I_CONVW, I_CONVB, I_LNAG, I_LNAB, I_LNVG, I_LNVB, I_WS, I_BS, I_EWOUT, I_FW1, I_FW3, I_FW2,
       I_OWIN, I_GQ, I_GKV, I_WUQ, I_WUKV, I_WO, I_ROUTER, I_XW1, I_XW3, I_XW2, I_FINALG };

struct MapId   { int off; __device__ __forceinline__ int operator()(int n) const { return off + n; } };
struct MapPair { int half; __device__ __forceinline__ int operator()(int n) const { return 256 * (n >> 7) + 128 * half + (n & 127); } };
struct MapMixIn { __device__ __forceinline__ int operator()(int n) const { if (n >= 1024) return n; const int j = n & 511, hf = n >> 9; return 256 * (j >> 7) + 128 * hf + (j & 127); } };
struct MapUq { __device__ __forceinline__ int operator()(int n) const { const int h = n / QKD, d = n - h * QKD; if (d < 128) return h * 128 + d;
    const int dd = d - 128, a = dd >> 5, p = (dd >> 4) & 1, f = dd & 15; return 1024 + 256 * (h >> 2) + 128 * p + (h & 3) * 32 + a * 16 + f; } };
template <class Map>
__device__ __forceinline__ void p0_transpose_item(const float* W, int K, int N, bf16* WT, const Map& map, LAS float* scr, int item, int lane) {
    const int nblk = N / 32, kb = item / nblk, nb = item - kb * nblk, k0 = 64 * kb, n0 = 32 * nb;
#pragma unroll 8
    for (int i = 0; i < 32; ++i) { const int kk = 2 * i + (lane >> 5); scr[kk * 33 + (lane & 31)] = W[(size_t)(k0 + kk) * N + n0 + (lane & 31)]; }
    LDS_WAIT(); asm volatile("" ::: "memory");
    const int c = lane & 7;
#pragma unroll
    for (int j = 0; j < 4; ++j) { const int n = (lane >> 3) + 8 * j; const LAS float* s = scr + (8 * c) * 33 + n;
        v4u o; o.x = cvt_pk_bf16(s[0 * 33], s[1 * 33]); o.y = cvt_pk_bf16(s[2 * 33], s[3 * 33]); o.z = cvt_pk_bf16(s[4 * 33], s[5 * 33]); o.w = cvt_pk_bf16(s[6 * 33], s[7 * 33]);
        *(GAS v4u*)(WT + (size_t)map(n0 + n) * K + k0 + 8 * c) = o; }
    LDS_WAIT(); asm volatile("" ::: "memory");
}
__device__ __forceinline__ void sincos_d(double th, float& c, float& s) {
    const double q = __builtin_rint(th * 0.63661977236758134308); const int n = (int)q;
    const double r = (th - q * 1.5707963267948966192) - q * 6.123233995736766036e-17, r2 = r * r;
    double sp = -7.6471637318198164759e-13; sp = sp * r2 + 1.6059043836821614599e-10; sp = sp * r2 - 2.5052108385441718775e-08; sp = sp * r2 + 2.7557319223985890653e-06;
    sp = sp * r2 - 1.9841269841269841253e-04; sp = sp * r2 + 8.3333333333333332177e-03; sp = sp * r2 - 1.6666666666666665741e-01; const double sr = r + r * r2 * sp;
    double cp = 4.7794773323873852974e-14; cp = cp * r2 - 1.1470745597729724714e-11; cp = cp * r2 + 2.0876756987868098979e-09; cp = cp * r2 - 2.7557319223985888e-07;
    cp = cp * r2 + 2.4801587301587301566e-05; cp = cp * r2 - 1.3888888888888889419e-03; cp = cp * r2 + 4.1666666666666664354e-02; const double cr = 1.0 - 0.5 * r2 + r2 * r2 * cp;
    const int k = n & 3; const double sv = (k == 0) ? sr : (k == 1) ? cr : (k == 2) ? -sr : -cr, cv = (k == 0) ? cr : (k == 1) ? -sr : (k == 2) ? -cr : sr;
    c = (float)cv; s = (float)sv;
}
__device__ __forceinline__ double inv_freq_d(int f) {
    const int q = f >> 2, r = f & 3; const double rr = (r == 0) ? 1.0 : (r == 1) ? 0.5623413251903491 : (r == 2) ? 0.31622776601683794 : 0.1778279410038923;
    const double qq = (q == 0) ? 1.0 : (q == 1) ? 0.1 : (q == 2) ? 0.01 : 0.001; return rr * qq;
}
__device__ __forceinline__ void p0_prologue(Frame& F, const Args& A) {
    unsigned char* ws = A.ws;
    {
        LAS float* sv = (LAS float*)(F.lds + RING_OFF);
        LAS float* part = (LAS float*)(F.lds + RING_OFF + 9 * 1024 * 4);
        for (int i = F.tid; i < 9 * DM; i += NWAVES * 64) { const float v = (i < 8 * DM) ? A.in[I_C][i] : A.in[I_CCTX][i - 8 * DM]; sv[i] = fsilu(v); }
        __syncthreads();
        float* mod = (float*)(ws + WS_MOD);
        for (int it = F.vcu; it < 2 * MODW / 48; it += F.G) {
            const int l = it / (MODW / 48), j0 = (it - l * (MODW / 48)) * 48;
            const float* W = A.in[I_WADA] + (size_t)l * DM * MODW;
            if (F.tid < 480) { const int cc = F.tid % 48, ks = F.tid / 48, kbeg = ks * 103, kend = (kbeg + 103 < DM) ? kbeg + 103 : DM;
                float a[9];
#pragma unroll
                for (int b = 0; b < 9; ++b) a[b] = 0.f;
                for (int k = kbeg; k < kend; ++k) { const float w = W[(size_t)k * MODW + j0 + cc];
#pragma unroll
                    for (int b = 0; b < 9; ++b) a[b] += sv[b * DM + k] * w; }
#pragma unroll
                for (int b = 0; b < 9; ++b) part[(ks * 9 + b) * 48 + cc] = a[b]; }
            __syncthreads();
            if (F.tid < 9 * 48) { const int b = F.tid / 48, cc = F.tid % 48; float s = A.in[I_BADA][l * MODW + j0 + cc];
#pragma unroll
                for (int ks = 0; ks < 10; ++ks) s += part[(ks * 9 + b) * 48 + cc];
                mod[(size_t)(l * 9 + b) * MODW + j0 + cc] = s; }
            __syncthreads();
        }
    }
    if (F.vcu == 0) for (int i = F.tid; i < 64 * 16; i += NWAVES * 64) { float c, s; sincos_d((double)(i >> 4) * inv_freq_d(i & 15), c, s); ((float*)(ws + WS_ROPE))[2 * i] = c; ((float*)(ws + WS_ROPE))[2 * i + 1] = s; }
    { const int gt = F.vcu * NWAVES * 64 + F.tid, NT = F.G * NWAVES * 64;
      for (int i = gt; i < NEXP * CHUNK * CHUNK / 4; i += NT) { const f32x4 v = ((const f32x4*)A.in[I_WS])[i]; v2u o; o.x = cvt_pk_bf16(v[0], v[1]); o.y = cvt_pk_bf16(v[2], v[3]); ((v2u*)(ws + WS_WSB))[i] = o; }
      for (int i = gt; i < (INO_PAD - INO) * DM * 2 / 16; i += NT) ((v4u*)(ws + WS_WINO + (size_t)INO * DM * 2))[i] = (v4u){0u, 0u, 0u, 0u}; }
    __syncthreads();
    LAS float* scr = (LAS float*)(F.lds + RING_OFF + F.wave * 16384);
    const int gw = F.vcu * NWAVES + F.wave, NGW = F.G * NWAVES;
#define ITEMS(K_, N_) (((K_) / 64) * ((N_) / 32))
    constexpr int I_1 = ITEMS(DM, 2048), I_2 = ITEMS(DM, DM), I_3 = ITEMS(DM, DFF), I_4 = ITEMS(DFF, DM), I_5 = ITEMS(DM, INO), I_6 = ITEMS(QRANK, 1536), I_7 = ITEMS(KVRANK, 2048), I_8 = ITEMS(DM, DM);
    constexpr int I_E1 = ITEMS(DM, DEXP), I_E2 = ITEMS(DEXP, DM);
    constexpr int NITEMS = I_1 + I_2 + 2 * I_3 + I_4 + I_5 + I_6 + I_7 + I_8 + NEXP * (2 * I_E1 + I_E2);
    for (int it = gw; it < NITEMS; it += NGW) {
        int r = it;
        if (r < I_1) { p0_transpose_item(A.in[I_EWIN], DM, 2048, (bf16*)(ws + WS_WIN), MapMixIn{}, scr, r, F.lane); continue; } r -= I_1;
        if (r < I_2) { p0_transpose_item(A.in[I_EWOUT], DM, DM, (bf16*)(ws + WS_WOUT), MapId{0}, scr, r, F.lane); continue; } r -= I_2;
        if (r < I_3) { p0_transpose_item(A.in[I_FW1], DM, DFF, (bf16*)(ws + WS_W13), MapPair{0}, scr, r, F.lane); continue; } r -= I_3;
        if (r < I_3) { p0_transpose_item(A.in[I_FW3], DM, DFF, (bf16*)(ws + WS_W13), MapPair{1}, scr, r, F.lane); continue; } r -= I_3;
        if (r < I_4) { p0_transpose_item(A.in[I_FW2], DFF, DM, (bf16*)(ws + WS_W2), MapId{0}, scr, r, F.lane); continue; } r -= I_4;
        if (r < I_5) { p0_transpose_item(A.in[I_OWIN], DM, INO, (bf16*)(ws + WS_WINO), MapId{0}, scr, r, F.lane); continue; } r -= I_5;
        if (r < I_6) { p0_transpose_item(A.in[I_WUQ], QRANK, 1536, (bf16*)(ws + WS_WUQ), MapUq{}, scr, r, F.lane); continue; } r -= I_6;
        if (r < I_7) { p0_transpose_item(A.in[I_WUKV], KVRANK, 2048, (bf16*)(ws + WS_WUKV), MapId{0}, scr, r, F.lane); continue; } r -= I_7;
        if (r < I_8) { p0_transpose_item(A.in[I_WO], DM, DM, (bf16*)(ws + WS_WO), MapId{0}, scr, r, F.lane); continue; } r -= I_8;
        { const int per = 2 * I_E1 + I_E2, e = r / per; r -= e * per;
          if (r < I_E1) { p0_transpose_item(A.in[I_XW1] + (size_t)e * DM * DEXP, DM, DEXP, (bf16*)(ws + WS_EW13) + (size_t)e * 2 * DEXP * DM, MapPair{0}, scr, r, F.lane); continue; } r -= I_E1;
          if (r < I_E1) { p0_transpose_item(A.in[I_XW3] + (size_t)e * DM * DEXP, DM, DEXP, (bf16*)(ws + WS_EW13) + (size_t)e * 2 * DEXP * DM, MapPair{1}, scr, r, F.lane); continue; } r -= I_E1;
          p0_transpose_item(A.in[I_XW2] + (size_t)e * DEXP * DM, DEXP, DM, (bf16*)(ws + WS_EW2) + (size_t)e * DM * DEXP, MapId{0}, scr, r, F.lane); }
    }
#undef ITEMS
}

template <bool ROUTE>
__device__ __forceinline__ void norm_phase(Frame& F, const Args& A, const float* srcL, const float* srcC, int nrows, const float* g, const float* modl, int shift_slot, bf16* H) {
    LAS float* rt = (LAS float*)(F.lds + RING_OFF);
    if constexpr (ROUTE) { for (int i = F.tid; i < DM * NEXP; i += NWAVES * 64) { const int k = i >> 3, e = i & 7; rt[e * DM + k] = A.in[I_ROUTER][i]; } __syncthreads(); }
    const int gw = F.vcu * NWAVES + F.wave, NGW = F.G * NWAVES;
    for (int row = gw; row < nrows; row += NGW) {
        const bool lat = row < NLAT; const float* src = lat ? srcL + (size_t)row * DM : srcC + (size_t)(row - NLAT) * DM; const int bi = lat ? (row >> 12) : 8;
        const float* sh = modl + bi * MODW + shift_slot * DM; const float* sc = sh + DM;
        f32x4 v[4]; float ss = 0.f;
#pragma unroll
        for (int j = 0; j < 4; ++j) { v[j] = ((const f32x4*)src)[F.lane + 64 * j]; ss += (v[j][0] * v[j][0] + v[j][1] * v[j][1]) + (v[j][2] * v[j][2] + v[j][3] * v[j][3]); }
        const float r = 1.0f / sqrtf(wave_sum(ss) * (1.0f / DM) + EPS);
        float lg[NEXP];
        if constexpr (ROUTE) {
#pragma unroll
            for (int e = 0; e < NEXP; ++e) lg[e] = 0.f; }
#pragma unroll
        for (int j = 0; j < 4; ++j) { const int c = 4 * F.lane + 256 * j; const f32x4 gv = *(const f32x4*)(g + c), s1 = *(const f32x4*)(sc + c), s0 = *(const f32x4*)(sh + c);
            const f32x4 y = (v[j] * r) * gv * (s1 + 1.0f) + s0;
            if constexpr (ROUTE) {
#pragma unroll
                for (int e = 0; e < NEXP; ++e) { const f32x4 w = *(const LAS f32x4*)(rt + e * DM + c); lg[e] += (y[0] * w[0] + y[1] * w[1]) + (y[2] * w[2] + y[3] * w[3]); } }
            v2u o; o.x = cvt_pk_bf16(y[0], y[1]); o.y = cvt_pk_bf16(y[2], y[3]); *(v2u*)(H + (size_t)row * DM + c) = o; }
        if constexpr (ROUTE) {
#pragma unroll
            for (int e = 0; e < NEXP; ++e) lg[e] = wave_sum(lg[e]);
            int i0 = 0; float v0 = lg[0];
#pragma unroll
            for (int e = 1; e < NEXP; ++e) if (lg[e] > v0) { v0 = lg[e]; i0 = e; }
            int i1 = -1; float v1 = -3.0e38f;
#pragma unroll
            for (int e = 0; e < NEXP; ++e) if (e != i0 && lg[e] > v1) { v1 = lg[e]; i1 = e; }
            if (F.lane == 0) {
                const float ex = __expf(v1 - v0), g0 = 1.0f / (1.0f + ex), g1 = ex * g0;
                const int s = row / SLICE_TOK, tl = row - s * SLICE_TOK;
                unsigned* list = (unsigned*)(A.ws + WS_LIST) + (size_t)s * NEXP * LIST_CAP;
                const unsigned p0 = __hip_atomic_fetch_add((unsigned*)F.ctl + CW_CNT + 64 * (s * NEXP + i0), 1u, RLX_AGENT);
                const unsigned p1 = __hip_atomic_fetch_add((unsigned*)F.ctl + CW_CNT + 64 * (s * NEXP + i1), 1u, RLX_AGENT);
                list[i0 * LIST_CAP + p0] = (unsigned)tl * 2u; list[i1 * LIST_CAP + p1] = (unsigned)tl * 2u + 1u;
                *(f32x2*)(A.ws + WS_TOKG + (size_t)row * 8) = (f32x2){g0, g1};
            }
        }
    }
}

__device__ __forceinline__ void mixmid_conv(Frame& F, const Args& A, int ch, int hf, const bf16* AG, bf16* A2) {
    const int R0 = ch * CHUNK + hf * 64;
    int s_lo, s_hi; if (R0 < NLAT) { s_lo = R0 & ~(SEQ - 1); s_hi = s_lo + SEQ; } else { s_lo = NLAT + ((R0 - NLAT) & ~(CTXL - 1)); s_hi = s_lo + CTXL; }
    const int p = (F.wave & 3) * 64 + F.lane, gq = F.wave >> 2;
    LAS float* red = (LAS float*)(F.lds + RING_OFF);
    float w0[CONVK], w1[CONVK];
#pragma unroll
    for (int k = 0; k < CONVK; ++k) { const f32x2 w = *(const f32x2*)(A.in[I_CONVW] + k * ACH + 2 * p); w0[k] = w[0]; w1[k] = w[1]; }
    const f32x2 cb = *(const f32x2*)(A.in[I_CONVB] + 2 * p), lg = *(const f32x2*)(A.in[I_LNAG] + 2 * p), lb = *(const f32x2*)(A.in[I_LNAB] + 2 * p);
#pragma unroll 1
    for (int it = 0; it < 4; ++it) {
        const int t0 = R0 + 8 * (gq + 2 * it);
        float o0[8], o1[8];
#pragma unroll
        for (int t = 0; t < 8; ++t) { o0[t] = cb[0]; o1[t] = cb[1]; }
#pragma unroll
        for (int i = 0; i < 38; ++i) { const int rr = t0 - 15 + i; const unsigned wv = (rr >= s_lo && rr < s_hi) ? *(const unsigned*)((const char*)(AG + (size_t)rr * ACH) + 4 * p) : 0u;
            const float x0 = bf_lo(wv), x1 = bf_hi(wv);
#pragma unroll
            for (int t = 0; t < 8; ++t) { const int k = i - t; if (k >= 0 && k < CONVK) { o0[t] += w0[k] * x0; o1[t] += w1[k] * x1; } }
            if ((i & 7) == 7) asm volatile("" ::: "memory"); }
        LAS float* rd = red + ((it & 1) * 2 + gq) * (4 * 8 * 2);
#pragma unroll
        for (int t = 0; t < 8; ++t) { const float s = wave_sum(o0[t] + o1[t]), q = wave_sum(o0[t] * o0[t] + o1[t] * o1[t]);
            if (F.lane == 0) { rd[((F.wave & 3) * 8 + t) * 2] = s; rd[((F.wave & 3) * 8 + t) * 2 + 1] = q; } }
        __syncthreads();
#pragma unroll
        for (int t = 0; t < 8; ++t) { float s = 0.f, q = 0.f;
#pragma unroll
            for (int w = 0; w < 4; ++w) { s += rd[(w * 8 + t) * 2]; q += rd[(w * 8 + t) * 2 + 1]; }
            const float mu = s * (1.0f / ACH); float var = q * (1.0f / ACH) - mu * mu; var = var > 0.f ? var : 0.f; const float rs = 1.0f / sqrtf(var + EPS);
            const float y0 = (o0[t] - mu) * rs * lg[0] + lb[0], y1 = (o1[t] - mu) * rs * lg[1] + lb[1];
            *(unsigned*)((char*)(A2 + (size_t)(t0 + t) * DM) + 4 * p) = (DROPMASK & 16) ? 0u : cvt_pk_bf16(fsilu(y0), fsilu(y1)); }
    }
    __syncthreads();
}
__device__ __forceinline__ void mixmid_gmlp(Frame& F, const Args& A, int ch, int hg, const bf16* UG, const bf16* VG, const bf16* WSB, bf16* A2) {
    const int R0 = ch * CHUNK;
    LAS f32x2* st = (LAS f32x2*)(F.lds + RING_OFF);
    LAS bf16* vnT = (LAS bf16*)(F.lds + RING_OFF + 1024);
    constexpr int VP = 136;
    for (int i = 0; i < 16; ++i) { const int j = F.wave * 16 + i; const v4u x = *(const v4u*)(VG + (size_t)(R0 + j) * BCH + 8 * F.lane);
        float s = 0.f, q = 0.f;
#pragma unroll
        for (int e = 0; e < 4; ++e) { const float a = bf_lo(x[e]), b = bf_hi(x[e]); s += a + b; q += a * a + b * b; }
        s = wave_sum(s); q = wave_sum(q); const float mu = s * (1.0f / BCH); float var = q * (1.0f / BCH) - mu * mu; var = var > 0.f ? var : 0.f;
        if (F.lane == 0) st[j] = (f32x2){mu, 1.0f / sqrtf(var + EPS)}; }
    __syncthreads();
    { const int j = F.tid >> 2, cq = (F.tid & 3) * 16; const f32x2 ms = st[j];
#pragma unroll
      for (int hh = 0; hh < 4; ++hh) { const int c0 = (4 * hg + hh) * 64 + cq;
#pragma unroll
        for (int q = 0; q < 2; ++q) { const v4u x = *(const v4u*)(VG + (size_t)(R0 + j) * BCH + c0 + 8 * q);
#pragma unroll
            for (int e = 0; e < 4; ++e) { const int c = c0 + 8 * q + 2 * e; const f32x2 gg = *(const f32x2*)(A.in[I_LNVG] + c), bb = *(const f32x2*)(A.in[I_LNVB] + c);
                const float y0 = (bf_lo(x[e]) - ms[0]) * ms[1] * gg[0] + bb[0], y1 = (bf_hi(x[e]) - ms[0]) * ms[1] * gg[1] + bb[1];
                const unsigned pk = cvt_pk_bf16(y0, y1); const int d = cq + 8 * q + 2 * e;
                vnT[(hh * 64 + d) * VP + j] = (bf16)(pk & 0xffffu); vnT[(hh * 64 + d + 1) * VP + j] = (bf16)(pk >> 16); } } } }
    __syncthreads();
    { const int hh = F.wave >> 1, h = 4 * hg + hh, ib0 = (F.wave & 1) * 4, lr = F.lane & 15, lq = F.lane >> 4;
      f32x4 acc[4][4];
#pragma unroll
      for (int a = 0; a < 4; ++a)
#pragma unroll
          for (int b = 0; b < 4; ++b) acc[a][b] = (f32x4){0.f, 0.f, 0.f, 0.f};
#pragma unroll
      for (int kk = 0; kk < 4; ++kk) { bf16x8 wf[4], vf[4];
#pragma unroll
          for (int ib = 0; ib < 4; ++ib) wf[ib] = *(const bf16x8*)(WSB + ((size_t)h * CHUNK + (ib0 + ib) * 16 + lr) * CHUNK + kk * 32 + 8 * lq);
#pragma unroll
          for (int db = 0; db < 4; ++db) vf[db] = *(const LAS bf16x8*)(vnT + (hh * 64 + db * 16 + lr) * VP + kk * 32 + 8 * lq);
#pragma unroll
          for (int ib = 0; ib < 4; ++ib)
#pragma unroll
              for (int db = 0; db < 4; ++db) acc[ib][db] = __builtin_amdgcn_mfma_f32_16x16x32_bf16(vf[db], wf[ib], acc[ib][db], 0, 0, 0); }
#pragma unroll
      for (int ib = 0; ib < 4; ++ib) { const int i = (ib0 + ib) * 16 + lr; const float bsv = A.in[I_BS][h * CHUNK + i];
#pragma unroll
          for (int db = 0; db < 4; ++db) { const int c = h * 64 + db * 16 + 4 * lq; const v2u uu = *(const v2u*)(UG + (size_t)(R0 + i) * BCH + c);
              const f32x4 s = acc[ib][db] + bsv; v2u o; o.x = cvt_pk_bf16(bf_lo(uu.x) * s[0], bf_hi(uu.x) * s[1]); o.y = cvt_pk_bf16(bf_lo(uu.y) * s[2], bf_hi(uu.y) * s[3]);
              if (DROPMASK & 32) { o.x = 0u; o.y = 0u; }
              *(v2u*)(A2 + (size_t)(R0 + i) * DM + ACH + c) = o; } } }
    __syncthreads();
}
__device__ __forceinline__ void mixmid_phase(Frame& F, const Args& A, const bf16* AG, const bf16* UG, const bf16* VG, const bf16* WSB, bf16* A2) {
    constexpr int NU = (MALL / CHUNK) * 4;
    for (int u = F.vcu; u < NU; u += F.G) { const int part = u / (MALL / CHUNK), ch = u - part * (MALL / CHUNK);
#if !defined(MIX_ONLY) || MIX_ONLY == 1
        if (part < 2) mixmid_conv(F, A, ch, part, AG, A2);
#endif
#if !defined(MIX_ONLY) || MIX_ONLY == 2
        if (part >= 2) mixmid_gmlp(F, A, ch, part - 2, UG, VG, WSB, A2);
#endif
    }
}

__device__ __forceinline__ void zsplit_phase(Frame& F, const Args& A, const bf16* Z, bf16* QN, bf16* KVN, bf16* KPE, const float* rope) {
    const int gw = F.vcu * NWAVES + F.wave, NGW = F.G * NWAVES, l = F.lane;
    for (int row = gw; row < MALL; row += NGW) {
        const bf16* z = Z + (size_t)row * INO_PAD; float x[3][4];
#pragma unroll
        for (int j = 0; j < 3; ++j) { const v2u w = *(const v2u*)(z + 4 * l + 256 * j); x[j][0] = bf_lo(w.x); x[j][1] = bf_hi(w.x); x[j][2] = bf_lo(w.y); x[j][3] = bf_hi(w.y); }
        float q0 = 0.f, q1 = 0.f, q2 = 0.f;
#pragma unroll
        for (int e = 0; e < 4; ++e) { q0 += x[0][e] * x[0][e]; q1 += x[1][e] * x[1][e]; q2 += x[2][e] * x[2][e]; }
        const float sq = wave_sum(q0 + (l < 32 ? q1 : 0.f)), skv = wave_sum((l >= 32 ? q1 : 0.f) + (l < 32 ? q2 : 0.f));
        const float rq = 1.0f / sqrtf(sq * (1.0f / QRANK) + EPS), rkv = 1.0f / sqrtf(skv * (1.0f / KVRANK) + EPS);
        const bool lat = row < NLAT;
        if (lat) { const f32x4 g0 = *(const f32x4*)(A.in[I_GQ] + 4 * l); v2u o; o.x = cvt_pk_bf16(x[0][0] * rq * g0[0], x[0][1] * rq * g0[1]); o.y = cvt_pk_bf16(x[0][2] * rq * g0[2], x[0][3] * rq * g0[3]);
            *(v2u*)(QN + (size_t)row * QRANK + 4 * l) = o;
            if (l < 32) { const f32x4 g1 = *(const f32x4*)(A.in[I_GQ] + 256 + 4 * l); v2u o1; o1.x = cvt_pk_bf16(x[1][0] * rq * g1[0], x[1][1] * rq * g1[1]); o1.y = cvt_pk_bf16(x[1][2] * rq * g1[2], x[1][3] * rq * g1[3]);
                *(v2u*)(QN + (size_t)row * QRANK + 256 + 4 * l) = o1; } }
        { const int jj = (l >= 32) ? 1 : 2, kc = (l >= 32) ? 4 * (l - 32) : 128 + 4 * l; const f32x4 gk = *(const f32x4*)(A.in[I_GKV] + kc);
          const float a0 = (jj == 1) ? x[1][0] : x[2][0], a1 = (jj == 1) ? x[1][1] : x[2][1], a2 = (jj == 1) ? x[1][2] : x[2][2], a3 = (jj == 1) ? x[1][3] : x[2][3];
          v2u o; o.x = cvt_pk_bf16(a0 * rkv * gk[0], a1 * rkv * gk[1]); o.y = cvt_pk_bf16(a2 * rkv * gk[2], a3 * rkv * gk[3]);
          *(v2u*)(KVN + (size_t)row * KVRANK + kc) = o; }
        float y[4];
#pragma unroll
        for (int e = 0; e < 4; ++e) y[e] = lane_xor<4>(x[2][e]);
        if (l >= 32 && l < 48) { const int m = l - 32; int b, key, t = 0;
            if (lat) { b = row >> 12; t = row & (SEQ - 1); key = CTXL + t; } else { const int rc = row - NLAT; b = rc >> 8; key = rc & (CTXL - 1); }
            float o[4];
            if (lat) { const int a = m >> 3, pp = (m >> 2) & 1, f0 = 4 * (m & 3), pos = a ? (t & 63) : (t >> 6);
#pragma unroll
                for (int e = 0; e < 4; ++e) { const f32x2 cs = *(const f32x2*)(rope + (pos * 16 + f0 + e) * 2); const float x1 = pp ? y[e] : x[2][e], x2 = pp ? x[2][e] : y[e];
                    o[e] = pp ? (x1 * cs[1] + x2 * cs[0]) : (x1 * cs[0] - x2 * cs[1]); } }
            else {
#pragma unroll
                for (int e = 0; e < 4; ++e) o[e] = x[2][e]; }
            v2u w; w.x = cvt_pk_bf16(o[0], o[1]); w.y = cvt_pk_bf16(o[2], o[3]);
            *(v2u*)(KPE + ((size_t)b * SKV + key) * ROPE + 4 * m) = w; }
    }
}

__device__ __forceinline__ void combine_phase(Frame& F, const Args& A, int slice, const bf16* Y, const float* mod1, float mul) {
    const int gw = F.vcu * NWAVES + F.wave, NGW = F.G * NWAVES;
    for (int tl = gw; tl < SLICE_TOK; tl += NGW) { const int row = slice * SLICE_TOK + tl, bi = row >> 12;
        float* xr = A.out + (size_t)row * DM; const float* gate = mod1 + bi * MODW + 5 * DM; const f32x2 gg = *(const f32x2*)(A.ws + WS_TOKG + (size_t)row * 8);
        const bf16* y0 = Y + (size_t)(2 * tl) * DM; const bf16* y1 = y0 + DM;
        f32x4 v[4]; float ss = 0.f;
#pragma unroll
        for (int j = 0; j < 4; ++j) { const int c = 4 * F.lane + 256 * j; const f32x4 x = *(const f32x4*)(xr + c), gt = *(const f32x4*)(gate + c); const v2u a = *(const v2u*)(y0 + c), b = *(const v2u*)(y1 + c);
            f32x4 m; m[0] = gg[0] * bf_lo(a.x) + gg[1] * bf_lo(b.x); m[1] = gg[0] * bf_hi(a.x) + gg[1] * bf_hi(b.x); m[2] = gg[0] * bf_lo(a.y) + gg[1] * bf_lo(b.y); m[3] = gg[0] * bf_hi(a.y) + gg[1] * bf_hi(b.y);
            v[j] = x + gt * m * mul; ss += (v[j][0] * v[j][0] + v[j][1] * v[j][1]) + (v[j][2] * v[j][2] + v[j][3] * v[j][3]); }
        const float r = 1.0f / sqrtf(wave_sum(ss) * (1.0f / DM) + EPS);
#pragma unroll
        for (int j = 0; j < 4; ++j) { const int c = 4 * F.lane + 256 * j; const f32x4 fg = *(const f32x4*)(A.in[I_FINALG] + c); *(f32x4*)(xr + c) = v[j] * r * fg; }
    }
}
#if SELFCHECK
namespace chk {
__device__ __forceinline__ float bff(bf16 v) { return __builtin_bit_cast(float, (unsigned)v << 16); }
__device__ __forceinline__ float bfr(float f) { unsigned u = __builtin_bit_cast(unsigned, f); u = (u + 0x7fffu + ((u >> 16) & 1u)) & 0xffff0000u; return __builtin_bit_cast(float, u); }
__device__ __forceinline__ unsigned hsh(unsigned x) { x ^= x >> 16; x *= 0x7feb352du; x ^= x >> 15; x *= 0x846ca68bu; x ^= x >> 16; return x; }
__device__ __forceinline__ float dot_w(const bf16* a, const float* W, int K, int N, int n) { float s = 0.f; for (int k = 0; k < K; ++k) s += bff(a[k]) * bfr(W[(size_t)k * N + n]); return s; }
__device__ __forceinline__ float sigm(float x) { return 1.0f / (1.0f + __expf(-x)); }
__device__ __forceinline__ float gelu_t(float x) { return 0.5f * x * (1.0f + tanhf(0.7978845608028654f * (x + 0.044715f * x * x * x))); }
__device__ __forceinline__ void report(unsigned* dbg, int k, float got, float ref, float rel, float abs_) {
    const float err = fabsf(got - ref); const bool bad = !(err <= rel * fabsf(ref) + abs_);
    atomicAdd(dbg + 64 * k + 1, 1u); if (bad) atomicAdd(dbg + 64 * k, 1u);
}
}
#define CHK_LOOP(NS) for (int s_ = (int)(blockIdx.x * 512 + F.tid); s_ < (NS); s_ += (int)(gridDim.x * 512))
#endif
#if SELFCHECK
constexpr int CW_DBG = 32768;
constexpr size_t WS_CAP = 3 * MiB + 512 * 1024;
namespace chk {
struct Ctx { const Args* A; unsigned char* ws; unsigned char* ar; unsigned* dbg; const float* mod; float* XC; };
#define CK_IN(i) (C.A->in[i])
__device__ __forceinline__ const float* xrow(const Ctx& C, const float* L, const float* Cx, int row) { return row < NLAT ? L + (size_t)row * DM : Cx + (size_t)(row - NLAT) * DM; }
__device__ __forceinline__ void c_mod(Frame& F, const Ctx& C) {
    CHK_LOOP(2048) { const unsigned h = hsh(s_); const int l = h & 1, bi = (h >> 1) % 9, j = (h >> 8) % MODW;
        const float* cv = bi < 8 ? CK_IN(I_C) + bi * DM : CK_IN(I_CCTX); float s = CK_IN(I_BADA)[l * MODW + j];
        for (int k = 0; k < DM; ++k) { const float c = cv[k]; s += (c * sigm(c)) * CK_IN(I_WADA)[((size_t)l * DM + k) * MODW + j]; }
        report(C.dbg, 0, C.mod[(size_t)(l * 9 + bi) * MODW + j], s, 2e-3f, 2e-3f); }
}
__device__ __forceinline__ void c_norm(Frame& F, const Ctx& C, int k, const float* L, const float* Cx, int nrows, const float* g, const float* modl, int slot, const bf16* H) {
    CHK_LOOP(2048) { const unsigned h = hsh(s_ + 7919u * k); const int row = h % nrows, col = (h >> 16) % DM; const float* x = xrow(C, L, Cx, row); const int bi = row < NLAT ? row >> 12 : 8;
        float ss = 0.f; for (int i = 0; i < DM; ++i) ss += x[i] * x[i];
        const float r = 1.0f / sqrtf(ss / DM + EPS), y = x[col] * r * g[col] * (1.0f + modl[bi * MODW + (slot + 1) * DM + col]) + modl[bi * MODW + slot * DM + col];
        report(C.dbg, row < NLAT ? k : k + 20, bff(H[(size_t)row * DM + col]), y, 0.01f, 0.01f); }
}
__device__ __forceinline__ void c_mixin(Frame& F, const Ctx& C, const bf16* H, const bf16* AG, const bf16* UG, const bf16* VG) {
    CHK_LOOP(2048) { const unsigned h = hsh(s_ + 111u); const int row = h % MALL, c = (h >> 16) % 1536; const bf16* a = H + (size_t)row * DM; const float* W = CK_IN(I_EWIN); float ref, got;
        if (c < 512) { ref = dot_w(a, W, DM, 2048, c) * sigm(dot_w(a, W, DM, 2048, 512 + c)); got = bff(AG[(size_t)row * ACH + c]); }
        else if (c < 1024) { ref = gelu_t(dot_w(a, W, DM, 2048, 512 + c)); got = bff(UG[(size_t)row * BCH + c - 512]); }
        else { ref = gelu_t(dot_w(a, W, DM, 2048, 512 + c)); got = bff(VG[(size_t)row * BCH + c - 1024]); }
        report(C.dbg, 2, got, ref, 0.02f, 0.02f); }
}
__device__ __forceinline__ void c_mixmid(Frame& F, const Ctx& C, const bf16* AG, const bf16* UG, const bf16* VG, const bf16* A2) {
    CHK_LOOP(512) { const unsigned h = hsh(s_ + 222u); const int row = h % MALL, c = (h >> 16) % DM; float ref;
        if (c < ACH) { int s_lo, s_hi; if (row < NLAT) { s_lo = row & ~(SEQ - 1); s_hi = s_lo + SEQ; } else { s_lo = NLAT + ((row - NLAT) & ~(CTXL - 1)); s_hi = s_lo + CTXL; }
            float s = 0.f, q = 0.f, vc = 0.f;
            for (int ch = 0; ch < ACH; ++ch) { float v = CK_IN(I_CONVB)[ch];
                for (int k = 0; k < CONVK; ++k) { const int rr = row + k - 15; if (rr >= s_lo && rr < s_hi) v += CK_IN(I_CONVW)[k * ACH + ch] * bff(AG[(size_t)rr * ACH + ch]); }
                s += v; q += v * v; if (ch == c) vc = v; }
            const float mu = s / ACH, var = q / ACH - mu * mu, y = (vc - mu) / sqrtf(var + EPS) * CK_IN(I_LNAG)[c] + CK_IN(I_LNAB)[c]; ref = y * sigm(y);
        } else { const int cc = c - ACH, hh = cc >> 6, R0 = row & ~(CHUNK - 1), i = row - R0; float sv = CK_IN(I_BS)[hh * CHUNK + i];
            for (int j = 0; j < CHUNK; ++j) { const bf16* vr = VG + (size_t)(R0 + j) * BCH; float s = 0.f, q = 0.f;
                for (int ch = 0; ch < BCH; ++ch) { const float v = bff(vr[ch]); s += v; q += v * v; }
                const float mu = s / BCH, var = q / BCH - mu * mu, vn = (bff(vr[cc]) - mu) / sqrtf(var + EPS) * CK_IN(I_LNVG)[cc] + CK_IN(I_LNVB)[cc];
                sv += bfr(CK_IN(I_WS)[((size_t)hh * CHUNK + i) * CHUNK + j]) * bfr(vn); }
            ref = bff(UG[(size_t)row * BCH + cc]) * sv; }
        report(C.dbg, 3, bff(A2[(size_t)row * DM + c]), ref, 0.02f, 0.02f); }
}
__device__ __forceinline__ void c_resid(Frame& F, const Ctx& C, int k, int nrows, const bf16* Ain, int K, const float* W, const float* gate, const float* baseL, const float* baseC, bool captured) {
    CHK_LOOP(2048) { const unsigned h = hsh(s_ + 333u * k); const int row = h % nrows, col = (h >> 16) % DM, bi = row < NLAT ? row >> 12 : 8;
        const float base = captured ? ((const float*)(C.ws + WS_CAP))[s_] : xrow(C, baseL, baseC, row)[col];
        const float ref = base + gate[bi * MODW + col] * dot_w(Ain + (size_t)row * K, W, K, DM, col), got = xrow(C, C.A->out, C.XC, row)[col];
        report(C.dbg, k, got, ref, 0.01f, 0.01f); }
}
__device__ __forceinline__ void c_capture(Frame& F, const Ctx& C, int k, int nrows) {
    CHK_LOOP(2048) { const unsigned h = hsh(s_ + 333u * k); const int row = h % nrows, col = (h >> 16) % DM; ((float*)(C.ws + WS_CAP))[s_] = xrow(C, C.A->out, C.XC, row)[col]; }
}
__device__ __forceinline__ void c_swiglu(Frame& F, const Ctx& C, const bf16* H, const bf16* ACT) {
    CHK_LOOP(2048) { const unsigned h = hsh(s_ + 444u); const int row = h % MALL, j = (h >> 16) % DFF; const bf16* a = H + (size_t)row * DM;
        const float p = dot_w(a, CK_IN(I_FW1), DM, DFF, j), q = dot_w(a, CK_IN(I_FW3), DM, DFF, j);
        report(C.dbg, 6, bff(ACT[(size_t)row * DFF + j]), p * sigm(p) * q, 0.02f, 0.02f); }
}
__device__ __forceinline__ void c_z(Frame& F, const Ctx& C, const bf16* H, const bf16* Z) {
    CHK_LOOP(2048) { const unsigned h = hsh(s_ + 555u); const int row = h % MALL, j = (h >> 16) % INO;
        report(C.dbg, 9, bff(Z[(size_t)row * INO_PAD + j]), dot_w(H + (size_t)row * DM, CK_IN(I_OWIN), DM, INO, j), 0.02f, 0.02f); }
}
__device__ __forceinline__ float rope_ref(float x1, float x2, int p, int a, int f, int t) {
    const int pos = a ? (t & 63) : (t >> 6); const float ang = (float)pos * powf(10000.0f, -(float)f / 16.0f), c = cosf(ang), s = sinf(ang);
    return p ? (x1 * s + x2 * c) : (x1 * c - x2 * s);
}
__device__ __forceinline__ void c_zsplit(Frame& F, const Ctx& C, const bf16* Z, const bf16* QN, const bf16* KVN, const bf16* KPE) {
    CHK_LOOP(3072) { const unsigned h = hsh(s_ + 666u); const int kind = s_ % 3; const bf16* z;
        if (kind == 0) { const int row = h % NLAT, c = (h >> 16) % QRANK; z = Z + (size_t)row * INO_PAD; float ss = 0.f; for (int i = 0; i < QRANK; ++i) ss += bff(z[i]) * bff(z[i]);
            report(C.dbg, 10, bff(QN[(size_t)row * QRANK + c]), bff(z[c]) / sqrtf(ss / QRANK + EPS) * CK_IN(I_GQ)[c], 0.01f, 0.01f); }
        else if (kind == 1) { const int row = h % MALL, c = (h >> 16) % KVRANK; z = Z + (size_t)row * INO_PAD; float ss = 0.f; for (int i = 0; i < KVRANK; ++i) ss += bff(z[QRANK + i]) * bff(z[QRANK + i]);
            report(C.dbg, 10, bff(KVN[(size_t)row * KVRANK + c]), bff(z[QRANK + c]) / sqrtf(ss / KVRANK + EPS) * CK_IN(I_GKV)[c], 0.01f, 0.01f); }
        else { const int row = h % MALL, dd = (h >> 16) % ROPE; z = Z + (size_t)row * INO_PAD + QRANK + KVRANK; int b, key; float ref;
            if (row < NLAT) { b = row >> 12; const int t = row & (SEQ - 1); key = CTXL + t; const int a = dd >> 5, p = (dd >> 4) & 1, f = dd & 15; ref = rope_ref(bff(z[a * 32 + f]), bff(z[a * 32 + 16 + f]), p, a, f, t); }
            else { const int rc = row - NLAT; b = rc >> 8; key = rc & (CTXL - 1); ref = bff(z[dd]); }
            report(C.dbg, 10, bff(KPE[((size_t)b * SKV + key) * ROPE + dd]), ref, 0.01f, 0.01f); } }
}
__device__ __forceinline__ void c_qkv(Frame& F, const Ctx& C, const bf16* QN, const bf16* KVN, const bf16* Q, const bf16* KN, const bf16* V) {
    CHK_LOOP(3072) { const unsigned h = hsh(s_ + 777u), h2 = hsh(s_ + 778u); const int kind = s_ % 3, b = h % NB, hd = (h >> 8) % NHEAD;
        if (kind == 0) { const int t = (h >> 16) % SEQ, d = h2 % QKD, row = b * SEQ + t; const bf16* a = QN + (size_t)row * QRANK; float ref;
            if (d < 128) ref = dot_w(a, CK_IN(I_WUQ), QRANK, 1536, hd * QKD + d);
            else { const int dd = d - 128, aa = dd >> 5, p = (dd >> 4) & 1, f = dd & 15;
                ref = rope_ref(dot_w(a, CK_IN(I_WUQ), QRANK, 1536, hd * QKD + 128 + aa * 32 + f), dot_w(a, CK_IN(I_WUQ), QRANK, 1536, hd * QKD + 128 + aa * 32 + 16 + f), p, aa, f, t); }
            report(C.dbg, 11, bff(Q[((size_t)(b * NHEAD + hd) * SEQ + t) * QKD + d]), ref, 0.02f, 0.02f); }
        else { const int key = (h >> 16) % SKV, d = h2 % VHD, row = key < CTXL ? NLAT + b * CTXL + key : b * SEQ + key - CTXL; const bf16* a = KVN + (size_t)row * KVRANK;
            const float ref = dot_w(a, CK_IN(I_WUKV), KVRANK, 2048, hd * 256 + (kind == 1 ? 0 : 128) + d); const bf16* O = kind == 1 ? KN : V;
            report(C.dbg, 11, bff(O[((size_t)(b * NHEAD + hd) * SKV + key) * VHD + d]), ref, 0.02f, 0.02f); } }
}
__device__ __forceinline__ void c_attn(Frame& F, const Ctx& C, const bf16* Q, const bf16* KN, const bf16* KPE, const bf16* V, const bf16* ATT) {
    CHK_LOOP(256) { const unsigned h = hsh(s_ + 888u), h2 = hsh(s_ + 889u); const int b = h % NB, hd = (h >> 8) % NHEAD, t = (h >> 16) % SEQ, d = h2 % VHD;
        const bf16* q = Q + ((size_t)(b * NHEAD + hd) * SEQ + t) * QKD; float m = -1e30f, l = 0.f, o = 0.f;
        for (int k = 0; k < SKV; ++k) { const bf16* kn = KN + ((size_t)(b * NHEAD + hd) * SKV + k) * VHD; const bf16* kp = KPE + ((size_t)b * SKV + k) * ROPE; float sc = 0.f;
            for (int i = 0; i < 128; ++i) sc += bff(q[i]) * bff(kn[i]);
            for (int i = 0; i < 64; ++i) sc += bff(q[128 + i]) * bff(kp[i]);
            sc *= ATTN_SCALE; const float mn = fmaxf(m, sc), al = __expf(m - mn), p = __expf(sc - mn); l = l * al + p; o = o * al + p * bff(V[((size_t)(b * NHEAD + hd) * SKV + k) * VHD + d]); m = mn; }
        report(C.dbg, 12, bff(ATT[((size_t)b * SEQ + t) * DM + hd * VHD + d]), o / l, 0.03f, 0.01f); }
}
__device__ __forceinline__ void c_route(Frame& F, const Ctx& C, const float* modl, const bf16* H4) {
    CHK_LOOP(128) { const unsigned h = hsh(s_ + 999u); const int row = h % NLAT, col = (h >> 16) % DM, bi = row >> 12; const float* x = C.A->out + (size_t)row * DM; const float* g = CK_IN(I_NORMG) + 3 * DM;
        float ss = 0.f; for (int i = 0; i < DM; ++i) ss += x[i] * x[i]; const float r = 1.0f / sqrtf(ss / DM + EPS); float lg[NEXP]; float ycol = 0.f;
#pragma unroll
        for (int e = 0; e < NEXP; ++e) lg[e] = 0.f;
        for (int i = 0; i < DM; ++i) { const float y = x[i] * r * g[i] * (1.0f + modl[bi * MODW + 4 * DM + i]) + modl[bi * MODW + 3 * DM + i]; if (i == col) ycol = y;
#pragma unroll
            for (int e = 0; e < NEXP; ++e) lg[e] += y * CK_IN(I_ROUTER)[i * NEXP + e]; }
        report(C.dbg, 14, bff(H4[(size_t)row * DM + col]), ycol, 0.01f, 0.01f);
        int i0 = 0; float v0 = lg[0];
#pragma unroll
        for (int e = 1; e < NEXP; ++e) if (lg[e] > v0) { v0 = lg[e]; i0 = e; }
        int i1 = 0; float v1 = -3.0e38f;
#pragma unroll
        for (int e = 0; e < NEXP; ++e) if (e != i0 && lg[e] > v1) { v1 = lg[e]; i1 = e; }
        float v2 = -3.0e38f;
#pragma unroll
        for (int e = 0; e < NEXP; ++e) if (e != i0 && e != i1 && lg[e] > v2) v2 = lg[e];
        if (v1 - v2 > 1e-3f && v0 - v1 > 1e-3f) {
            const float ex = __expf(v1 - v0), g0 = 1.0f / (1.0f + ex); const f32x2 tg = *(const f32x2*)(C.ws + WS_TOKG + (size_t)row * 8);
            report(C.dbg, 14, tg[0], g0, 0.01f, 0.002f); report(C.dbg, 14, tg[1], 1.0f - g0, 0.01f, 0.002f);
            const int s = row / SLICE_TOK, tl = row - s * SLICE_TOK; const unsigned* list = (const unsigned*)(C.ws + WS_LIST) + (size_t)s * NEXP * LIST_CAP;
            const int c0 = (int)((const unsigned*)(C.ws + WS_CTL))[CW_CNT + 64 * (s * NEXP + i0)], c1 = (int)((const unsigned*)(C.ws + WS_CTL))[CW_CNT + 64 * (s * NEXP + i1)];
            float f0 = 0.f, f1 = 0.f; for (int i = 0; i < c0; ++i) if (list[i0 * LIST_CAP + i] == (unsigned)tl * 2u) f0 += 1.f; for (int i = 0; i < c1; ++i) if (list[i1 * LIST_CAP + i] == (unsigned)tl * 2u + 1u) f1 += 1.f;
            report(C.dbg, 14, f0, 1.0f, 0.f, 0.01f); report(C.dbg, 14, f1, 1.0f, 0.f, 0.01f); } }
}
__device__ __forceinline__ void c_moe_up(Frame& F, const Ctx& C, int s, const LAS int* tab, const bf16* H4, const bf16* ACTE) {
    const unsigned* list = (const unsigned*)(C.ws + WS_LIST) + (size_t)s * NEXP * LIST_CAP;
    CHK_LOOP(2048) { const unsigned h = hsh(s_ + 1111u + s), h2 = hsh(s_ + 1112u); const int e = h % NEXP, cnt = tab[16 + e]; if (cnt == 0) continue; const int slot = (h >> 8) % cnt, j = h2 % DEXP;
        const int tok = s * SLICE_TOK + (int)(list[e * LIST_CAP + slot] >> 1); const bf16* a = H4 + (size_t)tok * DM;
        const float p = dot_w(a, CK_IN(I_XW1) + (size_t)e * DM * DEXP, DM, DEXP, j), q = dot_w(a, CK_IN(I_XW3) + (size_t)e * DM * DEXP, DM, DEXP, j);
        report(C.dbg, 15, bff(ACTE[((size_t)tab[e] * 256 + slot) * DEXP + j]), p * sigm(p) * q, 0.02f, 0.02f); }
}
__device__ __forceinline__ void c_moe_down(Frame& F, const Ctx& C, int s, const LAS int* tab, const bf16* ACTE, const bf16* Y) {
    const unsigned* list = (const unsigned*)(C.ws + WS_LIST) + (size_t)s * NEXP * LIST_CAP;
    CHK_LOOP(2048) { const unsigned h = hsh(s_ + 2222u + s), h2 = hsh(s_ + 2223u); const int e = h % NEXP, cnt = tab[16 + e]; if (cnt == 0) continue; const int slot = (h >> 8) % cnt, col = h2 % DM;
        const unsigned ent = list[e * LIST_CAP + slot];
        report(C.dbg, 16, bff(Y[(size_t)ent * DM + col]), dot_w(ACTE + ((size_t)tab[e] * 256 + slot) * DEXP, CK_IN(I_XW2) + (size_t)e * DEXP * DM, DEXP, DM, col), 0.02f, 0.02f); }
}
__device__ __forceinline__ void c_cap_rows(Frame& F, const Ctx& C, int s) {
    float* cap = (float*)(C.ws + WS_CAP + 65536);
    for (int i = (int)(blockIdx.x * 512 + F.tid); i < 64 * DM; i += (int)(gridDim.x * 512)) { const int r = i >> 10, c = i & (DM - 1), tl = hsh(r + 3333u + s) % SLICE_TOK; cap[i] = C.A->out[(size_t)(s * SLICE_TOK + tl) * DM + c]; }
}
__device__ __forceinline__ void c_combine(Frame& F, const Ctx& C, int s, const float* mod1, const bf16* Y) {
    const float* cap = (const float*)(C.ws + WS_CAP + 65536);
    CHK_LOOP(64 * 16) { const int r = s_ >> 4, tl = hsh(r + 3333u + s) % SLICE_TOK, row = s * SLICE_TOK + tl, bi = row >> 12, col = hsh(s_ + 4444u) % DM; const f32x2 tg = *(const f32x2*)(C.ws + WS_TOKG + (size_t)row * 8);
        float ss = 0.f, vc = 0.f; for (int i = 0; i < DM; ++i) { const float v = cap[r * DM + i] + mod1[bi * MODW + 5 * DM + i] * (tg[0] * bff(Y[(size_t)(2 * tl) * DM + i]) + tg[1] * bff(Y[(size_t)(2 * tl + 1) * DM + i])); ss += v * v; if (i == col) vc = v; }
        report(C.dbg, 17, C.A->out[(size_t)row * DM + col], vc / sqrtf(ss / DM + EPS) * CK_IN(I_FINALG)[col], 0.005f, 0.005f); }
}
}
#endif
namespace att {
using bf16x8 = __attribute__((ext_vector_type(8))) short;
using s16x4  = __attribute__((ext_vector_type(4))) short;
using f32x16 = __attribute__((ext_vector_type(16))) float;
using u32x4  = __attribute__((ext_vector_type(4))) unsigned;
constexpr int D = 128, NW = 8, QBLK = 32, KVBLK = 64;
constexpr float THR = 8.f, SCALE = ATTN_SCALE;
constexpr int SHM_V = KVBLK * D * 2, SHM_K = KVBLK * D * 2, SHM_P = KVBLK * ROPE * 2, SHM_QP = 2 * SHM_V + 2 * SHM_K + 2 * SHM_P + NW * 64 * 4, NQL = 6  , SHM_ATTN = SHM_QP + NW * NQL * 1024;
static_assert(SHM_ATTN <= RING_BYTES, "attention LDS");
#define KSWZ(row, colB) ((row) * 256 + ((colB) ^ (((row) & 7) << 4)))
#define PSWZ(row, colB) ((row) * 128 + ((colB) ^ (((row) & 7) << 4)))
#define SBAR() __builtin_amdgcn_sched_barrier(0)
__device__ __forceinline__ int crow(int r, int hi) { return (r & 3) + 8 * (r >> 2) + 4 * hi; }
__device__ __forceinline__ unsigned cvtpk(float lo, float hi) { unsigned r; asm volatile("v_cvt_pk_bf16_f32 %0, %1, %2" : "=v"(r) : "v"(lo), "v"(hi)); return r; }
__device__ __forceinline__ void swap32(unsigned& a, unsigned& b) { asm volatile("s_nop 1\n\tv_permlane32_swap_b32 %0, %1\n\ts_nop 0" : "+v"(a), "+v"(b)); }
__device__ __forceinline__ void partialSM(f32x16& p0, f32x16& p1, float& m_reg, float& mn, float& alpha) {
  constexpr float C = SCALE * 1.4426950408889634f;
  float pmax = p0[0]; for (int r = 1; r < 16; ++r) pmax = fmaxf(pmax, p0[r]); for (int r = 0; r < 16; ++r) pmax = fmaxf(pmax, p1[r]);
  { unsigned a_ = __float_as_uint(pmax), b_ = a_; swap32(a_, b_); pmax = fmaxf(__uint_as_float(a_), __uint_as_float(b_)); }
  if (__builtin_expect(__all(pmax - m_reg <= THR / SCALE), 1)) { mn = m_reg; alpha = 1.f; }
  else { mn = fmaxf(m_reg, pmax); alpha = __builtin_amdgcn_exp2f((m_reg - mn) * C); m_reg = mn; }
  float mnC = -mn * C;
  for (int r = 0; r < 16; ++r) p0[r] = fmaf(p0[r], C, mnC); for (int r = 0; r < 16; ++r) p1[r] = fmaf(p1[r], C, mnC);
  for (int r = 0; r < 16; ++r) p0[r] = __builtin_amdgcn_exp2f(p0[r]);
}
__device__ __forceinline__ void finishSM(f32x16& p0, f32x16& p1, float alpha, float& l_reg, bf16x8& pa0, bf16x8& pa1, bf16x8& pa2, bf16x8& pa3) {
  for (int r = 0; r < 16; ++r) p1[r] = __builtin_amdgcn_exp2f(p1[r]);
  float ps = 0; for (int r = 0; r < 16; ++r) ps += p0[r]; for (int r = 0; r < 16; ++r) ps += p1[r];
  { unsigned a_ = __float_as_uint(ps), b_ = a_; swap32(a_, b_); ps = __uint_as_float(a_) + __uint_as_float(b_); }
  l_reg = l_reg * alpha + ps;
#define PK4(P, BASE, OUT) do { unsigned a0 = cvtpk(P[BASE + 0], P[BASE + 1]), a1 = cvtpk(P[BASE + 2], P[BASE + 3]);   \
    unsigned b0 = cvtpk(P[BASE + 4], P[BASE + 5]), b1 = cvtpk(P[BASE + 6], P[BASE + 7]);                              \
    auto r0 = __builtin_amdgcn_permlane32_swap(a0, b0, false, false); auto r1 = __builtin_amdgcn_permlane32_swap(a1, b1, false, false); \
    u32x4 w = {r0[0], r1[0], r0[1], r1[1]}; OUT = *reinterpret_cast<bf16x8*>(&w); } while (0)
  PK4(p0, 0, pa0); PK4(p0, 8, pa1); PK4(p1, 0, pa2); PK4(p1, 8, pa3);
#undef PK4
}
__device__ __forceinline__ void qkt(f32x16& p0, f32x16& p1, const char* Ks, const char* Ps, const bf16x8* qr, const char* qp, int r32, int hi) {
  p0 = f32x16{}; p1 = f32x16{};
#pragma unroll
  for (int d0 = 0; d0 < 8; ++d0) { int cb = (d0 * 16 + hi * 8) * 2;
    bf16x8 b0 = *reinterpret_cast<const bf16x8*>(Ks + KSWZ(r32, cb));
    bf16x8 b1 = *reinterpret_cast<const bf16x8*>(Ks + KSWZ(32 + r32, cb));
    const bf16x8 qf = (d0 < 12 - NQL) ? qr[d0 < 12 - NQL ? d0 : 0] : *reinterpret_cast<const bf16x8*>(qp + (d0 - (12 - NQL)) * 1024);
    p0 = __builtin_amdgcn_mfma_f32_32x32x16_bf16(b0, qf, p0, 0, 0, 0);
    p1 = __builtin_amdgcn_mfma_f32_32x32x16_bf16(b1, qf, p1, 0, 0, 0); }
#pragma unroll
  for (int d0 = 0; d0 < 4; ++d0) { int cb = (d0 * 16 + hi * 8) * 2;
    bf16x8 b0 = *reinterpret_cast<const bf16x8*>(Ps + PSWZ(r32, cb));
    bf16x8 b1 = *reinterpret_cast<const bf16x8*>(Ps + PSWZ(32 + r32, cb));
    const bf16x8 qf = *reinterpret_cast<const bf16x8*>(qp + (8 + d0 - (12 - NQL)) * 1024);
    p0 = __builtin_amdgcn_mfma_f32_32x32x16_bf16(b0, qf, p0, 0, 0, 0);
    p1 = __builtin_amdgcn_mfma_f32_32x32x16_bf16(b1, qf, p1, 0, 0, 0); }
}
__device__ __forceinline__ int v_st(int k, int c) { const int kk = (k & ~0xC) | ((k & 4) << 1) | ((k & 8) >> 1); return ((kk >> 3) * 4 + (c >> 5)) * 512 + ((kk & 7) * 32 + (c & 31)) * 2; }
__device__ __forceinline__ int v_rd_base(int lane) { return ((lane & 3) << 3) | (((lane >> 2) & 3) << 6) | (((lane >> 4) & 1) << 5) | (((lane >> 5) & 1) << 8); }
constexpr int v_rd_off(int d0, int ks, int half) { return d0 * 512 + ks * 4096 + half * 2048; }
template <int OFF> __device__ __forceinline__ s16x4 tr_read(int vb) {
  s16x4 r; asm volatile("ds_read_b64_tr_b16 %0, %1 offset:%2" : "=&v"(r) : "v"(vb), "i"(OFF) : "memory"); return r;
}
template <int D0> __device__ __forceinline__ void pv_one(f32x16& od, int vb, bf16x8 pa0, bf16x8 pa1, bf16x8 pa2, bf16x8 pa3) {
  const s16x4 l0 = tr_read<v_rd_off(D0, 0, 0)>(vb), h0 = tr_read<v_rd_off(D0, 0, 1)>(vb), l1 = tr_read<v_rd_off(D0, 1, 0)>(vb), h1 = tr_read<v_rd_off(D0, 1, 1)>(vb);
  const s16x4 l2 = tr_read<v_rd_off(D0, 2, 0)>(vb), h2 = tr_read<v_rd_off(D0, 2, 1)>(vb), l3 = tr_read<v_rd_off(D0, 3, 0)>(vb), h3 = tr_read<v_rd_off(D0, 3, 1)>(vb);
  asm volatile("s_waitcnt lgkmcnt(0)" ::: "memory"); SBAR();
#define PK(L, H) (bf16x8){L[0], L[1], L[2], L[3], H[0], H[1], H[2], H[3]}
  od = __builtin_amdgcn_mfma_f32_32x32x16_bf16(pa0, PK(l0, h0), od, 0, 0, 0);
  od = __builtin_amdgcn_mfma_f32_32x32x16_bf16(pa1, PK(l1, h1), od, 0, 0, 0);
  od = __builtin_amdgcn_mfma_f32_32x32x16_bf16(pa2, PK(l2, h2), od, 0, 0, 0);
  od = __builtin_amdgcn_mfma_f32_32x32x16_bf16(pa3, PK(l3, h3), od, 0, 0, 0);
#undef PK
}
__device__ __forceinline__ void pv_d0(f32x16* o, int vb, bf16x8 pa0, bf16x8 pa1, bf16x8 pa2, bf16x8 pa3) {
  pv_one<0>(o[0], vb, pa0, pa1, pa2, pa3); pv_one<1>(o[1], vb, pa0, pa1, pa2, pa3); pv_one<2>(o[2], vb, pa0, pa1, pa2, pa3); pv_one<3>(o[3], vb, pa0, pa1, pa2, pa3);
}
__device__ __forceinline__ void attn_unit(const bf16* __restrict__ Qb, const bf16* __restrict__ Kh, const bf16* __restrict__ Ph, const bf16* __restrict__ Vh, bf16* __restrict__ Ob, int seq, char* lds, int wave_id) {
  const int wid = __builtin_amdgcn_readfirstlane(wave_id), lane = fresh_lane(), tid = wid * 64 + lane, r32 = lane & 31, hi = lane >> 5;
  char* V_lds = lds; char* K_lds = lds + 2 * SHM_V; char* P_lds = lds + 2 * SHM_V + 2 * SHM_K;
  float* ws = (float*)(lds + 2 * SHM_V + 2 * SHM_K + 2 * SHM_P) + wid * 64; float* li_l = ws; float* al_l = ws + 32;
  float m_reg = -1e30f, l_reg = 0; f32x16 o[4] = {}; bf16x8 qr[12 - NQL];
  char* qp = lds + SHM_QP + wid * (NQL * 1024) + lane * 16;
  const char* Qw = (const char*)Qb + (size_t)wid * (QBLK * QKD * 2); const int qoff = (r32 * QKD + hi * 8) * 2;
#pragma unroll
  for (int d0 = 0; d0 < 12 - NQL; ++d0) qr[d0] = *reinterpret_cast<const bf16x8*>(Qw + qoff + d0 * 32);
#pragma unroll
  for (int d0 = 0; d0 < NQL; ++d0) *reinterpret_cast<bf16x8*>(qp + d0 * 1024) = *reinterpret_cast<const bf16x8*>(Qw + qoff + (12 - NQL + d0) * 32);
  const int sr = tid >> 4, sc = (tid & 15) * 8, vst0 = v_st(sr, sc), vst1 = v_st(32 + sr, sc);
  const int pr = tid >> 3, pc = (tid & 7) * 8;
  const int vb0 = (int)(uintptr_t)V_lds + v_rd_base(lane);
  struct { bf16x8 vs0, vs1, ks0, ks1, ps; } sr_[1];
  const int kvoff = (sr * D + sc) * 2, poff = (pr * ROPE + pc) * 2;
#define SLOAD(i, k0) do { const char* vt_ = (const char*)Vh + (size_t)(k0) * (D * 2); const char* kt_ = (const char*)Kh + (size_t)(k0) * (D * 2); const char* pt_ = (const char*)Ph + (size_t)(k0) * (ROPE * 2); \
    sr_[i].vs0 = *(const bf16x8*)(vt_ + kvoff); sr_[i].vs1 = *(const bf16x8*)(vt_ + kvoff + 32 * D * 2); \
    sr_[i].ks0 = *(const bf16x8*)(kt_ + kvoff); sr_[i].ks1 = *(const bf16x8*)(kt_ + kvoff + 32 * D * 2); \
    sr_[i].ps = *(const bf16x8*)(pt_ + poff); } while (0)
#define SWRITE(b, i) do { *(bf16x8*)(V_lds + (b) * SHM_V + vst0) = sr_[i].vs0; *(bf16x8*)(V_lds + (b) * SHM_V + vst1) = sr_[i].vs1; int kc = sc * 2; \
    *(bf16x8*)(K_lds + (b) * SHM_K + KSWZ(sr, kc)) = sr_[i].ks0; *(bf16x8*)(K_lds + (b) * SHM_K + KSWZ(32 + sr, kc)) = sr_[i].ks1; \
    *(bf16x8*)(P_lds + (b) * SHM_P + PSWZ(pr, pc * 2)) = sr_[i].ps; } while (0)
#define SWAIT() asm volatile("s_waitcnt vmcnt(0)" ::: "memory")
#define RESC(a) do { if (__any((a) < 1.f)) { if (hi == 0) al_l[r32] = (a); asm volatile("s_waitcnt lgkmcnt(0)" ::: "memory"); \
    for (int d = 0; d < 4; ++d) for (int r = 0; r < 16; ++r) o[d][r] *= al_l[crow(r, hi)]; } } while (0)
  f32x16 pA0, pA1, pB0, pB1; float mnA, mnB, alA, alB; bf16x8 pa0, pa1, pa2, pa3; const int NT = seq / KVBLK;
  SLOAD(0, 0); asm volatile("s_waitcnt vmcnt(0)" ::: "memory"); SWRITE(0, 0); __syncthreads();
  qkt(pA0, pA1, K_lds, P_lds, qr, qp, r32, hi); partialSM(pA0, pA1, m_reg, mnA, alA);
  SLOAD(0, KVBLK);
  SWAIT(); SWRITE(1, 0); __syncthreads();
  for (int j = 1; j + 1 < NT; j += 2) {
    SBAR(); qkt(pB0, pB1, K_lds + SHM_K, P_lds + SHM_P, qr, qp, r32, hi);
    finishSM(pA0, pA1, alA, l_reg, pa0, pa1, pa2, pa3); SBAR();
    SLOAD(0, (j + 1) * KVBLK); SBAR();
    pv_d0(o, vb0, pa0, pa1, pa2, pa3); partialSM(pB0, pB1, m_reg, mnB, alB);
    __syncthreads(); SWAIT(); SWRITE(0, 0);
    RESC(alB); __syncthreads();
    SBAR(); qkt(pA0, pA1, K_lds, P_lds, qr, qp, r32, hi);
    finishSM(pB0, pB1, alB, l_reg, pa0, pa1, pa2, pa3); SBAR();
    SLOAD(0, (j + 2) * KVBLK); SBAR();
    pv_d0(o, vb0 + (int)SHM_V, pa0, pa1, pa2, pa3); partialSM(pA0, pA1, m_reg, mnA, alA);
    __syncthreads(); SWAIT(); SWRITE(1, 0);
    RESC(alA); __syncthreads();
  }
  SBAR(); qkt(pB0, pB1, K_lds + SHM_K, P_lds + SHM_P, qr, qp, r32, hi);
  finishSM(pA0, pA1, alA, l_reg, pa0, pa1, pa2, pa3); SBAR();
  pv_d0(o, vb0, pa0, pa1, pa2, pa3); partialSM(pB0, pB1, m_reg, mnB, alB);
  __syncthreads(); RESC(alB);
  finishSM(pB0, pB1, alB, l_reg, pa0, pa1, pa2, pa3); SBAR();
  pv_d0(o, vb0 + (int)SHM_V, pa0, pa1, pa2, pa3);
  if (hi == 0) li_l[r32] = l_reg; asm volatile("s_waitcnt lgkmcnt(0)" ::: "memory");
  float rli[16];
#pragma unroll
  for (int r = 0; r < 16; ++r) rli[r] = __builtin_amdgcn_rcpf(li_l[crow(r, hi)]);
  char* Ow = (char*)Ob + (size_t)wid * (QBLK * DM * 2); const int ooff = (4 * hi * DM + r32) * 2;
#pragma unroll
  for (int r = 0; r < 16; ++r) { const int orow = (r & 3) + 8 * (r >> 2);
#pragma unroll
    for (int d0 = 0; d0 < 4; ++d0) { const unsigned w = cvtpk(o[d0][r] * rli[r], 0.f); *(bf16*)(Ow + ooff + (orow * DM + d0 * 32) * 2) = (bf16)(w & 0xffffu); } }
  __syncthreads();
#undef SLOAD
#undef SWRITE
#undef SWAIT
#undef RESC
}
#undef KSWZ
#undef PSWZ
#undef SBAR
}

__global__ void __launch_bounds__(NWAVES * 64, 2) fwd_kernel(Args args) {
    extern __shared__ __attribute__((aligned(16))) unsigned char lds[];
    Frame F;
    F.lds = (LAS unsigned char*)lds;
    F.MISC = (volatile LAS unsigned*)(F.lds + MISC_OFF);
    F.tid = threadIdx.x; F.lane = F.tid & 63; F.wave = __builtin_amdgcn_readfirstlane(F.tid >> 6);
    F.G = gridDim.x; { const int bx = blockIdx.x; F.vcu = (F.G % 8 == 0) ? (bx % 8) * (F.G / 8) + bx / 8 : bx; }
    unsigned char* ws = args.ws;
    F.ctl = (gu32*)(ws + WS_CTL);
    for (int u = F.tid; u < (LDS_BYTES - LDSCTL_OFF) / 4; u += NWAVES * 64) ((LAS unsigned*)(F.lds + LDSCTL_OFF))[u] = 0u;
    __syncthreads();
    XcdBarrier bar = xcd_barrier_post((unsigned*)(F.ctl + CW_BAR), F.MISC + 8);
#define GRID_BAR() xcd_barrier(bar, F.wave)
#ifndef DROPMASK
#define DROPMASK 0
#endif
#ifndef PHMASK
#define PHMASK 0xffffffffu
#endif
#define PH(k) FRESH(); if constexpr (((PHMASK) >> (k)) & 1u)
#define FRESH() do { F.lane = fresh_lane(); F.tid = F.wave * 64 + F.lane; } while (0)
    unsigned char* ar = ws + WS_ARENA;
    float* const mod = (float*)(ws + WS_MOD); const float* const mod0 = mod; const float* const mod1 = mod + 9 * MODW;
    const float* const rope = (const float*)(ws + WS_ROPE);
    bf16* const XCb = nullptr; (void)XCb;
    float* const XC = (float*)(ar + AR_XC * MiB);
    bf16* const H = (bf16*)(ar + AR_H * MiB);
    PG8_LAS unsigned char* const ring = (PG8_LAS unsigned char*)(F.lds + RING_OFF);
    const int G = F.G, cid = (int)blockIdx.x;
#if SELFCHECK
    chk::Ctx CK{&args, ws, ar, (unsigned*)(ws + WS_CTL) + CW_DBG, mod, XC};
#define CHK(stmt) do { FRESH(); stmt; GRID_BAR(); } while (0)
#else
#define CHK(stmt) do { } while (0)
#endif

    PH(0) p0_prologue(F, args);
    GRID_BAR();
    CHK(chk::c_mod(F, CK));
    PH(1) norm_phase<false>(F, args, args.in[I_X], args.in[I_CTX], MALL, args.in[I_NORMG] + 0 * DM, mod0, 0, H);
    GRID_BAR();
    CHK(chk::c_norm(F, CK, 1, args.in[I_X], args.in[I_CTX], MALL, args.in[I_NORMG], mod0, 0, H));
    PH(2) { pg8::Gemm g{H, (const bf16*)(ws + WS_WIN), MALL, 2048, DM}; pg8::StaticOrder S; S.init(MALL, 2048, G, cid);
      epi::EpiMixIn E{(bf16*)(ar + AR_AG * MiB), (bf16*)(ar + AR_UG * MiB), (bf16*)(ar + AR_VG * MiB)};
      pg8::gemm_phase<epi::EpiMixIn, pg8::StaticOrder, true>(ring, g, S, E, F.wave); }
    GRID_BAR();
    CHK(chk::c_mixin(F, CK, H, (const bf16*)(ar + AR_AG * MiB), (const bf16*)(ar + AR_UG * MiB), (const bf16*)(ar + AR_VG * MiB)));
    PH(3) mixmid_phase(F, args, (const bf16*)(ar + AR_AG * MiB), (const bf16*)(ar + AR_UG * MiB), (const bf16*)(ar + AR_VG * MiB), (const bf16*)(ws + WS_WSB), H);
    GRID_BAR();
    CHK(chk::c_mixmid(F, CK, (const bf16*)(ar + AR_AG * MiB), (const bf16*)(ar + AR_UG * MiB), (const bf16*)(ar + AR_VG * MiB), H));
    PH(4) { pg8::Gemm g{H, (const bf16*)(ws + WS_WOUT), MALL, DM, DM}; pg8::StaticOrder S; S.init(MALL, DM, G, cid);
      epi::EpiResid E{args.in[I_X], args.in[I_CTX], args.out, XC, mod0 + 2 * DM, (DROPMASK & 1) ? 0.f : 1.f};
      pg8::gemm_phase<epi::EpiResid, pg8::StaticOrder, true>(ring, g, S, E, F.wave); }
    GRID_BAR();
    CHK(chk::c_resid(F, CK, 4, MALL, H, DM, args.in[I_EWOUT], mod0 + 2 * DM, args.in[I_X], args.in[I_CTX], false));
    PH(5) norm_phase<false>(F, args, args.out, XC, MALL, args.in[I_NORMG] + 1 * DM, mod0, 3, H);
    GRID_BAR();
    CHK(chk::c_norm(F, CK, 5, args.out, XC, MALL, args.in[I_NORMG] + DM, mod0, 3, H));
    PH(6) { pg8::Gemm g{H, (const bf16*)(ws + WS_W13), MALL, 2 * DFF, DM}; pg8::StaticOrder S; S.init(MALL, 2 * DFF, G, cid);
      epi::EpiSwiGlu E{(bf16*)(ar + AR_ACT * MiB), DFF, 2 * DFF / 256};
      pg8::gemm_phase<epi::EpiSwiGlu, pg8::StaticOrder, true>(ring, g, S, E, F.wave); }
    GRID_BAR();
    CHK(chk::c_swiglu(F, CK, H, (const bf16*)(ar + AR_ACT * MiB)));
    CHK(chk::c_capture(F, CK, 7, MALL));
    PH(7) { pg8::Gemm g{(const bf16*)(ar + AR_ACT * MiB), (const bf16*)(ws + WS_W2), MALL, DM, DFF}; pg8::StaticOrder S; S.init(MALL, DM, G, cid);
      epi::EpiResid E{args.out, XC, args.out, XC, mod0 + 5 * DM, (DROPMASK & 2) ? 0.f : 1.f};
      pg8::gemm_phase<epi::EpiResid, pg8::StaticOrder, true>(ring, g, S, E, F.wave); }
    GRID_BAR();
    CHK(chk::c_resid(F, CK, 7, MALL, (const bf16*)(ar + AR_ACT * MiB), DFF, args.in[I_FW2], mod0 + 5 * DM, nullptr, nullptr, true));
    PH(8) norm_phase<false>(F, args, args.out, XC, MALL, args.in[I_NORMG] + 2 * DM, mod1, 0, H);
    GRID_BAR();
    CHK(chk::c_norm(F, CK, 8, args.out, XC, MALL, args.in[I_NORMG] + 2 * DM, mod1, 0, H));
    PH(9) { pg8::Gemm g{H, (const bf16*)(ws + WS_WINO), MALL, INO_PAD, DM}; pg8::StaticOrder S; S.init(MALL, INO_PAD, G, cid);
      epi::EpiPlain E{(bf16*)(ar + AR_Z * MiB), INO_PAD};
      pg8::gemm_phase<epi::EpiPlain, pg8::StaticOrder, true>(ring, g, S, E, F.wave); }
    GRID_BAR();
    CHK(chk::c_z(F, CK, H, (const bf16*)(ar + AR_Z * MiB)));
    PH(10) zsplit_phase(F, args, (const bf16*)(ar + AR_Z * MiB), (bf16*)(ar + AR_QN * MiB), (bf16*)(ar + AR_KVN * MiB), (bf16*)(ar + AR_KPE * MiB), rope);
    GRID_BAR();
    CHK(chk::c_zsplit(F, CK, (const bf16*)(ar + AR_Z * MiB), (const bf16*)(ar + AR_QN * MiB), (const bf16*)(ar + AR_KVN * MiB), (const bf16*)(ar + AR_KPE * MiB)));
    PH(11) { pg8::Gemm g{(const bf16*)(ar + AR_QN * MiB), (const bf16*)(ws + WS_WUQ), NLAT, 1536, QRANK}; pg8::StaticOrder S; S.init(NLAT, 1536, G, cid);
      epi::EpiQ E{(bf16*)(ar + AR_Q * MiB), rope};
      pg8::gemm_phase<epi::EpiQ, pg8::StaticOrder, true>(ring, g, S, E, F.wave); }
    PH(12) { pg8::Gemm g{(const bf16*)(ar + AR_KVN * MiB), (const bf16*)(ws + WS_WUKV), MALL, 2048, KVRANK}; pg8::StaticOrder S; S.init(MALL, 2048, G, cid);
      epi::EpiKV E{(bf16*)(ar + AR_KN * MiB), (bf16*)(ar + AR_V * MiB)};
      pg8::gemm_phase<epi::EpiKV, pg8::StaticOrder, true>(ring, g, S, E, F.wave); }
    GRID_BAR();
    CHK(chk::c_qkv(F, CK, (const bf16*)(ar + AR_QN * MiB), (const bf16*)(ar + AR_KVN * MiB), (const bf16*)(ar + AR_Q * MiB), (const bf16*)(ar + AR_KN * MiB), (const bf16*)(ar + AR_V * MiB)));
    PH(13) { const bf16* Qg = (const bf16*)(ar + AR_Q * MiB); const bf16* Kg = (const bf16*)(ar + AR_KN * MiB); const bf16* Pg = (const bf16*)(ar + AR_KPE * MiB); const bf16* Vg = (const bf16*)(ar + AR_V * MiB);
      bf16* Og = (bf16*)(ar + AR_ATT * MiB);
      constexpr int NQB = SEQ / 256, NU = NB * NHEAD * NQB;
      for (int u = F.vcu; u < NU; u += G) { const int bh = u / NQB, qb = u - bh * NQB, b = bh / NHEAD, h = bh - b * NHEAD;
          att::attn_unit(Qg + ((size_t)bh * SEQ + qb * 256) * QKD, Kg + (size_t)bh * SKV * VHD, Pg + (size_t)b * SKV * ROPE, Vg + (size_t)bh * SKV * VHD,
                         Og + ((size_t)b * SEQ + qb * 256) * DM + h * VHD, SKV, (char*)lds + RING_OFF, F.wave); } }
    GRID_BAR();
    CHK(chk::c_attn(F, CK, (const bf16*)(ar + AR_Q * MiB), (const bf16*)(ar + AR_KN * MiB), (const bf16*)(ar + AR_KPE * MiB), (const bf16*)(ar + AR_V * MiB), (const bf16*)(ar + AR_ATT * MiB)));
    CHK(chk::c_capture(F, CK, 13, NLAT));
    PH(14) { pg8::Gemm g{(const bf16*)(ar + AR_ATT * MiB), (const bf16*)(ws + WS_WO), NLAT, DM, DM}; pg8::StaticOrder S; S.init(NLAT, DM, G, cid);
      epi::EpiResid E{args.out, XC, args.out, XC, mod1 + 2 * DM, (DROPMASK & 4) ? 0.f : 1.f};
      pg8::gemm_phase<epi::EpiResid, pg8::StaticOrder, true>(ring, g, S, E, F.wave); }
    GRID_BAR();
    CHK(chk::c_resid(F, CK, 13, NLAT, (const bf16*)(ar + AR_ATT * MiB), DM, args.in[I_WO], mod1 + 2 * DM, nullptr, nullptr, true));
    PH(15) norm_phase<true>(F, args, args.out, XC, NLAT, args.in[I_NORMG] + 3 * DM, mod1, 3, (bf16*)(ar + AR_H4 * MiB));
    GRID_BAR();
    CHK(chk::c_route(F, CK, mod1, (const bf16*)(ar + AR_H4 * MiB)));
    LAS int* const tab = (LAS int*)(F.lds + MOET_OFF);
#pragma unroll 1
    for (int s = 0; s < NSLICE; ++s) {
        if (F.tid == 0) { int base = 0;
            for (int e = 0; e < NEXP; ++e) { const int c = (int)__hip_atomic_load((unsigned*)F.ctl + CW_CNT + 64 * (s * NEXP + e), RLX_AGENT); tab[e] = base; tab[16 + e] = c; base += (c + 255) >> 8; }
            tab[8] = base; }
        __syncthreads();
        const int TT = tab[8];
        const unsigned* list = (const unsigned*)(ws + WS_LIST) + (size_t)s * NEXP * LIST_CAP;
        PH(16) { pg8::Gemm g{(const bf16*)(ar + AR_H4 * MiB), (const bf16*)(ws + WS_EW13), TT * 256, 2 * DEXP, DM};
          MoeOrder S; S.so.init(TT * 256, 2 * DEXP, G, cid); S.nN = 2 * DEXP / 256; S.tab = tab; S.list = list; S.tok0 = s * SLICE_TOK;
          epi::EpiSwiGlu E{(bf16*)(ar + AR_ACTE * MiB), DEXP, 2 * DEXP / 256};
          pg8::gemm_phase<epi::EpiSwiGlu, MoeOrder, true, true>(ring, g, S, E, F.wave); }
        GRID_BAR();
        CHK(chk::c_moe_up(F, CK, s, tab, (const bf16*)(ar + AR_H4 * MiB), (const bf16*)(ar + AR_ACTE * MiB)));
        PH(17) { pg8::Gemm g{(const bf16*)(ar + AR_ACTE * MiB), (const bf16*)(ws + WS_EW2), TT * 256, DM, DEXP};
          MoeOrder S; S.so.init(TT * 256, DM, G, cid); S.nN = DM / 256; S.tab = tab; S.list = list; S.tok0 = 0;
          epi::EpiMoeDown E{(bf16*)(ar + AR_Y * MiB), list, tab};
          pg8::gemm_phase<epi::EpiMoeDown, MoeOrder, true, false>(ring, g, S, E, F.wave); }
        GRID_BAR();
        CHK(chk::c_moe_down(F, CK, s, tab, (const bf16*)(ar + AR_ACTE * MiB), (const bf16*)(ar + AR_Y * MiB)));
        CHK(chk::c_cap_rows(F, CK, s));
        PH(18) combine_phase(F, args, s, (const bf16*)(ar + AR_Y * MiB), mod1, (DROPMASK & 8) ? 0.f : 1.f);
#if SELFCHECK
        GRID_BAR(); CHK(chk::c_combine(F, CK, s, mod1, (const bf16*)(ar + AR_Y * MiB)));
#else
        if (s + 1 < NSLICE) GRID_BAR();
#endif
    }
#if SELFCHECK
    { FRESH(); int code = -1;
      for (int k = 39; k >= 0; --k) { const unsigned f = __hip_atomic_load(CK.dbg + 64 * k, RLX_AGENT), n = __hip_atomic_load(CK.dbg + 64 * k + 1, RLX_AGENT); if (f * 50u > n) code = k; }
      if (code >= 0) { const float v = sqrtf((float)(code + 1)); for (size_t i = (size_t)blockIdx.x * 512 + F.tid; i < (size_t)NLAT * DM; i += (size_t)gridDim.x * 512) args.out[i] = v; } }
#endif
#undef GRID_BAR
}

extern "C" void kernel_launch(void* const* d_in, const int* in_sizes, int n_in, void* d_out, int out_size, void* d_ws, size_t ws_size, hipStream_t stream) {
    static int grid = 0;
    if (grid == 0) {
        if (n_in != 31 || in_sizes[0] != NLAT * DM || out_size != NLAT * DM || ws_size < WS_END) {
            fprintf(stderr, "kernel_launch: shape mismatch: n_in %d in0 %d out %d ws %zu (need %zu); nothing launched\n", n_in, n_in > 0 ? in_sizes[0] : -1, out_size, ws_size, (size_t)WS_END); grid = -1; return; }
        int dev = 0, cus = 0, per_cu = 0;
        if (hipGetDevice(&dev) != hipSuccess || hipDeviceGetAttribute(&cus, hipDeviceAttributeMultiprocessorCount, dev) != hipSuccess) { fprintf(stderr, "kernel_launch: device query failed\n"); grid = -1; return; }
        if (hipFuncSetAttribute((const void*)fwd_kernel, hipFuncAttributeMaxDynamicSharedMemorySize, LDS_BYTES) != hipSuccess) { fprintf(stderr, "kernel_launch: hipFuncSetAttribute failed\n"); grid = -1; return; }
        if (hipOccupancyMaxActiveBlocksPerMultiprocessor(&per_cu, (const void*)fwd_kernel, NWAVES * 64, LDS_BYTES) != hipSuccess || per_cu < 1) {
            fprintf(stderr, "kernel_launch: occupancy query reports %d workgroups per CU; nothing launched\n", per_cu); (void)hipGetLastError(); grid = -1; return; }
        grid = cus;
    }
    if (grid < 0) return;
    if (hipMemsetAsync((char*)d_ws + WS_CTL, 0, CTL_ZERO_BYTES, stream) != hipSuccess) { fprintf(stderr, "kernel_launch: memset failed\n"); return; }
    Args a{};
    for (int i = 0; i < 31; ++i) a.in[i] = (const float*)d_in[i];
    a.out = (float*)d_out; a.ws = (unsigned char*)d_ws;
    hipLaunchKernelGGL(fwd_kernel, dim3(grid), dim3(NWAVES * 64), LDS_BYTES, stream, a);
    const hipError_t le = hipPeekAtLastError();
    if (le != hipSuccess) fprintf(stderr, "kernel_launch: launch failed: %s\n", hipGetErrorName(le));
}
```

```cpp
#include <hip/hip_runtime.h>
#include <cstdio>
#include <cstdint>
#ifndef DROPMASK
#define DROPMASK 0
#endif

__device__ __forceinline__ int fresh_lane() { int l; asm volatile("v_mbcnt_lo_u32_b32 %0, -1, 0\n\tv_mbcnt_hi_u32_b32 %0, -1, %0" : "=v"(l)); return l; }
namespace pg8 {
#define PG8_LAS __attribute__((address_space(3)))
typedef unsigned short bf16_t;
typedef short bf16x8 __attribute__((ext_vector_type(8)));
typedef float f32x4 __attribute__((ext_vector_type(4)));
typedef unsigned u32x4 __attribute__((ext_vector_type(4)));
constexpr int BM = 256, BK = 64, HALF = 128, HTB = HALF * BK * 2  , STAGE_BYTES = 8 * HTB, NXCD = 8, WGM = 8;

__host__ __device__ __forceinline__ int lds_byte(int r, int c) { const int st = (r >> 4) * 2 + (c >> 5), rr = r & 15, cc = c & 31, ob = rr * 64 + cc * 2; return st * 1024 + (ob ^ (((ob >> 9) & 1) << 5)); }
__host__ __device__ __forceinline__ void stage_rc(int b, int& R, int& C) { const int st = b / 1024, sb = b % 1024, swz = sb ^ (((sb >> 9) & 1) << 5); R = (st >> 1) * 16 + swz / 64; C = (st & 1) * 32 + (swz % 64) / 2; }
__host__ __device__ __forceinline__ int perm32(int rho) { const int n = rho >> 4, i = rho & 15; return 8 * (i >> 2) + 4 * n + (i & 3); }

struct Unit { int pm, pn; };
struct Gemm { const bf16_t* A; const bf16_t* Bt; int M, N, K; int sa, sb; };
typedef int i32x4 __attribute__((ext_vector_type(4)));
typedef int i32x8 __attribute__((ext_vector_type(8)));

struct StaticOrder {
    int nM, nN, nwg, G, c;
    __host__ __device__ void init(int M, int N, int G_, int c_) { nM = M / BM; nN = N / BM; nwg = nM * nN; G = G_; c = c_; }
    __host__ __device__ bool next(int i, Unit& u) const {
        const long L = (long)i * G + c; if (L >= nwg) return false;
        int wgid = (int)L; { const int q = nwg / NXCD, r = nwg % NXCD, xcd = wgid % NXCD, off = wgid / NXCD; wgid = (xcd < r ? xcd * (q + 1) : r * (q + 1) + (xcd - r) * q) + off; }
        const int nig = WGM * nN, gid = wgid / nig, fm = gid * WGM, gsz = (nM - fm) < WGM ? (nM - fm) : WGM;
        u.pm = fm + ((wgid % nig) % gsz); u.pn = (wgid % nig) / gsz; return true;
    }
    __device__ __forceinline__ int arow(const Unit&, int) const { return 0; }
};

__device__ __forceinline__ unsigned cvt_pk_bf16(float lo, float hi) { unsigned r; asm volatile("v_cvt_pk_bf16_f32 %0, %1, %2" : "=v"(r) : "v"(lo), "v"(hi)); return r; }
__device__ __forceinline__ u32x4 pack8(const f32x4 a, const f32x4 b) { u32x4 w; w.x = cvt_pk_bf16(a[0], a[1]); w.y = cvt_pk_bf16(a[2], a[3]); w.z = cvt_pk_bf16(b[0], b[1]); w.w = cvt_pk_bf16(b[2], b[3]); return w; }

template <class Epi, class Sched, bool ALIGN_EPI = false, bool GATHER = false, bool FP8 = false>
__device__ __forceinline__ void gemm_phase(PG8_LAS unsigned char* lds, const Gemm g, const Sched& S, const Epi& E, int wave_id) {
    const int wid = __builtin_amdgcn_readfirstlane(wave_id), tid = wid * 64 + fresh_lane(), lane = tid & 63, wr = wid >> 2, wc = wid & 3, fr = lane & 15, fq = lane >> 4;
    const int K = g.K, nt = K / BK;
    unsigned voffA[2], voffB[2]; int RA[2], CA[2];
#pragma unroll
    for (int i = 0; i < 2; ++i) { int R, C; stage_rc(tid * 16 + i * 8192, R, C); const int Rb = Epi::PERM ? ((R & ~31) + perm32(R & 31)) : R;
        RA[i] = R; CA[i] = C; voffA[i] = (unsigned)(R * K + C) * 2u; voffB[i] = (unsigned)(Rb * K + C) * 2u; }
    const size_t kstep = (size_t)(BK * 2);
    const size_t hstep = (size_t)HALF * K * 2;
    const size_t tstep = 2 * hstep;
    const unsigned ldsw = (unsigned)wid * 1024u;
    const int aoff = lds_byte(wr * 64 + fr, fq * 8), boff = lds_byte(wc * 32 + fr, fq * 8);
#define PG8_SA(b, h) (((b) * 2 + (h)) * HTB)
#define PG8_SB(b, h) ((4 + (b) * 2 + (h)) * HTB)
#define PG8_GLDS(gp, loff) __builtin_amdgcn_global_load_lds((const unsigned*)(gp), (PG8_LAS unsigned*)(lds + (loff)), 16, 0, 0)
#define PG8_STAGE(bufoff, gbase, voff) do { _Pragma("unroll") for (int _i = 0; _i < 2; ++_i) PG8_GLDS((const char*)(gbase) + (voff)[_i], (bufoff) + ldsw + _i * 8192); } while (0)
#define PG8_STAGE_A(bufoff, ptr_ng, ptr_g, h, nx) do { if constexpr (GATHER) { const unsigned _o0 = (nx) ? gn[h][0] : gc[h][0], _o1 = (nx) ? gn[h][1] : gc[h][1]; \
        PG8_GLDS((const char*)(ptr_g) + _o0, (bufoff) + ldsw); PG8_GLDS((const char*)(ptr_g) + _o1, (bufoff) + ldsw + 8192); } \
    else { PG8_STAGE(bufoff, (const char*)(ptr_ng) + (h) * hstep, voffA); } } while (0)
#define PG8_MAP(u, go) do { _Pragma("unroll") for (int _h = 0; _h < 2; ++_h) _Pragma("unroll") for (int _i = 0; _i < 2; ++_i) go[_h][_i] = ((unsigned)S.arow(u, _h * HALF + RA[_i]) * (unsigned)K + (unsigned)CA[_i]) * 2u; } while (0)
#define PG8_LD16(off) (*(const PG8_LAS bf16x8*)(lds + (off)))
#define PG8_CAT(x0, x1) __builtin_shufflevector(__builtin_bit_cast(i32x4, x0), __builtin_bit_cast(i32x4, x1), 0, 1, 2, 3, 4, 5, 6, 7)
#define PG8_LDA(dst, b, h) do { if constexpr (FP8) { _Pragma("unroll") for (int m = 0; m < 4; ++m) dst##8[m] = PG8_CAT(PG8_LD16(PG8_SA(b, h) + aoff + m * 2048), PG8_LD16(PG8_SA(b, h) + aoff + m * 2048 + 1024)); } \
    else { _Pragma("unroll") for (int m = 0; m < 4; ++m) _Pragma("unroll") for (int k = 0; k < 2; ++k) dst[m][k] = PG8_LD16(PG8_SA(b, h) + aoff + m * 2048 + k * 1024); } } while (0)
#define PG8_LDB(dst, b, h) do { if constexpr (FP8) { _Pragma("unroll") for (int n = 0; n < 2; ++n) dst##8[n] = PG8_CAT(PG8_LD16(PG8_SB(b, h) + boff + n * 2048), PG8_LD16(PG8_SB(b, h) + boff + n * 2048 + 1024)); } \
    else { _Pragma("unroll") for (int n = 0; n < 2; ++n) _Pragma("unroll") for (int k = 0; k < 2; ++k) dst[n][k] = PG8_LD16(PG8_SB(b, h) + boff + n * 2048 + k * 1024); } } while (0)
#define PG8_MMA(ai, bj, At, Bt) do { __builtin_amdgcn_s_setprio(1); if constexpr (FP8) { _Pragma("unroll") for (int m = 0; m < 4; ++m) _Pragma("unroll") for (int n = 0; n < 2; ++n) \
        asm volatile("v_mfma_scale_f32_16x16x128_f8f6f4 %0, %1, %2, %0, %3, %4 op_sel_hi:[0,0,0]" : "+v"(acc[ai][bj][m][n]) : "v"(Bt##8[n]), "v"(At##8[m]), "v"(vsb), "v"(vsa)); } \
    else { _Pragma("unroll") for (int m = 0; m < 4; ++m) _Pragma("unroll") for (int n = 0; n < 2; ++n) _Pragma("unroll") for (int k = 0; k < 2; ++k) \
        acc[ai][bj][m][n] = __builtin_amdgcn_mfma_f32_16x16x32_bf16(Bt[n][k], At[m][k], acc[ai][bj][m][n], 0, 0, 0); } __builtin_amdgcn_s_setprio(0); } while (0)
#define PG8_WAIT_V(n) asm volatile("s_waitcnt vmcnt(" #n ")" ::: "memory")
#define PG8_WAIT_L(n) asm volatile("s_waitcnt lgkmcnt(" #n ")" ::: "memory")
#define PG8_BAR __builtin_amdgcn_s_barrier()
#define PG8_SCHED __builtin_amdgcn_sched_barrier(0)
    Unit cur, nxt; int ui = 0;
    if (!S.next(0, cur)) return;
    const int vsa = g.sa, vsb = g.sb; (void)vsa; (void)vsb;
    f32x4 acc[2][2][4][2];
#pragma unroll
    for (int a = 0; a < 2; ++a)
#pragma unroll
        for (int b = 0; b < 2; ++b)
#pragma unroll
            for (int m = 0; m < 4; ++m)
#pragma unroll
                for (int n = 0; n < 2; ++n) acc[a][b][m][n] = (f32x4){0.f, 0.f, 0.f, 0.f};
    bf16x8 At[4][2], B0[2][2], B1[2][2]; i32x8 At8[4], B08[2], B18[2];
    unsigned gc[2][2] = {{0u, 0u}, {0u, 0u}}, gn[2][2] = {{0u, 0u}, {0u, 0u}};
    if constexpr (GATHER) { PG8_MAP(cur, gc); }
    const char* const gA = (const char*)g.A;
    const char* cA = GATHER ? gA : gA + (size_t)cur.pm * tstep; const char* cB = (const char*)g.Bt + (size_t)cur.pn * tstep;
    PG8_STAGE(PG8_SB(0, 0), cB, voffB); PG8_STAGE(PG8_SB(0, 1), cB + hstep, voffB); PG8_STAGE_A(PG8_SA(0, 0), cA, gA, 0, false); PG8_STAGE_A(PG8_SA(0, 1), cA, gA, 1, false);
    if (wr == 1) PG8_BAR;
    PG8_WAIT_V(2); PG8_BAR;
    PG8_STAGE(PG8_SB(1, 0), cB + kstep, voffB); PG8_STAGE_A(PG8_SA(1, 0), cA + kstep, gA + kstep, 0, false); PG8_STAGE(PG8_SB(1, 1), cB + hstep + kstep, voffB);
    PG8_WAIT_V(6); PG8_BAR;
    for (;;) {
        const bool has_next = S.next(ui + 1, nxt);
        if constexpr (GATHER) { if (has_next) { PG8_MAP(nxt, gn); } else {
#pragma unroll
            for (int h = 0; h < 2; ++h)
#pragma unroll
                for (int i = 0; i < 2; ++i) gn[h][i] = gc[h][i]; } }
        const char* nA = GATHER ? gA : (has_next ? gA + (size_t)nxt.pm * tstep : cA); const char* nB = has_next ? (const char*)g.Bt + (size_t)nxt.pn * tstep : cB;
#pragma unroll 1
        for (int t = 0; t < nt; t += 2) {
            const bool last = (t == nt - 2);
            const char* a1 = cA + (size_t)(t + 1) * kstep;
            const char* a2 = last ? nA : cA + (size_t)(t + 2) * kstep; const char* b2 = last ? nB : cB + (size_t)(t + 2) * kstep;
            const char* a3 = a2 + kstep; const char* b3 = b2 + kstep;
            PG8_LDB(B0, 0, 0); PG8_LDB(B1, 0, 1); PG8_SCHED; PG8_LDA(At, 0, 0); PG8_STAGE_A(PG8_SA(1, 1), a1, a1, 1, false);
            PG8_WAIT_V(8); PG8_WAIT_L(0); PG8_BAR; PG8_MMA(0, 0, At, B0); PG8_MMA(0, 1, At, B1); PG8_BAR; PG8_SCHED;
            PG8_LDA(At, 0, 1); PG8_STAGE(PG8_SB(0, 0), b2, voffB); PG8_STAGE(PG8_SB(0, 1), b2 + hstep, voffB); PG8_STAGE_A(PG8_SA(0, 0), a2, a2, 0, last);
            PG8_WAIT_V(8); PG8_WAIT_L(0); PG8_BAR; PG8_MMA(1, 0, At, B0); PG8_MMA(1, 1, At, B1); PG8_BAR; PG8_SCHED;
            PG8_LDB(B0, 1, 0); PG8_LDB(B1, 1, 1); PG8_SCHED; PG8_LDA(At, 1, 0); PG8_STAGE_A(PG8_SA(0, 1), a2, a2, 1, last);
            PG8_WAIT_V(8); PG8_WAIT_L(0); PG8_BAR; PG8_MMA(0, 0, At, B0); PG8_MMA(0, 1, At, B1); PG8_BAR; PG8_SCHED;
            PG8_LDA(At, 1, 1); PG8_STAGE(PG8_SB(1, 0), b3, voffB); PG8_STAGE(PG8_SB(1, 1), b3 + hstep, voffB); PG8_STAGE_A(PG8_SA(1, 0), a3, a3, 0, last);
            PG8_WAIT_V(8); PG8_WAIT_L(0); PG8_BAR; PG8_MMA(1, 0, At, B0); PG8_MMA(1, 1, At, B1); PG8_BAR; PG8_SCHED;
        }
        if constexpr (ALIGN_EPI) { if (wr == 0) PG8_BAR; }
        if constexpr (FP8) { asm volatile("s_nop 15\n\ts_nop 15" ::: "memory"); }
        E(acc, cur, wr, wc, fr, fq);
        if (!has_next) break;
#pragma unroll
        for (int a = 0; a < 2; ++a)
#pragma unroll
            for (int b = 0; b < 2; ++b)
#pragma unroll
                for (int m = 0; m < 4; ++m)
#pragma unroll
                    for (int n = 0; n < 2; ++n) acc[a][b][m][n] = (f32x4){0.f, 0.f, 0.f, 0.f};
        cur = nxt; cA = nA; cB = nB; ++ui;
        if constexpr (GATHER) {
#pragma unroll
            for (int h = 0; h < 2; ++h)
#pragma unroll
                for (int i = 0; i < 2; ++i) gc[h][i] = gn[h][i]; }
        if constexpr (ALIGN_EPI) { if (wr == 1) PG8_BAR; }
    }
    PG8_WAIT_V(0);
    if constexpr (!ALIGN_EPI) { if (wr == 0) PG8_BAR; }
    PG8_BAR;
#undef PG8_SA
#undef PG8_SB
#undef PG8_GLDS
#undef PG8_STAGE
#undef PG8_STAGE_A
#undef PG8_MAP
#undef PG8_LDA
#undef PG8_LD16
#undef PG8_LDB
#undef PG8_MMA
#undef PG8_CAT
#undef PG8_WAIT_V
#undef PG8_WAIT_L
#undef PG8_BAR
#undef PG8_SCHED
}
}
constexpr int NWAVES = 8;
constexpr int DM = 1024, NB = 8, SEQ = 4096, CTXL = 256;
constexpr int NLAT = NB * SEQ, NCTX = NB * CTXL, MALL = NLAT + NCTX;
constexpr int ACH = 512, BCH = 512, CONVK = 31, CHUNK = 128;
constexpr int DFF = 2816, NEXP = 8, DEXP = 3584;
constexpr int QRANK = 384, KVRANK = 256, ROPE = 64, INO = 704, INO_PAD = 768, NHEAD = 8, QKD = 192, VHD = 128;
constexpr int SKV = CTXL + SEQ;
constexpr float EPS = 1e-6f;
constexpr float ATTN_SCALE = 0.07216878364870322f;
constexpr int LIST_CAP = NLAT;
constexpr int XROWS = 2 * NLAT + NEXP * 256;
constexpr int SC_W13 = 127 - 5, SC_W2 = 127 - 6;
constexpr int MODW = 6 * DM;

constexpr size_t MiB = 1u << 20;
constexpr size_t WS_CTL = 0, CTL_ZERO_BYTES = 1 * MiB;
constexpr size_t WS_MOD = 1 * MiB;
constexpr size_t WS_ROPE = 1 * MiB + 512 * 1024;
constexpr size_t WS_TOKG = 1 * MiB + 768 * 1024;
constexpr size_t WS_LIST = 2 * MiB;
constexpr size_t WS_WIN = 4 * MiB, WS_WOUT = 8 * MiB, WS_W13 = 10 * MiB, WS_W2 = 21 * MiB, WS_WINO = 27 * MiB, WS_WUQ = 29 * MiB, WS_WUKV = 31 * MiB, WS_WO = 32 * MiB;
constexpr size_t WS_WSB = 3 * MiB;
constexpr size_t WS_EW13 = 34 * MiB, WS_EW2 = 90 * MiB, WS_ARENA = 118 * MiB;
static_assert(WS_W2 + (size_t)DM * DFF * 2 <= WS_WINO && WS_WINO + (size_t)INO_PAD * DM * 2 <= WS_WUQ && WS_WUQ + (size_t)1536 * QRANK * 2 <= WS_WUKV && WS_WUKV + (size_t)2048 * KVRANK * 2 <= WS_WO && WS_WO + (size_t)DM * DM * 2 <= 34 * MiB && WS_LIST + (size_t)NEXP * LIST_CAP * 4 <= WS_WSB, "weight map");
static_assert(WS_EW13 + (size_t)NEXP * 2 * DEXP * DM == WS_EW2 && WS_EW2 + (size_t)NEXP * DM * DEXP == WS_ARENA, "expert weight map");
constexpr size_t AR_XC = 0, AR_H = 8, AR_AG = 76, AR_UG = 110, AR_VG = 144, AR_ACT = 76, AR_Z = 76, AR_QN = 127, AR_KVN = 151, AR_KPE = 168, AR_Q = 173, AR_KN = 0, AR_V = 269, AR_ATT = 68;
constexpr size_t AR_H4 = 0, AR_Y = 32, AR_ACTE = 160, AR_END = 392;
constexpr size_t WS_END = WS_ARENA + AR_END * MiB;
static_assert(AR_ACT * MiB + (size_t)MALL * DFF * 2 <= AR_V * MiB && AR_ACTE * MiB + (size_t)XROWS * DEXP <= AR_END * MiB && (AR_V + 68) <= AR_END, "arena");
constexpr int CW_TMO = 0, CW_CODE = 1, CW_BAR = 4096, CW_CNT = 16384;

constexpr int RING_OFF = 0, RING_BYTES = 139264;
constexpr int LDSCTL_OFF = RING_BYTES, MISC_OFF = LDSCTL_OFF + 320, MOET_OFF = LDSCTL_OFF + 512;
constexpr int LDS_BYTES = 147456;

#define GAS __attribute__((address_space(1)))
#define LAS __attribute__((address_space(3)))
typedef unsigned short bf16;
typedef unsigned v4u __attribute__((ext_vector_type(4)));
typedef unsigned v2u __attribute__((ext_vector_type(2)));
typedef float f32x4 __attribute__((ext_vector_type(4)));
typedef float f32x2 __attribute__((ext_vector_type(2)));
typedef short bf16x8 __attribute__((ext_vector_type(8)));
typedef GAS unsigned gu32;
#define RLX_AGENT __ATOMIC_RELAXED, __HIP_MEMORY_SCOPE_AGENT
#define LDS_WAIT() asm volatile("s_waitcnt lgkmcnt(0)" ::: "memory")
#define VM_WAIT() asm volatile("s_waitcnt vmcnt(0)" ::: "memory")
using pg8::cvt_pk_bf16; using pg8::pack8;
__device__ __forceinline__ float bf_lo(unsigned w) { return __builtin_bit_cast(float, w << 16); }
__device__ __forceinline__ float bf_hi(unsigned w) { return __builtin_bit_cast(float, w & 0xffff0000u); }
__device__ __forceinline__ unsigned pk_fp8x4(float a, float b, float c, float d) { int w = 0; w = __builtin_amdgcn_cvt_pk_fp8_f32(a, b, w, false); w = __builtin_amdgcn_cvt_pk_fp8_f32(c, d, w, true); return (unsigned)w; }
__device__ __forceinline__ float fsigmoid(float x) { return __builtin_amdgcn_rcpf(1.0f + __builtin_amdgcn_exp2f(-1.4426950408889634f * x)); }
__device__ __forceinline__ float fsilu(float x) { return x * fsigmoid(x); }
__device__ __forceinline__ float fgelu(float x) { const float u = 0.7978845608028654f * (x + 0.044715f * x * x * x); return x * fsigmoid(2.0f * u); }
template <int K> __device__ __forceinline__ float lane_xor(float v) { return __builtin_bit_cast(float, __builtin_amdgcn_ds_swizzle(__builtin_bit_cast(int, v), (K << 10) | 0x1f)); }
__device__ __forceinline__ float wave_sum(float v) {
    v += lane_xor<1>(v); v += lane_xor<2>(v); v += lane_xor<4>(v); v += lane_xor<8>(v); v += lane_xor<16>(v);
    return __builtin_bit_cast(float, __builtin_amdgcn_readlane(__builtin_bit_cast(int, v), 0)) + __builtin_bit_cast(float, __builtin_amdgcn_readlane(__builtin_bit_cast(int, v), 32));
}

#define XB_TMO      128
#define XB_XCNT(j)  (256  + 64 * (j))
#define XB_XSUB(j)  (1280 + 64 * (j))
#define XB_XGEN(j)  (2304 + 64 * (j))
#define XB_TOP      3328
#define XB_TOPGEN   3392
#define XCD_BAR_WORDS 3456
#define XB_SPIN_CAP (1u << 18)

__device__ __forceinline__ unsigned xb_ld(unsigned* p)              { return __hip_atomic_load(p, __ATOMIC_RELAXED, __HIP_MEMORY_SCOPE_AGENT); }
__device__ __forceinline__ unsigned xb_add(unsigned* p, unsigned v) { return __hip_atomic_fetch_add(p, v, __ATOMIC_RELAXED, __HIP_MEMORY_SCOPE_AGENT); }
__device__ __forceinline__ unsigned xb_xcc_id() { return (unsigned)__builtin_amdgcn_s_getreg((3 << 11) | 20) & 0xFu; }
#define XB_SPIN(cond, bar) do { unsigned _sp = 0; while (cond) { __builtin_amdgcn_s_sleep(1); \
    if ((++_sp & 255u) == 0u) { if (xb_ld(&(bar)[XB_TMO])) break; if (_sp > XB_SPIN_CAP) { atomicAdd(&(bar)[XB_TMO], 1u); break; } } } } while (0)

struct XcdBarrier {
    unsigned* bar; unsigned x;
    volatile LAS unsigned* st;
};

__device__ __forceinline__ XcdBarrier xcd_barrier_post(unsigned* bar, volatile LAS unsigned* st) {
    XcdBarrier b; b.bar = bar; b.x = xb_xcc_id(); b.st = st;
    if (threadIdx.x == 0) (void)xb_add(&bar[XB_XCNT(b.x)], 1u);
    return b;
}
__device__ __forceinline__ void xcd_barrier_complete(unsigned* bar, unsigned x, unsigned& nloc, unsigned& nx) {
    const unsigned G = gridDim.x * gridDim.y * gridDim.z;
    unsigned sum, cnt, mine, sp = 0u;
    for (;;) {
        sum = 0u; cnt = 0u; mine = 0u;
#pragma unroll
        for (unsigned j = 0; j < 16; ++j) { const unsigned c = xb_ld(&bar[XB_XCNT(j)]); sum += c; cnt += (c > 0u) ? 1u : 0u; mine = (j == x) ? c : mine; }
        if (sum == G) break;
        __builtin_amdgcn_s_sleep(1);
        if ((++sp & 255u) == 0u) { if (xb_ld(&bar[XB_TMO])) break; if (sp > XB_SPIN_CAP) { atomicAdd(&bar[XB_TMO], 1u); break; } }
    }
    nloc = mine > 0u ? mine : 1u; nx = cnt > 0u ? cnt : 1u;
}

__device__ __forceinline__ void xcd_barrier(const XcdBarrier& b, int wave_id) {
    const bool t0 = (wave_id == 0) && (fresh_lane() == 0);
    asm volatile("s_waitcnt vmcnt(0)" ::: "memory");
    __syncthreads();
    if (t0) {
        unsigned* bar = b.bar;
        __builtin_amdgcn_s_waitcnt(0);
        unsigned nloc = b.st[0], nx = b.st[1];
        if (nloc == 0u) { xcd_barrier_complete(bar, b.x, nloc, nx); b.st[0] = nloc; b.st[1] = nx; }
        const unsigned old = xb_add(&bar[XB_XSUB(b.x)], 1u);
        const unsigned gen = old / nloc;
        if (old + 1u == (gen + 1u) * nloc) {
            __builtin_amdgcn_fence(__ATOMIC_RELEASE, "agent");
            asm volatile("s_waitcnt vmcnt(0)" ::: "memory");
            const unsigned og = xb_add(&bar[XB_TOP], 1u);
            const unsigned tg = og / nx;
            if (og + 1u == (tg + 1u) * nx) xb_add(&bar[XB_TOPGEN], 1u);
            else XB_SPIN(xb_ld(&bar[XB_TOPGEN]) == tg, bar);
            __builtin_amdgcn_fence(__ATOMIC_ACQUIRE, "agent");
            xb_add(&bar[XB_XGEN(b.x)], 1u);
            asm volatile("s_waitcnt vmcnt(0)" ::: "memory");
        } else {
            XB_SPIN(xb_ld(&bar[XB_XGEN(b.x)]) == gen, bar);
            __builtin_amdgcn_fence(__ATOMIC_ACQUIRE, "agent");
            asm volatile("s_waitcnt vmcnt(0)" ::: "memory");
        }
    }
    __syncthreads();
}
namespace epi {
using pg8::Unit; using pg8::f32x4; using pg8::u32x4; using pg8::bf16_t; using pg8::HALF; using pg8::BM;
#define EPI_ST16(base, off, val) (*(u32x4*)((char*)(base) + (unsigned)(off)) = (val))
struct EpiMixIn {
    static constexpr bool PERM = true;
    bf16_t *AG, *UG, *VG;
    __device__ __forceinline__ void operator()(const f32x4 (&acc)[2][2][4][2], const Unit& u, int wr, int wc, int fr, int fq) const {
        const int cw = wc * 32 + 8 * fq;
        if (u.pn < 4) {
            char* tb = (char*)(AG + (size_t)u.pm * (BM * ACH)); const unsigned lo = (unsigned)((wr * 64 + fr) * ACH + u.pn * 128 + cw) * 2u;
#pragma unroll
            for (int ai = 0; ai < 2; ++ai)
#pragma unroll
                for (int m = 0; m < 4; ++m) { f32x4 o0, o1;
#pragma unroll
                    for (int e = 0; e < 4; ++e) { o0[e] = acc[ai][0][m][0][e] * fsigmoid(acc[ai][1][m][0][e]); o1[e] = acc[ai][0][m][1][e] * fsigmoid(acc[ai][1][m][1][e]); }
                    EPI_ST16(tb + (ai * HALF + m * 16) * ACH * 2, lo, pack8(o0, o1)); }
        } else {
            char* tb = (char*)(((u.pn < 6) ? UG : VG) + (size_t)u.pm * (BM * BCH)); const unsigned lo = (unsigned)((wr * 64 + fr) * BCH + (u.pn & 1) * 256 + cw) * 2u;
#pragma unroll
            for (int ai = 0; ai < 2; ++ai)
#pragma unroll
                for (int m = 0; m < 4; ++m)
#pragma unroll
                    for (int bj = 0; bj < 2; ++bj) { f32x4 o0, o1;
#pragma unroll
                        for (int e = 0; e < 4; ++e) { o0[e] = fgelu(acc[ai][bj][m][0][e]); o1[e] = fgelu(acc[ai][bj][m][1][e]); }
                        EPI_ST16(tb + ((ai * HALF + m * 16) * BCH + bj * HALF) * 2, lo, pack8(o0, o1)); }
        }
    }
};
struct EpiSwiGlu {
    static constexpr bool PERM = true;
    bf16_t* O; int ldc, npn;
    __device__ __forceinline__ void operator()(const f32x4 (&acc)[2][2][4][2], const Unit& u, int wr, int wc, int fr, int fq) const {
        char* tb = (char*)(O + (size_t)u.pm * BM * ldc); const unsigned lo = (unsigned)((wr * 64 + fr) * ldc + (u.pn % npn) * 128 + wc * 32 + 8 * fq) * 2u;
#pragma unroll
        for (int ai = 0; ai < 2; ++ai)
#pragma unroll
            for (int m = 0; m < 4; ++m) { f32x4 o0, o1;
#pragma unroll
                for (int e = 0; e < 4; ++e) { o0[e] = fsilu(acc[ai][0][m][0][e]) * acc[ai][1][m][0][e]; o1[e] = fsilu(acc[ai][0][m][1][e]) * acc[ai][1][m][1][e]; }
                EPI_ST16(tb + (size_t)(ai * HALF + m * 16) * ldc * 2, lo, pack8(o0, o1)); }
    }
};
struct EpiSwiGluF8 {
    static constexpr bool PERM = true;
    unsigned char* O; int ldc, npn;
    __device__ __forceinline__ void operator()(const f32x4 (&acc)[2][2][4][2], const Unit& u, int wr, int wc, int fr, int fq) const {
        char* tb = (char*)(O + (size_t)u.pm * BM * ldc); const unsigned lo = (unsigned)((wr * 64 + fr) * ldc + (u.pn % npn) * 128 + wc * 32 + 8 * fq);
#pragma unroll
        for (int ai = 0; ai < 2; ++ai)
#pragma unroll
            for (int m = 0; m < 4; ++m) { f32x4 o0, o1;
#pragma unroll
                for (int e = 0; e < 4; ++e) { o0[e] = fsilu(acc[ai][0][m][0][e]) * acc[ai][1][m][0][e]; o1[e] = fsilu(acc[ai][0][m][1][e]) * acc[ai][1][m][1][e]; }
                v2u w; w.x = pk_fp8x4(o0[0], o0[1], o0[2], o0[3]); w.y = pk_fp8x4(o1[0], o1[1], o1[2], o1[3]);
                *(v2u*)(tb + (size_t)(ai * HALF + m * 16) * ldc + lo) = w; }
    }
};
struct EpiPlain {
    static constexpr bool PERM = true;
    bf16_t* O; int ldc;
    __device__ __forceinline__ void operator()(const f32x4 (&acc)[2][2][4][2], const Unit& u, int wr, int wc, int fr, int fq) const {
        char* tb = (char*)(O + (size_t)u.pm * BM * ldc + u.pn * BM); const unsigned lo = (unsigned)((wr * 64 + fr) * ldc + wc * 32 + 8 * fq) * 2u;
#pragma unroll
        for (int ai = 0; ai < 2; ++ai)
#pragma unroll
            for (int m = 0; m < 4; ++m)
#pragma unroll
                for (int bj = 0; bj < 2; ++bj) EPI_ST16(tb + ((size_t)(ai * HALF + m * 16) * ldc + bj * HALF) * 2, lo, pack8(acc[ai][bj][m][0], acc[ai][bj][m][1]));
    }
};
struct EpiResid {
    static constexpr bool PERM = false;
    const float *srcL, *srcC; float *dstL, *dstC; const float* gate; float mul;
    __device__ __forceinline__ void operator()(const f32x4 (&acc)[2][2][4][2], const Unit& u, int wr, int wc, int fr, int fq) const {
        const bool lat = u.pm < NLAT / BM; const int bi = lat ? (u.pm >> 4) : 8;
        const size_t tb = (size_t)(lat ? u.pm : u.pm - NLAT / BM) * (BM * DM) + u.pn * BM;
        const char* src = (const char*)((lat ? srcL : srcC) + tb); char* dst = (char*)((lat ? dstL : dstC) + tb); const float* gp = gate + bi * MODW + u.pn * BM;
        const unsigned lo = (unsigned)((wr * 64 + fr) * DM + wc * 32 + 4 * fq) * 4u, lg = (unsigned)(wc * 32 + 4 * fq) * 4u;
        f32x4 gv[2][2];
#pragma unroll
        for (int bj = 0; bj < 2; ++bj)
#pragma unroll
            for (int n = 0; n < 2; ++n) gv[bj][n] = *(const f32x4*)((const char*)gp + (bj * HALF + n * 16) * 4 + lg) * mul;
#pragma unroll
        for (int ai = 0; ai < 2; ++ai)
#pragma unroll
            for (int m = 0; m < 4; ++m) {
#pragma unroll
                for (int bj = 0; bj < 2; ++bj)
#pragma unroll
                    for (int n = 0; n < 2; ++n) { const int co = ((ai * HALF + m * 16) * DM + bj * HALF + n * 16) * 4;
                        const f32x4 bs = *(const f32x4*)(src + co + lo); *(f32x4*)(dst + co + lo) = bs + gv[bj][n] * acc[ai][bj][m][n]; }
                if (m & 1) asm volatile("" ::: "memory"); }
    }
};
struct EpiQ {
    static constexpr bool PERM = true;
    bf16_t* Q; const float* rope;
    __device__ __forceinline__ void operator()(const f32x4 (&acc)[2][2][4][2], const Unit& u, int wr, int wc, int fr, int fq) const {
        const int b = u.pm >> 4, t0 = (u.pm & 15) * BM, rl = wr * 64 + fr;
        if (u.pn < 4) {
#pragma unroll
            for (int bj = 0; bj < 2; ++bj) { char* tb = (char*)(Q + ((size_t)(b * NHEAD + 2 * u.pn + bj) * SEQ + t0) * QKD); const unsigned lo = (unsigned)(rl * QKD + wc * 32 + 8 * fq) * 2u;
#pragma unroll
                for (int ai = 0; ai < 2; ++ai)
#pragma unroll
                    for (int m = 0; m < 4; ++m) EPI_ST16(tb + (ai * HALF + m * 16) * QKD * 2, lo, pack8(acc[ai][bj][m][0], acc[ai][bj][m][1])); }
        } else {
            const int h = 4 * (u.pn - 4) + wc, a = fq >> 1, f0 = 8 * (fq & 1);
            char* tb = (char*)(Q + ((size_t)(b * NHEAD + h) * SEQ + t0) * QKD + 128); const unsigned lo = (unsigned)(rl * QKD + a * 32 + f0) * 2u;
#pragma unroll
            for (int ai = 0; ai < 2; ++ai)
#pragma unroll
                for (int m = 0; m < 4; ++m) { const int t = t0 + rl + ai * HALF + m * 16, pos = a ? (t & 63) : (t >> 6);
                    const char* cs = (const char*)rope + (unsigned)((pos * 16 + f0) * 8); f32x4 o1[2], o2[2];
#pragma unroll
                    for (int n = 0; n < 2; ++n) { const f32x4 c0 = *(const f32x4*)(cs + n * 32), c1 = *(const f32x4*)(cs + n * 32 + 16);
                        const f32x4 x1 = acc[ai][0][m][n], x2 = acc[ai][1][m][n];
                        o1[n][0] = x1[0] * c0[0] - x2[0] * c0[1]; o2[n][0] = x1[0] * c0[1] + x2[0] * c0[0];
                        o1[n][1] = x1[1] * c0[2] - x2[1] * c0[3]; o2[n][1] = x1[1] * c0[3] + x2[1] * c0[2];
                        o1[n][2] = x1[2] * c1[0] - x2[2] * c1[1]; o2[n][2] = x1[2] * c1[1] + x2[2] * c1[0];
                        o1[n][3] = x1[3] * c1[2] - x2[3] * c1[3]; o2[n][3] = x1[3] * c1[3] + x2[3] * c1[2]; }
                    EPI_ST16(tb + (ai * HALF + m * 16) * QKD * 2, lo, pack8(o1[0], o1[1])); EPI_ST16(tb + (ai * HALF + m * 16) * QKD * 2 + 32, lo, pack8(o2[0], o2[1]));
                    asm volatile("" ::: "memory"); }
        }
    }
};
struct EpiKV {
    static constexpr bool PERM = true;
    bf16_t *KN, *V;
    __device__ __forceinline__ void operator()(const f32x4 (&acc)[2][2][4][2], const Unit& u, int wr, int wc, int fr, int fq) const {
        const bool lat = u.pm < NLAT / BM; const int b = lat ? (u.pm >> 4) : (u.pm - NLAT / BM), key0 = lat ? CTXL + (u.pm & 15) * BM : 0;
        const size_t te = ((size_t)(b * NHEAD + u.pn) * SKV + key0) * VHD; char* kb = (char*)(KN + te); char* vb = (char*)(V + te);
        const unsigned lo = (unsigned)((wr * 64 + fr) * VHD + wc * 32 + 8 * fq) * 2u;
#pragma unroll
        for (int ai = 0; ai < 2; ++ai)
#pragma unroll
            for (int m = 0; m < 4; ++m) { EPI_ST16(kb + (ai * HALF + m * 16) * VHD * 2, lo, pack8(acc[ai][0][m][0], acc[ai][0][m][1])); EPI_ST16(vb + (ai * HALF + m * 16) * VHD * 2, lo, pack8(acc[ai][1][m][0], acc[ai][1][m][1])); }
    }
};
struct EpiMoeDown {
    static constexpr bool PERM = true;
    bf16_t* Y; const unsigned* list; const LAS int* tab;
    __device__ __forceinline__ void operator()(const f32x4 (&acc)[2][2][4][2], const Unit& u, int wr, int wc, int fr, int fq) const {
        const int e = u.pn >> 2, pnl = u.pn & 3, cnt = tab[16 + e], s0 = (u.pm - tab[e]) * BM + wr * 64 + fr; const unsigned cb = (unsigned)(pnl * BM + wc * 32 + 8 * fq) * 2u;
        const char* lp = (const char*)(list + e * LIST_CAP);
#pragma unroll
        for (int ai = 0; ai < 2; ++ai)
#pragma unroll
            for (int m = 0; m < 4; ++m) { const int slot = s0 + ai * HALF + m * 16;
                if (slot < cnt) { const unsigned ent = *(const unsigned*)(lp + (unsigned)slot * 4u), ro = ent * (unsigned)(DM * 2) + cb;
#pragma unroll
                    for (int bj = 0; bj < 2; ++bj) EPI_ST16(Y, ro + bj * HALF * 2, pack8(acc[ai][bj][m][0], acc[ai][bj][m][1])); } }
    }
};
}
struct MoeOrder {
    pg8::StaticOrder so; int nN; const LAS int* tab; const unsigned* list; int tok0;
    __device__ __forceinline__ bool next(int i, pg8::Unit& u) const {
        if (!so.next(i, u)) return false;
        int e = 0;
#pragma unroll
        for (int k = 1; k < NEXP; ++k) e += (u.pm >= tab[k]) ? 1 : 0;
        u.pn += e * nN; return true;
    }
    __device__ __forceinline__ int arow(const pg8::Unit& u, int r) const {
        const int e = u.pn / nN, cnt = tab[16 + e], slot = (u.pm - tab[e]) * pg8::BM + r;
        const unsigned ent = list[e * LIST_CAP + (slot < cnt ? slot : 0)];
        return tok0 + (int)(ent >> 1);
    }
};
struct Args { const float* in[31]; float* out; unsigned char* ws; };
struct Frame {
    LAS unsigned char* lds; volatile LAS unsigned* MISC; gu32* ctl;
    int tid, lane, wave, vcu, G;
};
enum { I_X = 0, I_C, I_CTX, I_CCTX, I_WADA, I_BADA, I_NORMG, I_EWIN, I_CONVW, I_CONVB, I_LNAG, I_LNAB, I_LNVG, I_LNVB, I_WS, I_BS, I_EWOUT, I_FW1, I_FW3, I_FW2,
       I_OWIN, I_GQ, I_GKV, I_WUQ, I_WUKV, I_WO, I_ROUTER, I_XW1, I_XW3, I_XW2, I_FINALG };

struct MapId   { int off; __device__ __forceinline__ int operator()(int n) const { return off + n; } };
struct MapPair { int half; __device__ __forceinline__ int operator()(int n) const { return 256 * (n >> 7) + 128 * half + (n & 127); } };
struct MapMixIn { __device__ __forceinline__ int operator()(int n) const { if (n >= 1024) return n; const int j = n & 511, hf = n >> 9; return 256 * (j >> 7) + 128 * hf + (j & 127); } };
struct MapUq { __device__ __forceinline__ int operator()(int n) const { const int h = n / QKD, d = n - h * QKD; if (d < 128) return h * 128 + d;
    const int dd = d - 128, a = dd >> 5, p = (dd >> 4) & 1, f = dd & 15; return 1024 + 256 * (h >> 2) + 128 * p + (h & 3) * 32 + a * 16 + f; } };
template <class Map>
__device__ __forceinline__ void p0_transpose_item(const float* W, int K, int N, bf16* WT, const Map& map, LAS float* scr, int item, int lane) {
    const int nblk = N / 32, kb = item / nblk, nb = item - kb * nblk, k0 = 64 * kb, n0 = 32 * nb;
#pragma unroll 8
    for (int i = 0; i < 32; ++i) { const int kk = 2 * i + (lane >> 5); scr[kk * 33 + (lane & 31)] = W[(size_t)(k0 + kk) * N + n0 + (lane & 31)]; }
    LDS_WAIT(); asm volatile("" ::: "memory");
    const int c = lane & 7;
#pragma unroll
    for (int j = 0; j < 4; ++j) { const int n = (lane >> 3) + 8 * j; const LAS float* s = scr + (8 * c) * 33 + n;
        v4u o; o.x = cvt_pk_bf16(s[0 * 33], s[1 * 33]); o.y = cvt_pk_bf16(s[2 * 33], s[3 * 33]); o.z = cvt_pk_bf16(s[4 * 33], s[5 * 33]); o.w = cvt_pk_bf16(s[6 * 33], s[7 * 33]);
        *(GAS v4u*)(WT + (size_t)map(n0 + n) * K + k0 + 8 * c) = o; }
    LDS_WAIT(); asm volatile("" ::: "memory");
}
template <class Map>
__device__ __forceinline__ void p0_transpose_item_f8(const float* W, int K, int N, unsigned char* WT, const Map& map, float mul, LAS float* scr, int item, int lane) {
    const int nblk = N / 32, kb = item / nblk, nb = item - kb * nblk, k0 = 64 * kb, n0 = 32 * nb;
#pragma unroll 8
    for (int i = 0; i < 32; ++i) { const int kk = 2 * i + (lane >> 5); scr[kk * 33 + (lane & 31)] = W[(size_t)(k0 + kk) * N + n0 + (lane & 31)] * mul; }
    LDS_WAIT(); asm volatile("" ::: "memory");
#pragma unroll
    for (int j = 0; j < 2; ++j) { const int idx = lane + 64 * j, n = idx >> 2, c = idx & 3; const LAS float* s = scr + (16 * c) * 33 + n;
        v4u o; o.x = pk_fp8x4(s[0 * 33], s[1 * 33], s[2 * 33], s[3 * 33]); o.y = pk_fp8x4(s[4 * 33], s[5 * 33], s[6 * 33], s[7 * 33]);
        o.z = pk_fp8x4(s[8 * 33], s[9 * 33], s[10 * 33], s[11 * 33]); o.w = pk_fp8x4(s[12 * 33], s[13 * 33], s[14 * 33], s[15 * 33]);
        *(GAS v4u*)(WT + (size_t)map(n0 + n) * K + k0 + 16 * c) = o; }
    LDS_WAIT(); asm volatile("" ::: "memory");
}
__device__ __forceinline__ void sincos_d(double th, float& c, float& s) {
    const double q = __builtin_rint(th * 0.63661977236758134308); const int n = (int)q;
    const double r = (th - q * 1.5707963267948966192) - q * 6.123233995736766036e-17, r2 = r * r;
    double sp = -7.6471637318198164759e-13; sp = sp * r2 + 1.6059043836821614599e-10; sp = sp * r2 - 2.5052108385441718775e-08; sp = sp * r2 + 2.7557319223985890653e-06;
    sp = sp * r2 - 1.9841269841269841253e-04; sp = sp * r2 + 8.3333333333333332177e-03; sp = sp * r2 - 1.6666666666666665741e-01; const double sr = r + r * r2 * sp;
    double cp = 4.7794773323873852974e-14; cp = cp * r2 - 1.1470745597729724714e-11; cp = cp * r2 + 2.0876756987868098979e-09; cp = cp * r2 - 2.7557319223985888e-07;
    cp = cp * r2 + 2.4801587301587301566e-05; cp = cp * r2 - 1.3888888888888889419e-03; cp = cp * r2 + 4.1666666666666664354e-02; const double cr = 1.0 - 0.5 * r2 + r2 * r2 * cp;
    const int k = n & 3; const double sv = (k == 0) ? sr : (k == 1) ? cr : (k == 2) ? -sr : -cr, cv = (k == 0) ? cr : (k == 1) ? -sr : (k == 2) ? -cr : sr;
    c = (float)cv; s = (float)sv;
}
__device__ __forceinline__ double inv_freq_d(int f) {
    const int q = f >> 2, r = f & 3; const double rr = (r == 0) ? 1.0 : (r == 1) ? 0.5623413251903491 : (r == 2) ? 0.31622776601683794 : 0.1778279410038923;
    const double qq = (q == 0) ? 1.0 : (q == 1) ? 0.1 : (q == 2) ? 0.01 : 0.001; return rr * qq;
}
__device__ __forceinline__ void p0_prologue(Frame& F, const Args& A) {
    unsigned char* ws = A.ws;
    {
        LAS float* sv = (LAS float*)(F.lds + RING_OFF);
        LAS float* part = (LAS float*)(F.lds + RING_OFF + 9 * 1024 * 4);
        for (int i = F.tid; i < 9 * DM; i += NWAVES * 64) { const float v = (i < 8 * DM) ? A.in[I_C][i] : A.in[I_CCTX][i - 8 * DM]; sv[i] = fsilu(v); }
        __syncthreads();
        float* mod = (float*)(ws + WS_MOD);
        for (int it = F.vcu; it < 2 * MODW / 48; it += F.G) {
            const int l = it / (MODW / 48), j0 = (it - l * (MODW / 48)) * 48;
            const float* W = A.in[I_WADA] + (size_t)l * DM * MODW;
            if (F.tid < 480) { const int cc = F.tid % 48, ks = F.tid / 48, kbeg = ks * 103, kend = (kbeg + 103 < DM) ? kbeg + 103 : DM;
                float a[9];
#pragma unroll
                for (int b = 0; b < 9; ++b) a[b] = 0.f;
                for (int k = kbeg; k < kend; ++k) { const float w = W[(size_t)k * MODW + j0 + cc];
#pragma unroll
                    for (int b = 0; b < 9; ++b) a[b] += sv[b * DM + k] * w; }
#pragma unroll
                for (int b = 0; b < 9; ++b) part[(ks * 9 + b) * 48 + cc] = a[b]; }
            __syncthreads();
            if (F.tid < 9 * 48) { const int b = F.tid / 48, cc = F.tid % 48; float s = A.in[I_BADA][l * MODW + j0 + cc];
#pragma unroll
                for (int ks = 0; ks < 10; ++ks) s += part[(ks * 9 + b) * 48 + cc];
                mod[(size_t)(l * 9 + b) * MODW + j0 + cc] = s; }
            __syncthreads();
        }
    }
    if (F.vcu == 0) for (int i = F.tid; i < 64 * 16; i += NWAVES * 64) { float c, s; sincos_d((double)(i >> 4) * inv_freq_d(i & 15), c, s); ((float*)(ws + WS_ROPE))[2 * i] = c; ((float*)(ws + WS_ROPE))[2 * i + 1] = s; }
    { const int gt = F.vcu * NWAVES * 64 + F.tid, NT = F.G * NWAVES * 64;
      for (int i = gt; i < NEXP * CHUNK * CHUNK / 4; i += NT) { const f32x4 v = ((const f32x4*)A.in[I_WS])[i]; v2u o; o.x = cvt_pk_bf16(v[0], v[1]); o.y = cvt_pk_bf16(v[2], v[3]); ((v2u*)(ws + WS_WSB))[i] = o; }
      for (int i = gt; i < (INO_PAD - INO) * DM * 2 / 16; i += NT) ((v4u*)(ws + WS_WINO + (size_t)INO * DM * 2))[i] = (v4u){0u, 0u, 0u, 0u}; }
    __syncthreads();
    LAS float* scr = (LAS float*)(F.lds + RING_OFF + F.wave * 16384);
    const int gw = F.vcu * NWAVES + F.wave, NGW = F.G * NWAVES;
#define ITEMS(K_, N_) (((K_) / 64) * ((N_) / 32))
    constexpr int I_1 = ITEMS(DM, 2048), I_2 = ITEMS(DM, DM), I_3 = ITEMS(DM, DFF), I_4 = ITEMS(DFF, DM), I_5 = ITEMS(DM, INO), I_6 = ITEMS(QRANK, 1536), I_7 = ITEMS(KVRANK, 2048), I_8 = ITEMS(DM, DM);
    constexpr int I_E1 = ITEMS(DM, DEXP), I_E2 = ITEMS(DEXP, DM);
    constexpr int NITEMS = I_1 + I_2 + 2 * I_3 + I_4 + I_5 + I_6 + I_7 + I_8 + NEXP * (2 * I_E1 + I_E2);
    for (int it = gw; it < NITEMS; it += NGW) {
        int r = it;
        if (r < I_1) { p0_transpose_item(A.in[I_EWIN], DM, 2048, (bf16*)(ws + WS_WIN), MapMixIn{}, scr, r, F.lane); continue; } r -= I_1;
        if (r < I_2) { p0_transpose_item(A.in[I_EWOUT], DM, DM, (bf16*)(ws + WS_WOUT), MapId{0}, scr, r, F.lane); continue; } r -= I_2;
        if (r < I_3) { p0_transpose_item(A.in[I_FW1], DM, DFF, (bf16*)(ws + WS_W13), MapPair{0}, scr, r, F.lane); continue; } r -= I_3;
        if (r < I_3) { p0_transpose_item(A.in[I_FW3], DM, DFF, (bf16*)(ws + WS_W13), MapPair{1}, scr, r, F.lane); continue; } r -= I_3;
        if (r < I_4) { p0_transpose_item(A.in[I_FW2], DFF, DM, (bf16*)(ws + WS_W2), MapId{0}, scr, r, F.lane); continue; } r -= I_4;
        if (r < I_5) { p0_transpose_item(A.in[I_OWIN], DM, INO, (bf16*)(ws + WS_WINO), MapId{0}, scr, r, F.lane); continue; } r -= I_5;
        if (r < I_6) { p0_transpose_item(A.in[I_WUQ], QRANK, 1536, (bf16*)(ws + WS_WUQ), MapUq{}, scr, r, F.lane); continue; } r -= I_6;
        if (r < I_7) { p0_transpose_item(A.in[I_WUKV], KVRANK, 2048, (bf16*)(ws + WS_WUKV), MapId{0}, scr, r, F.lane); continue; } r -= I_7;
        if (r < I_8) { p0_transpose_item(A.in[I_WO], DM, DM, (bf16*)(ws + WS_WO), MapId{0}, scr, r, F.lane); continue; } r -= I_8;
        { const int per = 2 * I_E1 + I_E2, e = r / per; r -= e * per;
          if (r < I_E1) { p0_transpose_item_f8(A.in[I_XW1] + (size_t)e * DM * DEXP, DM, DEXP, ws + WS_EW13 + (size_t)e * 2 * DEXP * DM, MapPair{0}, 32.0f, scr, r, F.lane); continue; } r -= I_E1;
          if (r < I_E1) { p0_transpose_item_f8(A.in[I_XW3] + (size_t)e * DM * DEXP, DM, DEXP, ws + WS_EW13 + (size_t)e * 2 * DEXP * DM, MapPair{1}, 32.0f, scr, r, F.lane); continue; } r -= I_E1;
          p0_transpose_item_f8(A.in[I_XW2] + (size_t)e * DEXP * DM, DEXP, DM, ws + WS_EW2 + (size_t)e * DM * DEXP, MapId{0}, 64.0f, scr, r, F.lane); }
    }
#undef ITEMS
}

template <bool ROUTE>
__device__ __forceinline__ void norm_phase(Frame& F, const Args& A, const float* srcL, const float* srcC, int nrows, const float* g, const float* modl, int shift_slot, bf16* H) {
    LAS float* rt = (LAS float*)(F.lds + RING_OFF);
    if constexpr (ROUTE) { for (int i = F.tid; i < DM * NEXP; i += NWAVES * 64) { const int k = i >> 3, e = i & 7; rt[e * DM + k] = A.in[I_ROUTER][i]; } __syncthreads(); }
    const int gw = F.vcu * NWAVES + F.wave, NGW = F.G * NWAVES;
    for (int row = gw; row < nrows; row += NGW) {
        const bool lat = row < NLAT; const float* src = lat ? srcL + (size_t)row * DM : srcC + (size_t)(row - NLAT) * DM; const int bi = lat ? (row >> 12) : 8;
        const float* sh = modl + bi * MODW + shift_slot * DM; const float* sc = sh + DM;
        f32x4 v[4]; float ss = 0.f;
#pragma unroll
        for (int j = 0; j < 4; ++j) { v[j] = ((const f32x4*)src)[F.lane + 64 * j]; ss += (v[j][0] * v[j][0] + v[j][1] * v[j][1]) + (v[j][2] * v[j][2] + v[j][3] * v[j][3]); }
        const float r = 1.0f / sqrtf(wave_sum(ss) * (1.0f / DM) + EPS);
        float lg[NEXP];
        if constexpr (ROUTE) {
#pragma unroll
            for (int e = 0; e < NEXP; ++e) lg[e] = 0.f; }
#pragma unroll
        for (int j = 0; j < 4; ++j) { const int c = 4 * F.lane + 256 * j; const f32x4 gv = *(const f32x4*)(g + c), s1 = *(const f32x4*)(sc + c), s0 = *(const f32x4*)(sh + c);
            const f32x4 y = (v[j] * r) * gv * (s1 + 1.0f) + s0;
            if constexpr (ROUTE) {
#pragma unroll
                for (int e = 0; e < NEXP; ++e) { const f32x4 w = *(const LAS f32x4*)(rt + e * DM + c); lg[e] += (y[0] * w[0] + y[1] * w[1]) + (y[2] * w[2] + y[3] * w[3]); } }
            if constexpr (ROUTE) { *(unsigned*)((unsigned char*)H + (size_t)row * DM + c) = pk_fp8x4(y[0], y[1], y[2], y[3]); }
            else { v2u o; o.x = cvt_pk_bf16(y[0], y[1]); o.y = cvt_pk_bf16(y[2], y[3]); *(v2u*)(H + (size_t)row * DM + c) = o; } }
        if constexpr (ROUTE) {
#pragma unroll
            for (int e = 0; e < NEXP; ++e) lg[e] = wave_sum(lg[e]);
            int i0 = 0; float v0 = lg[0];
#pragma unroll
            for (int e = 1; e < NEXP; ++e) if (lg[e] > v0) { v0 = lg[e]; i0 = e; }
            int i1 = -1; float v1 = -3.0e38f;
#pragma unroll
            for (int e = 0; e < NEXP; ++e) if (e != i0 && lg[e] > v1) { v1 = lg[e]; i1 = e; }
            if (F.lane == 0) {
                const float ex = __expf(v1 - v0), g0 = 1.0f / (1.0f + ex), g1 = ex * g0;
                unsigned* list = (unsigned*)(A.ws + WS_LIST);
                const unsigned p0 = __hip_atomic_fetch_add((unsigned*)F.ctl + CW_CNT + 64 * i0, 1u, RLX_AGENT);
                const unsigned p1 = __hip_atomic_fetch_add((unsigned*)F.ctl + CW_CNT + 64 * i1, 1u, RLX_AGENT);
                list[i0 * LIST_CAP + p0] = (unsigned)row * 2u; list[i1 * LIST_CAP + p1] = (unsigned)row * 2u + 1u;
                *(f32x2*)(A.ws + WS_TOKG + (size_t)row * 8) = (f32x2){g0, g1};
            }
        }
    }
}

__device__ __forceinline__ void mixmid_conv(Frame& F, const Args& A, int ch, int hf, const bf16* AG, bf16* A2) {
    const int R0 = ch * CHUNK + hf * 64;
    int s_lo, s_hi; if (R0 < NLAT) { s_lo = R0 & ~(SEQ - 1); s_hi = s_lo + SEQ; } else { s_lo = NLAT + ((R0 - NLAT) & ~(CTXL - 1)); s_hi = s_lo + CTXL; }
    const int p = (F.wave & 3) * 64 + F.lane, gq = F.wave >> 2;
    LAS float* red = (LAS float*)(F.lds + RING_OFF);
    float w0[CONVK], w1[CONVK];
#pragma unroll
    for (int k = 0; k < CONVK; ++k) { const f32x2 w = *(const f32x2*)(A.in[I_CONVW] + k * ACH + 2 * p); w0[k] = w[0]; w1[k] = w[1]; }
    const f32x2 cb = *(const f32x2*)(A.in[I_CONVB] + 2 * p), lg = *(const f32x2*)(A.in[I_LNAG] + 2 * p), lb = *(const f32x2*)(A.in[I_LNAB] + 2 * p);
#pragma unroll 1
    for (int it = 0; it < 4; ++it) {
        const int t0 = R0 + 8 * (gq + 2 * it);
        float o0[8], o1[8];
#pragma unroll
        for (int t = 0; t < 8; ++t) { o0[t] = cb[0]; o1[t] = cb[1]; }
#pragma unroll
        for (int i = 0; i < 38; ++i) { const int rr = t0 - 15 + i; const unsigned wv = (rr >= s_lo && rr < s_hi) ? *(const unsigned*)((const char*)(AG + (size_t)rr * ACH) + 4 * p) : 0u;
            const float x0 = bf_lo(wv), x1 = bf_hi(wv);
#pragma unroll
            for (int t = 0; t < 8; ++t) { const int k = i - t; if (k >= 0 && k < CONVK) { o0[t] += w0[k] * x0; o1[t] += w1[k] * x1; } }
            if ((i & 7) == 7) asm volatile("" ::: "memory"); }
        LAS float* rd = red + ((it & 1) * 2 + gq) * (4 * 8 * 2);
#pragma unroll
        for (int t = 0; t < 8; ++t) { const float s = wave_sum(o0[t] + o1[t]), q = wave_sum(o0[t] * o0[t] + o1[t] * o1[t]);
            if (F.lane == 0) { rd[((F.wave & 3) * 8 + t) * 2] = s; rd[((F.wave & 3) * 8 + t) * 2 + 1] = q; } }
        __syncthreads();
#pragma unroll
        for (int t = 0; t < 8; ++t) { float s = 0.f, q = 0.f;
#pragma unroll
            for (int w = 0; w < 4; ++w) { s += rd[(w * 8 + t) * 2]; q += rd[(w * 8 + t) * 2 + 1]; }
            const float mu = s * (1.0f / ACH); float var = q * (1.0f / ACH) - mu * mu; var = var > 0.f ? var : 0.f; const float rs = 1.0f / sqrtf(var + EPS);
            const float y0 = (o0[t] - mu) * rs * lg[0] + lb[0], y1 = (o1[t] - mu) * rs * lg[1] + lb[1];
            *(unsigned*)((char*)(A2 + (size_t)(t0 + t) * DM) + 4 * p) = (DROPMASK & 16) ? 0u : cvt_pk_bf16(fsilu(y0), fsilu(y1)); }
    }
    __syncthreads();
}
__device__ __forceinline__ void mixmid_gmlp(Frame& F, const Args& A, int ch, int hg, const bf16* UG, const bf16* VG, const bf16* WSB, bf16* A2) {
    const int R0 = ch * CHUNK;
    LAS f32x2* st = (LAS f32x2*)(F.lds + RING_OFF);
    LAS bf16* vnT = (LAS bf16*)(F.lds + RING_OFF + 1024);
    constexpr int VP = 136;
    for (int i = 0; i < 16; ++i) { const int j = F.wave * 16 + i; const v4u x = *(const v4u*)(VG + (size_t)(R0 + j) * BCH + 8 * F.lane);
        float s = 0.f, q = 0.f;
#pragma unroll
        for (int e = 0; e < 4; ++e) { const float a = bf_lo(x[e]), b = bf_hi(x[e]); s += a + b; q += a * a + b * b; }
        s = wave_sum(s); q = wave_sum(q); const float mu = s * (1.0f / BCH); float var = q * (1.0f / BCH) - mu * mu; var = var > 0.f ? var : 0.f;
        if (F.lane == 0) st[j] = (f32x2){mu, 1.0f / sqrtf(var + EPS)}; }
    __syncthreads();
    { const int j = F.tid >> 2, cq = (F.tid & 3) * 16; const f32x2 ms = st[j];
#pragma unroll
      for (int hh = 0; hh < 4; ++hh) { const int c0 = (4 * hg + hh) * 64 + cq;
#pragma unroll
        for (int q = 0; q < 2; ++q) { const v4u x = *(const v4u*)(VG + (size_t)(R0 + j) * BCH + c0 + 8 * q);
#pragma unroll
            for (int e = 0; e < 4; ++e) { const int c = c0 + 8 * q + 2 * e; const f32x2 gg = *(const f32x2*)(A.in[I_LNVG] + c), bb = *(const f32x2*)(A.in[I_LNVB] + c);
                const float y0 = (bf_lo(x[e]) - ms[0]) * ms[1] * gg[0] + bb[0], y1 = (bf_hi(x[e]) - ms[0]) * ms[1] * gg[1] + bb[1];
                const unsigned pk = cvt_pk_bf16(y0, y1); const int d = cq + 8 * q + 2 * e;
                vnT[(hh * 64 + d) * VP + j] = (bf16)(pk & 0xffffu); vnT[(hh * 64 + d + 1) * VP + j] = (bf16)(pk >> 16); } } } }
    __syncthreads();
    { const int hh = F.wave >> 1, h = 4 * hg + hh, ib0 = (F.wave & 1) * 4, lr = F.lane & 15, lq = F.lane >> 4;
      f32x4 acc[4][4];
#pragma unroll
      for (int a = 0; a < 4; ++a)
#pragma unroll
          for (int b = 0; b < 4; ++b) acc[a][b] = (f32x4){0.f, 0.f, 0.f, 0.f};
#pragma unroll
      for (int kk = 0; kk < 4; ++kk) { bf16x8 wf[4], vf[4];
#pragma unroll
          for (int ib = 0; ib < 4; ++ib) wf[ib] = *(const bf16x8*)(WSB + ((size_t)h * CHUNK + (ib0 + ib) * 16 + lr) * CHUNK + kk * 32 + 8 * lq);
#pragma unroll
          for (int db = 0; db < 4; ++db) vf[db] = *(const LAS bf16x8*)(vnT + (hh * 64 + db * 16 + lr) * VP + kk * 32 + 8 * lq);
#pragma unroll
          for (int ib = 0; ib < 4; ++ib)
#pragma unroll
              for (int db = 0; db < 4; ++db) acc[ib][db] = __builtin_amdgcn_mfma_f32_16x16x32_bf16(vf[db], wf[ib], acc[ib][db], 0, 0, 0); }
#pragma unroll
      for (int ib = 0; ib < 4; ++ib) { const int i = (ib0 + ib) * 16 + lr; const float bsv = A.in[I_BS][h * CHUNK + i];
#pragma unroll
          for (int db = 0; db < 4; ++db) { const int c = h * 64 + db * 16 + 4 * lq; const v2u uu = *(const v2u*)(UG + (size_t)(R0 + i) * BCH + c);
              const f32x4 s = acc[ib][db] + bsv; v2u o; o.x = cvt_pk_bf16(bf_lo(uu.x) * s[0], bf_hi(uu.x) * s[1]); o.y = cvt_pk_bf16(bf_lo(uu.y) * s[2], bf_hi(uu.y) * s[3]);
              if (DROPMASK & 32) { o.x = 0u; o.y = 0u; }
              *(v2u*)(A2 + (size_t)(R0 + i) * DM + ACH + c) = o; } } }
    __syncthreads();
}
__device__ __forceinline__ void mixmid_phase(Frame& F, const Args& A, const bf16* AG, const bf16* UG, const bf16* VG, const bf16* WSB, bf16* A2) {
    constexpr int NU = (MALL / CHUNK) * 4;
    for (int u = F.vcu; u < NU; u += F.G) { const int part = u / (MALL / CHUNK), ch = u - part * (MALL / CHUNK);
#if !defined(MIX_ONLY) || MIX_ONLY == 1
        if (part < 2) mixmid_conv(F, A, ch, part, AG, A2);
#endif
#if !defined(MIX_ONLY) || MIX_ONLY == 2
        if (part >= 2) mixmid_gmlp(F, A, ch, part - 2, UG, VG, WSB, A2);
#endif
    }
}

__device__ __forceinline__ void zsplit_phase(Frame& F, const Args& A, const bf16* Z, bf16* QN, bf16* KVN, bf16* KPE, const float* rope) {
    const int gw = F.vcu * NWAVES + F.wave, NGW = F.G * NWAVES, l = F.lane;
    for (int row = gw; row < MALL; row += NGW) {
        const bf16* z = Z + (size_t)row * INO_PAD; float x[3][4];
#pragma unroll
        for (int j = 0; j < 3; ++j) { const v2u w = *(const v2u*)(z + 4 * l + 256 * j); x[j][0] = bf_lo(w.x); x[j][1] = bf_hi(w.x); x[j][2] = bf_lo(w.y); x[j][3] = bf_hi(w.y); }
        float q0 = 0.f, q1 = 0.f, q2 = 0.f;
#pragma unroll
        for (int e = 0; e < 4; ++e) { q0 += x[0][e] * x[0][e]; q1 += x[1][e] * x[1][e]; q2 += x[2][e] * x[2][e]; }
        const float sq = wave_sum(q0 + (l < 32 ? q1 : 0.f)), skv = wave_sum((l >= 32 ? q1 : 0.f) + (l < 32 ? q2 : 0.f));
        const float rq = 1.0f / sqrtf(sq * (1.0f / QRANK) + EPS), rkv = 1.0f / sqrtf(skv * (1.0f / KVRANK) + EPS);
        const bool lat = row < NLAT;
        if (lat) { const f32x4 g0 = *(const f32x4*)(A.in[I_GQ] + 4 * l); v2u o; o.x = cvt_pk_bf16(x[0][0] * rq * g0[0], x[0][1] * rq * g0[1]); o.y = cvt_pk_bf16(x[0][2] * rq * g0[2], x[0][3] * rq * g0[3]);
            *(v2u*)(QN + (size_t)row * QRANK + 4 * l) = o;
            if (l < 32) { const f32x4 g1 = *(const f32x4*)(A.in[I_GQ] + 256 + 4 * l); v2u o1; o1.x = cvt_pk_bf16(x[1][0] * rq * g1[0], x[1][1] * rq * g1[1]); o1.y = cvt_pk_bf16(x[1][2] * rq * g1[2], x[1][3] * rq * g1[3]);
                *(v2u*)(QN + (size_t)row * QRANK + 256 + 4 * l) = o1; } }
        { const int jj = (l >= 32) ? 1 : 2, kc = (l >= 32) ? 4 * (l - 32) : 128 + 4 * l; const f32x4 gk = *(const f32x4*)(A.in[I_GKV] + kc);
          const float a0 = (jj == 1) ? x[1][0] : x[2][0], a1 = (jj == 1) ? x[1][1] : x[2][1], a2 = (jj == 1) ? x[1][2] : x[2][2], a3 = (jj == 1) ? x[1][3] : x[2][3];
          v2u o; o.x = cvt_pk_bf16(a0 * rkv * gk[0], a1 * rkv * gk[1]); o.y = cvt_pk_bf16(a2 * rkv * gk[2], a3 * rkv * gk[3]);
          *(v2u*)(KVN + (size_t)row * KVRANK + kc) = o; }
        float y[4];
#pragma unroll
        for (int e = 0; e < 4; ++e) y[e] = lane_xor<4>(x[2][e]);
        if (l >= 32 && l < 48) { const int m = l - 32; int b, key, t = 0;
            if (lat) { b = row >> 12; t = row & (SEQ - 1); key = CTXL + t; } else { const int rc = row - NLAT; b = rc >> 8; key = rc & (CTXL - 1); }
            float o[4];
            if (lat) { const int a = m >> 3, pp = (m >> 2) & 1, f0 = 4 * (m & 3), pos = a ? (t & 63) : (t >> 6);
#pragma unroll
                for (int e = 0; e < 4; ++e) { const f32x2 cs = *(const f32x2*)(rope + (pos * 16 + f0 + e) * 2); const float x1 = pp ? y[e] : x[2][e], x2 = pp ? x[2][e] : y[e];
                    o[e] = pp ? (x1 * cs[1] + x2 * cs[0]) : (x1 * cs[0] - x2 * cs[1]); } }
            else {
#pragma unroll
                for (int e = 0; e < 4; ++e) o[e] = x[2][e]; }
            v2u w; w.x = cvt_pk_bf16(o[0], o[1]); w.y = cvt_pk_bf16(o[2], o[3]);
            *(v2u*)(KPE + ((size_t)b * SKV + key) * ROPE + 4 * m) = w; }
    }
}

__device__ __forceinline__ void combine_phase(Frame& F, const Args& A, const bf16* Y, const float* mod1, float mul) {
    const int gw = F.vcu * NWAVES + F.wave, NGW = F.G * NWAVES;
    for (int tl = gw; tl < NLAT; tl += NGW) { const int row = tl, bi = row >> 12;
        float* xr = A.out + (size_t)row * DM; const float* gate = mod1 + bi * MODW + 5 * DM; const f32x2 gg = *(const f32x2*)(A.ws + WS_TOKG + (size_t)row * 8);
        const bf16* y0 = Y + (size_t)(2 * tl) * DM; const bf16* y1 = y0 + DM;
        f32x4 v[4]; float ss = 0.f;
#pragma unroll
        for (int j = 0; j < 4; ++j) { const int c = 4 * F.lane + 256 * j; const f32x4 x = *(const f32x4*)(xr + c), gt = *(const f32x4*)(gate + c); const v2u a = *(const v2u*)(y0 + c), b = *(const v2u*)(y1 + c);
            f32x4 m; m[0] = gg[0] * bf_lo(a.x) + gg[1] * bf_lo(b.x); m[1] = gg[0] * bf_hi(a.x) + gg[1] * bf_hi(b.x); m[2] = gg[0] * bf_lo(a.y) + gg[1] * bf_lo(b.y); m[3] = gg[0] * bf_hi(a.y) + gg[1] * bf_hi(b.y);
            v[j] = x + gt * m * mul; ss += (v[j][0] * v[j][0] + v[j][1] * v[j][1]) + (v[j][2] * v[j][2] + v[j][3] * v[j][3]); }
        const float r = 1.0f / sqrtf(wave_sum(ss) * (1.0f / DM) + EPS);
#pragma unroll
        for (int j = 0; j < 4; ++j) { const int c = 4 * F.lane + 256 * j; const f32x4 fg = *(const f32x4*)(A.in[I_FINALG] + c); *(f32x4*)(xr + c) = v[j] * r * fg; }
    }
}
#if SELFCHECK
namespace chk {
__device__ __forceinline__ float bff(bf16 v) { return __builtin_bit_cast(float, (unsigned)v << 16); }
__device__ __forceinline__ float bfr(float f) { unsigned u = __builtin_bit_cast(unsigned, f); u = (u + 0x7fffu + ((u >> 16) & 1u)) & 0xffff0000u; return __builtin_bit_cast(float, u); }
__device__ __forceinline__ unsigned hsh(unsigned x) { x ^= x >> 16; x *= 0x7feb352du; x ^= x >> 15; x *= 0x846ca68bu; x ^= x >> 16; return x; }
__device__ __forceinline__ float dot_w(const bf16* a, const float* W, int K, int N, int n) { float s = 0.f; for (int k = 0; k < K; ++k) s += bff(a[k]) * bfr(W[(size_t)k * N + n]); return s; }
__device__ __forceinline__ float f8f(unsigned char v) { return __builtin_amdgcn_cvt_f32_fp8((int)v, 0); }
__device__ __forceinline__ float f8r(float x) { const int w = __builtin_amdgcn_cvt_pk_fp8_f32(x, 0.f, 0, false); return __builtin_amdgcn_cvt_f32_fp8(w, 0); }
__device__ __forceinline__ float dot_w8(const unsigned char* a, const float* W, int K, int N, int n, float mul) { float s = 0.f; for (int k = 0; k < K; ++k) s += f8f(a[k]) * f8r(W[(size_t)k * N + n] * mul); return s / mul; }
__device__ __forceinline__ float sigm(float x) { return 1.0f / (1.0f + __expf(-x)); }
__device__ __forceinline__ float gelu_t(float x) { return 0.5f * x * (1.0f + tanhf(0.7978845608028654f * (x + 0.044715f * x * x * x))); }
__device__ __forceinline__ void report(unsigned* dbg, int k, float got, float ref, float rel, float abs_) {
    const float err = fabsf(got - ref); const bool bad = !(err <= rel * fabsf(ref) + abs_);
    atomicAdd(dbg + 64 * k + 1, 1u); if (bad) atomicAdd(dbg + 64 * k, 1u);
}
}
#define CHK_LOOP(NS) for (int s_ = (int)(blockIdx.x * 512 + F.tid); s_ < (NS); s_ += (int)(gridDim.x * 512))
#endif
#if SELFCHECK
constexpr int CW_DBG = 32768;
constexpr size_t WS_CAP = 3 * MiB + 512 * 1024;
namespace chk {
struct Ctx { const Args* A; unsigned char* ws; unsigned char* ar; unsigned* dbg; const float* mod; float* XC; };
#define CK_IN(i) (C.A->in[i])
__device__ __forceinline__ const float* xrow(const Ctx& C, const float* L, const float* Cx, int row) { return row < NLAT ? L + (size_t)row * DM : Cx + (size_t)(row - NLAT) * DM; }
__device__ __forceinline__ void c_mod(Frame& F, const Ctx& C) {
    CHK_LOOP(2048) { const unsigned h = hsh(s_); const int l = h & 1, bi = (h >> 1) % 9, j = (h >> 8) % MODW;
        const float* cv = bi < 8 ? CK_IN(I_C) + bi * DM : CK_IN(I_CCTX); float s = CK_IN(I_BADA)[l * MODW + j];
        for (int k = 0; k < DM; ++k) { const float c = cv[k]; s += (c * sigm(c)) * CK_IN(I_WADA)[((size_t)l * DM + k) * MODW + j]; }
        report(C.dbg, 0, C.mod[(size_t)(l * 9 + bi) * MODW + j], s, 2e-3f, 2e-3f); }
}
__device__ __forceinline__ void c_norm(Frame& F, const Ctx& C, int k, const float* L, const float* Cx, int nrows, const float* g, const float* modl, int slot, const bf16* H) {
    CHK_LOOP(2048) { const unsigned h = hsh(s_ + 7919u * k); const int row = h % nrows, col = (h >> 16) % DM; const float* x = xrow(C, L, Cx, row); const int bi = row < NLAT ? row >> 12 : 8;
        float ss = 0.f; for (int i = 0; i < DM; ++i) ss += x[i] * x[i];
        const float r = 1.0f / sqrtf(ss / DM + EPS), y = x[col] * r * g[col] * (1.0f + modl[bi * MODW + (slot + 1) * DM + col]) + modl[bi * MODW + slot * DM + col];
        report(C.dbg, row < NLAT ? k : k + 20, bff(H[(size_t)row * DM + col]), y, 0.01f, 0.01f); }
}
__device__ __forceinline__ void c_mixin(Frame& F, const Ctx& C, const bf16* H, const bf16* AG, const bf16* UG, const bf16* VG) {
    CHK_LOOP(2048) { const unsigned h = hsh(s_ + 111u); const int row = h % MALL, c = (h >> 16) % 1536; const bf16* a = H + (size_t)row * DM; const float* W = CK_IN(I_EWIN); float ref, got;
        if (c < 512) { ref = dot_w(a, W, DM, 2048, c) * sigm(dot_w(a, W, DM, 2048, 512 + c)); got = bff(AG[(size_t)row * ACH + c]); }
        else if (c < 1024) { ref = gelu_t(dot_w(a, W, DM, 2048, 512 + c)); got = bff(UG[(size_t)row * BCH + c - 512]); }
        else { ref = gelu_t(dot_w(a, W, DM, 2048, 512 + c)); got = bff(VG[(size_t)row * BCH + c - 1024]); }
        report(C.dbg, 2, got, ref, 0.02f, 0.02f); }
}
__device__ __forceinline__ void c_mixmid(Frame& F, const Ctx& C, const bf16* AG, const bf16* UG, const bf16* VG, const bf16* A2) {
    CHK_LOOP(512) { const unsigned h = hsh(s_ + 222u); const int row = h % MALL, c = (h >> 16) % DM; float ref;
        if (c < ACH) { int s_lo, s_hi; if (row < NLAT) { s_lo = row & ~(SEQ - 1); s_hi = s_lo + SEQ; } else { s_lo = NLAT + ((row - NLAT) & ~(CTXL - 1)); s_hi = s_lo + CTXL; }
            float s = 0.f, q = 0.f, vc = 0.f;
            for (int ch = 0; ch < ACH; ++ch) { float v = CK_IN(I_CONVB)[ch];
                for (int k = 0; k < CONVK; ++k) { const int rr = row + k - 15; if (rr >= s_lo && rr < s_hi) v += CK_IN(I_CONVW)[k * ACH + ch] * bff(AG[(size_t)rr * ACH + ch]); }
                s += v; q += v * v; if (ch == c) vc = v; }
            const float mu = s / ACH, var = q / ACH - mu * mu, y = (vc - mu) / sqrtf(var + EPS) * CK_IN(I_LNAG)[c] + CK_IN(I_LNAB)[c]; ref = y * sigm(y);
        } else { const int cc = c - ACH, hh = cc >> 6, R0 = row & ~(CHUNK - 1), i = row - R0; float sv = CK_IN(I_BS)[hh * CHUNK + i];
            for (int j = 0; j < CHUNK; ++j) { const bf16* vr = VG + (size_t)(R0 + j) * BCH; float s = 0.f, q = 0.f;
                for (int ch = 0; ch < BCH; ++ch) { const float v = bff(vr[ch]); s += v; q += v * v; }
                const float mu = s / BCH, var = q / BCH - mu * mu, vn = (bff(vr[cc]) - mu) / sqrtf(var + EPS) * CK_IN(I_LNVG)[cc] + CK_IN(I_LNVB)[cc];
                sv += bfr(CK_IN(I_WS)[((size_t)hh * CHUNK + i) * CHUNK + j]) * bfr(vn); }
            ref = bff(UG[(size_t)row * BCH + cc]) * sv; }
        report(C.dbg, 3, bff(A2[(size_t)row * DM + c]), ref, 0.02f, 0.02f); }
}
__device__ __forceinline__ void c_resid(Frame& F, const Ctx& C, int k, int nrows, const bf16* Ain, int K, const float* W, const float* gate, const float* baseL, const float* baseC, bool captured) {
    CHK_LOOP(2048) { const unsigned h = hsh(s_ + 333u * k); const int row = h % nrows, col = (h >> 16) % DM, bi = row < NLAT ? row >> 12 : 8;
        const float base = captured ? ((const float*)(C.ws + WS_CAP))[s_] : xrow(C, baseL, baseC, row)[col];
        const float ref = base + gate[bi * MODW + col] * dot_w(Ain + (size_t)row * K, W, K, DM, col), got = xrow(C, C.A->out, C.XC, row)[col];
        report(C.dbg, k, got, ref, 0.01f, 0.01f); }
}
__device__ __forceinline__ void c_capture(Frame& F, const Ctx& C, int k, int nrows) {
    CHK_LOOP(2048) { const unsigned h = hsh(s_ + 333u * k); const int row = h % nrows, col = (h >> 16) % DM; ((float*)(C.ws + WS_CAP))[s_] = xrow(C, C.A->out, C.XC, row)[col]; }
}
__device__ __forceinline__ void c_swiglu(Frame& F, const Ctx& C, const bf16* H, const bf16* ACT) {
    CHK_LOOP(2048) { const unsigned h = hsh(s_ + 444u); const int row = h % MALL, j = (h >> 16) % DFF; const bf16* a = H + (size_t)row * DM;
        const float p = dot_w(a, CK_IN(I_FW1), DM, DFF, j), q = dot_w(a, CK_IN(I_FW3), DM, DFF, j);
        report(C.dbg, 6, bff(ACT[(size_t)row * DFF + j]), p * sigm(p) * q, 0.02f, 0.02f); }
}
__device__ __forceinline__ void c_z(Frame& F, const Ctx& C, const bf16* H, const bf16* Z) {
    CHK_LOOP(2048) { const unsigned h = hsh(s_ + 555u); const int row = h % MALL, j = (h >> 16) % INO;
        report(C.dbg, 9, bff(Z[(size_t)row * INO_PAD + j]), dot_w(H + (size_t)row * DM, CK_IN(I_OWIN), DM, INO, j), 0.02f, 0.02f); }
}
__device__ __forceinline__ float rope_ref(float x1, float x2, int p, int a, int f, int t) {
    const int pos = a ? (t & 63) : (t >> 6); const float ang = (float)pos * powf(10000.0f, -(float)f / 16.0f), c = cosf(ang), s = sinf(ang);
    return p ? (x1 * s + x2 * c) : (x1 * c - x2 * s);
}
__device__ __forceinline__ void c_zsplit(Frame& F, const Ctx& C, const bf16* Z, const bf16* QN, const bf16* KVN, const bf16* KPE) {
    CHK_LOOP(3072) { const unsigned h = hsh(s_ + 666u); const int kind = s_ % 3; const bf16* z;
        if (kind == 0) { const int row = h % NLAT, c = (h >> 16) % QRANK; z = Z + (size_t)row * INO_PAD; float ss = 0.f; for (int i = 0; i < QRANK; ++i) ss += bff(z[i]) * bff(z[i]);
            report(C.dbg, 10, bff(QN[(size_t)row * QRANK + c]), bff(z[c]) / sqrtf(ss / QRANK + EPS) * CK_IN(I_GQ)[c], 0.01f, 0.01f); }
        else if (kind == 1) { const int row = h % MALL, c = (h >> 16) % KVRANK; z = Z + (size_t)row * INO_PAD; float ss = 0.f; for (int i = 0; i < KVRANK; ++i) ss += bff(z[QRANK + i]) * bff(z[QRANK + i]);
            report(C.dbg, 10, bff(KVN[(size_t)row * KVRANK + c]), bff(z[QRANK + c]) / sqrtf(ss / KVRANK + EPS) * CK_IN(I_GKV)[c], 0.01f, 0.01f); }
        else { const int row = h % MALL, dd = (h >> 16) % ROPE; z = Z + (size_t)row * INO_PAD + QRANK + KVRANK; int b, key; float ref;
            if (row < NLAT) { b = row >> 12; const int t = row & (SEQ - 1); key = CTXL + t; const int a = dd >> 5, p = (dd >> 4) & 1, f = dd & 15; ref = rope_ref(bff(z[a * 32 + f]), bff(z[a * 32 + 16 + f]), p, a, f, t); }
            else { const int rc = row - NLAT; b = rc >> 8; key = rc & (CTXL - 1); ref = bff(z[dd]); }
            report(C.dbg, 10, bff(KPE[((size_t)b * SKV + key) * ROPE + dd]), ref, 0.01f, 0.01f); } }
}
__device__ __forceinline__ void c_qkv(Frame& F, const Ctx& C, const bf16* QN, const bf16* KVN, const bf16* Q, const bf16* KN, const bf16* V) {
    CHK_LOOP(3072) { const unsigned h = hsh(s_ + 777u), h2 = hsh(s_ + 778u); const int kind = s_ % 3, b = h % NB, hd = (h >> 8) % NHEAD;
        if (kind == 0) { const int t = (h >> 16) % SEQ, d = h2 % QKD, row = b * SEQ + t; const bf16* a = QN + (size_t)row * QRANK; float ref;
            if (d < 128) ref = dot_w(a, CK_IN(I_WUQ), QRANK, 1536, hd * QKD + d);
            else { const int dd = d - 128, aa = dd >> 5, p = (dd >> 4) & 1, f = dd & 15;
                ref = rope_ref(dot_w(a, CK_IN(I_WUQ), QRANK, 1536, hd * QKD + 128 + aa * 32 + f), dot_w(a, CK_IN(I_WUQ), QRANK, 1536, hd * QKD + 128 + aa * 32 + 16 + f), p, aa, f, t); }
            report(C.dbg, 11, bff(Q[((size_t)(b * NHEAD + hd) * SEQ + t) * QKD + d]), ref, 0.02f, 0.02f); }
        else { const int key = (h >> 16) % SKV, d = h2 % VHD, row = key < CTXL ? NLAT + b * CTXL + key : b * SEQ + key - CTXL; const bf16* a = KVN + (size_t)row * KVRANK;
            const float ref = dot_w(a, CK_IN(I_WUKV), KVRANK, 2048, hd * 256 + (kind == 1 ? 0 : 128) + d); const bf16* O = kind == 1 ? KN : V;
            report(C.dbg, 11, bff(O[((size_t)(b * NHEAD + hd) * SKV + key) * VHD + d]), ref, 0.02f, 0.02f); } }
}
__device__ __forceinline__ void c_attn(Frame& F, const Ctx& C, const bf16* Q, const bf16* KN, const bf16* KPE, const bf16* V, const bf16* ATT) {
    CHK_LOOP(256) { const unsigned h = hsh(s_ + 888u), h2 = hsh(s_ + 889u); const int b = h % NB, hd = (h >> 8) % NHEAD, t = (h >> 16) % SEQ, d = h2 % VHD;
        const bf16* q = Q + ((size_t)(b * NHEAD + hd) * SEQ + t) * QKD; float m = -1e30f, l = 0.f, o = 0.f;
        for (int k = 0; k < SKV; ++k) { const bf16* kn = KN + ((size_t)(b * NHEAD + hd) * SKV + k) * VHD; const bf16* kp = KPE + ((size_t)b * SKV + k) * ROPE; float sc = 0.f;
            for (int i = 0; i < 128; ++i) sc += bff(q[i]) * bff(kn[i]);
            for (int i = 0; i < 64; ++i) sc += bff(q[128 + i]) * bff(kp[i]);
            sc *= ATTN_SCALE; const float mn = fmaxf(m, sc), al = __expf(m - mn), p = __expf(sc - mn); l = l * al + p; o = o * al + p * bff(V[((size_t)(b * NHEAD + hd) * SKV + k) * VHD + d]); m = mn; }
        report(C.dbg, 12, bff(ATT[((size_t)b * SEQ + t) * DM + hd * VHD + d]), o / l, 0.03f, 0.01f); }
}
__device__ __forceinline__ void c_route(Frame& F, const Ctx& C, const float* modl, const unsigned char* H4) {
    CHK_LOOP(128) { const unsigned h = hsh(s_ + 999u); const int row = h % NLAT, col = (h >> 16) % DM, bi = row >> 12; const float* x = C.A->out + (size_t)row * DM; const float* g = CK_IN(I_NORMG) + 3 * DM;
        float ss = 0.f; for (int i = 0; i < DM; ++i) ss += x[i] * x[i]; const float r = 1.0f / sqrtf(ss / DM + EPS); float lg[NEXP]; float ycol = 0.f;
#pragma unroll
        for (int e = 0; e < NEXP; ++e) lg[e] = 0.f;
        for (int i = 0; i < DM; ++i) { const float y = x[i] * r * g[i] * (1.0f + modl[bi * MODW + 4 * DM + i]) + modl[bi * MODW + 3 * DM + i]; if (i == col) ycol = y;
#pragma unroll
            for (int e = 0; e < NEXP; ++e) lg[e] += y * CK_IN(I_ROUTER)[i * NEXP + e]; }
        report(C.dbg, 14, f8f(H4[(size_t)row * DM + col]), ycol, 0.07f, 0.01f);
        int i0 = 0; float v0 = lg[0];
#pragma unroll
        for (int e = 1; e < NEXP; ++e) if (lg[e] > v0) { v0 = lg[e]; i0 = e; }
        int i1 = 0; float v1 = -3.0e38f;
#pragma unroll
        for (int e = 0; e < NEXP; ++e) if (e != i0 && lg[e] > v1) { v1 = lg[e]; i1 = e; }
        float v2 = -3.0e38f;
#pragma unroll
        for (int e = 0; e < NEXP; ++e) if (e != i0 && e != i1 && lg[e] > v2) v2 = lg[e];
        if (v1 - v2 > 1e-3f && v0 - v1 > 1e-3f) {
            const float ex = __expf(v1 - v0), g0 = 1.0f / (1.0f + ex); const f32x2 tg = *(const f32x2*)(C.ws + WS_TOKG + (size_t)row * 8);
            report(C.dbg, 14, tg[0], g0, 0.01f, 0.002f); report(C.dbg, 14, tg[1], 1.0f - g0, 0.01f, 0.002f);
            const int tl = row; const unsigned* list = (const unsigned*)(C.ws + WS_LIST);
            const int c0 = (int)((const unsigned*)(C.ws + WS_CTL))[CW_CNT + 64 * i0], c1 = (int)((const unsigned*)(C.ws + WS_CTL))[CW_CNT + 64 * i1];
            float f0 = 0.f, f1 = 0.f; for (int i = 0; i < c0; ++i) if (list[i0 * LIST_CAP + i] == (unsigned)tl * 2u) f0 += 1.f; for (int i = 0; i < c1; ++i) if (list[i1 * LIST_CAP + i] == (unsigned)tl * 2u + 1u) f1 += 1.f;
            report(C.dbg, 14, f0, 1.0f, 0.f, 0.01f); report(C.dbg, 14, f1, 1.0f, 0.f, 0.01f); } }
}
__device__ __forceinline__ void c_moe_up(Frame& F, const Ctx& C, const LAS int* tab, const unsigned char* H4, const unsigned char* ACTE) {
    const unsigned* list = (const unsigned*)(C.ws + WS_LIST);
    CHK_LOOP(2048) { const unsigned h = hsh(s_ + 1111u), h2 = hsh(s_ + 1112u); const int e = h % NEXP, cnt = tab[16 + e]; if (cnt == 0) continue; const int slot = (h >> 8) % cnt, j = h2 % DEXP;
        const int tok = (int)(list[e * LIST_CAP + slot] >> 1); const unsigned char* a = H4 + (size_t)tok * DM;
        const float p = dot_w8(a, CK_IN(I_XW1) + (size_t)e * DM * DEXP, DM, DEXP, j, 32.f), q = dot_w8(a, CK_IN(I_XW3) + (size_t)e * DM * DEXP, DM, DEXP, j, 32.f);
        report(C.dbg, 15, f8f(ACTE[((size_t)tab[e] * 256 + slot) * DEXP + j]), p * sigm(p) * q, 0.08f, 0.02f); }
}
__device__ __forceinline__ void c_moe_down(Frame& F, const Ctx& C, const LAS int* tab, const unsigned char* ACTE, const bf16* Y) {
    const unsigned* list = (const unsigned*)(C.ws + WS_LIST);
    CHK_LOOP(2048) { const unsigned h = hsh(s_ + 2222u), h2 = hsh(s_ + 2223u); const int e = h % NEXP, cnt = tab[16 + e]; if (cnt == 0) continue; const int slot = (h >> 8) % cnt, col = h2 % DM;
        const unsigned ent = list[e * LIST_CAP + slot];
        report(C.dbg, 16, bff(Y[(size_t)ent * DM + col]), dot_w8(ACTE + ((size_t)tab[e] * 256 + slot) * DEXP, CK_IN(I_XW2) + (size_t)e * DEXP * DM, DEXP, DM, col, 64.f), 0.02f, 0.02f); }
}
__device__ __forceinline__ void c_cap_rows(Frame& F, const Ctx& C) {
    float* cap = (float*)(C.ws + WS_CAP + 65536);
    for (int i = (int)(blockIdx.x * 512 + F.tid); i < 64 * DM; i += (int)(gridDim.x * 512)) { const int r = i >> 10, c = i & (DM - 1), tl = hsh(r + 3333u) % NLAT; cap[i] = C.A->out[(size_t)tl * DM + c]; }
}
__device__ __forceinline__ void c_combine(Frame& F, const Ctx& C, const float* mod1, const bf16* Y) {
    const float* cap = (const float*)(C.ws + WS_CAP + 65536);
    CHK_LOOP(64 * 16) { const int r = s_ >> 4, tl = hsh(r + 3333u) % NLAT, row = tl, bi = row >> 12, col = hsh(s_ + 4444u) % DM; const f32x2 tg = *(const f32x2*)(C.ws + WS_TOKG + (size_t)row * 8);
        float ss = 0.f, vc = 0.f; for (int i = 0; i < DM; ++i) { const float v = cap[r * DM + i] + mod1[bi * MODW + 5 * DM + i] * (tg[0] * bff(Y[(size_t)(2 * tl) * DM + i]) + tg[1] * bff(Y[(size_t)(2 * tl + 1) * DM + i])); ss += v * v; if (i == col) vc = v; }
        report(C.dbg, 17, C.A->out[(size_t)row * DM + col], vc / sqrtf(ss / DM + EPS) * CK_IN(I_FINALG)[col], 0.005f, 0.005f); }
}
}
#endif
namespace att {
using bf16x8 = __attribute__((ext_vector_type(8))) short;
using s16x4  = __attribute__((ext_vector_type(4))) short;
using f32x16 = __attribute__((ext_vector_type(16))) float;
using u32x4  = __attribute__((ext_vector_type(4))) unsigned;
constexpr int D = 128, NW = 8, QBLK = 32, KVBLK = 64;
constexpr float THR = 8.f, SCALE = ATTN_SCALE;
constexpr int SHM_V = KVBLK * D * 2, SHM_K = KVBLK * D * 2, SHM_P = KVBLK * ROPE * 2, SHM_QP = 2 * SHM_V + 2 * SHM_K + 2 * SHM_P + NW * 64 * 4, NQL = 6  , SHM_ATTN = SHM_QP + NW * NQL * 1024;
static_assert(SHM_ATTN <= RING_BYTES, "attention LDS");
#define KSWZ(row, colB) ((row) * 256 + ((colB) ^ (((row) & 7) << 4)))
#define PSWZ(row, colB) ((row) * 128 + ((colB) ^ (((row) & 7) << 4)))
#define SBAR() __builtin_amdgcn_sched_barrier(0)
__device__ __forceinline__ int crow(int r, int hi) { return (r & 3) + 8 * (r >> 2) + 4 * hi; }
__device__ __forceinline__ unsigned cvtpk(float lo, float hi) { unsigned r; asm volatile("v_cvt_pk_bf16_f32 %0, %1, %2" : "=v"(r) : "v"(lo), "v"(hi)); return r; }
__device__ __forceinline__ void swap32(unsigned& a, unsigned& b) { asm volatile("s_nop 1\n\tv_permlane32_swap_b32 %0, %1\n\ts_nop 0" : "+v"(a), "+v"(b)); }
__device__ __forceinline__ void partialSM(f32x16& p0, f32x16& p1, float& m_reg, float& mn, float& alpha) {
  constexpr float C = SCALE * 1.4426950408889634f;
  float pmax = p0[0]; for (int r = 1; r < 16; ++r) pmax = fmaxf(pmax, p0[r]); for (int r = 0; r < 16; ++r) pmax = fmaxf(pmax, p1[r]);
  { unsigned a_ = __float_as_uint(pmax), b_ = a_; swap32(a_, b_); pmax = fmaxf(__uint_as_float(a_), __uint_as_float(b_)); }
  if (__builtin_expect(__all(pmax - m_reg <= THR / SCALE), 1)) { mn = m_reg; alpha = 1.f; }
  else { mn = fmaxf(m_reg, pmax); alpha = __builtin_amdgcn_exp2f((m_reg - mn) * C); m_reg = mn; }
  float mnC = -mn * C;
  for (int r = 0; r < 16; ++r) p0[r] = fmaf(p0[r], C, mnC); for (int r = 0; r < 16; ++r) p1[r] = fmaf(p1[r], C, mnC);
  for (int r = 0; r < 16; ++r) p0[r] = __builtin_amdgcn_exp2f(p0[r]);
}
__device__ __forceinline__ void finishSM(f32x16& p0, f32x16& p1, float alpha, float& l_reg, bf16x8& pa0, bf16x8& pa1, bf16x8& pa2, bf16x8& pa3) {
  for (int r = 0; r < 16; ++r) p1[r] = __builtin_amdgcn_exp2f(p1[r]);
  float ps = 0; for (int r = 0; r < 16; ++r) ps += p0[r]; for (int r = 0; r < 16; ++r) ps += p1[r];
  { unsigned a_ = __float_as_uint(ps), b_ = a_; swap32(a_, b_); ps = __uint_as_float(a_) + __uint_as_float(b_); }
  l_reg = l_reg * alpha + ps;
#define PK4(P, BASE, OUT) do { unsigned a0 = cvtpk(P[BASE + 0], P[BASE + 1]), a1 = cvtpk(P[BASE + 2], P[BASE + 3]);   \
    unsigned b0 = cvtpk(P[BASE + 4], P[BASE + 5]), b1 = cvtpk(P[BASE + 6], P[BASE + 7]);                              \
    auto r0 = __builtin_amdgcn_permlane32_swap(a0, b0, false, false); auto r1 = __builtin_amdgcn_permlane32_swap(a1, b1, false, false); \
    u32x4 w = {r0[0], r1[0], r0[1], r1[1]}; OUT = *reinterpret_cast<bf16x8*>(&w); } while (0)
  PK4(p0, 0, pa0); PK4(p0, 8, pa1); PK4(p1, 0, pa2); PK4(p1, 8, pa3);
#undef PK4
}
__device__ __forceinline__ void qkt(f32x16& p0, f32x16& p1, const char* Ks, const char* Ps, const bf16x8* qr, const char* qp, int r32, int hi) {
  p0 = f32x16{}; p1 = f32x16{};
#pragma unroll
  for (int d0 = 0; d0 < 8; ++d0) { int cb = (d0 * 16 + hi * 8) * 2;
    bf16x8 b0 = *reinterpret_cast<const bf16x8*>(Ks + KSWZ(r32, cb));
    bf16x8 b1 = *reinterpret_cast<const bf16x8*>(Ks + KSWZ(32 + r32, cb));
    const bf16x8 qf = (d0 < 12 - NQL) ? qr[d0 < 12 - NQL ? d0 : 0] : *reinterpret_cast<const bf16x8*>(qp + (d0 - (12 - NQL)) * 1024);
    p0 = __builtin_amdgcn_mfma_f32_32x32x16_bf16(b0, qf, p0, 0, 0, 0);
    p1 = __builtin_amdgcn_mfma_f32_32x32x16_bf16(b1, qf, p1, 0, 0, 0); }
#pragma unroll
  for (int d0 = 0; d0 < 4; ++d0) { int cb = (d0 * 16 + hi * 8) * 2;
    bf16x8 b0 = *reinterpret_cast<const bf16x8*>(Ps + PSWZ(r32, cb));
    bf16x8 b1 = *reinterpret_cast<const bf16x8*>(Ps + PSWZ(32 + r32, cb));
    const bf16x8 qf = *reinterpret_cast<const bf16x8*>(qp + (8 + d0 - (12 - NQL)) * 1024);
    p0 = __builtin_amdgcn_mfma_f32_32x32x16_bf16(b0, qf, p0, 0, 0, 0);
    p1 = __builtin_amdgcn_mfma_f32_32x32x16_bf16(b1, qf, p1, 0, 0, 0); }
}
__device__ __forceinline__ int v_st(int k, int c) { const int kk = (k & ~0xC) | ((k & 4) << 1) | ((k & 8) >> 1); return ((kk >> 3) * 4 + (c >> 5)) * 512 + ((kk & 7) * 32 + (c & 31)) * 2; }
__device__ __forceinline__ int v_rd_base(int lane) { return ((lane & 3) << 3) | (((lane >> 2) & 3) << 6) | (((lane >> 4) & 1) << 5) | (((lane >> 5) & 1) << 8); }
constexpr int v_rd_off(int d0, int ks, int half) { return d0 * 512 + ks * 4096 + half * 2048; }
template <int OFF> __device__ __forceinline__ s16x4 tr_read(int vb) {
  s16x4 r; asm volatile("ds_read_b64_tr_b16 %0, %1 offset:%2" : "=&v"(r) : "v"(vb), "i"(OFF) : "memory"); return r;
}
template <int D0> __device__ __forceinline__ void pv_one(f32x16& od, int vb, bf16x8 pa0, bf16x8 pa1, bf16x8 pa2, bf16x8 pa3) {
  const s16x4 l0 = tr_read<v_rd_off(D0, 0, 0)>(vb), h0 = tr_read<v_rd_off(D0, 0, 1)>(vb), l1 = tr_read<v_rd_off(D0, 1, 0)>(vb), h1 = tr_read<v_rd_off(D0, 1, 1)>(vb);
  const s16x4 l2 = tr_read<v_rd_off(D0, 2, 0)>(vb), h2 = tr_read<v_rd_off(D0, 2, 1)>(vb), l3 = tr_read<v_rd_off(D0, 3, 0)>(vb), h3 = tr_read<v_rd_off(D0, 3, 1)>(vb);
  asm volatile("s_waitcnt lgkmcnt(0)" ::: "memory"); SBAR();
#define PK(L, H) (bf16x8){L[0], L[1], L[2], L[3], H[0], H[1], H[2], H[3]}
  od = __builtin_amdgcn_mfma_f32_32x32x16_bf16(pa0, PK(l0, h0), od, 0, 0, 0);
  od = __builtin_amdgcn_mfma_f32_32x32x16_bf16(pa1, PK(l1, h1), od, 0, 0, 0);
  od = __builtin_amdgcn_mfma_f32_32x32x16_bf16(pa2, PK(l2, h2), od, 0, 0, 0);
  od = __builtin_amdgcn_mfma_f32_32x32x16_bf16(pa3, PK(l3, h3), od, 0, 0, 0);
#undef PK
}
__device__ __forceinline__ void pv_d0(f32x16* o, int vb, bf16x8 pa0, bf16x8 pa1, bf16x8 pa2, bf16x8 pa3) {
  pv_one<0>(o[0], vb, pa0, pa1, pa2, pa3); pv_one<1>(o[1], vb, pa0, pa1, pa2, pa3); pv_one<2>(o[2], vb, pa0, pa1, pa2, pa3); pv_one<3>(o[3], vb, pa0, pa1, pa2, pa3);
}
__device__ __forceinline__ void attn_unit(const bf16* __restrict__ Qb, const bf16* __restrict__ Kh, const bf16* __restrict__ Ph, const bf16* __restrict__ Vh, bf16* __restrict__ Ob, int seq, char* lds, int wave_id) {
  const int wid = __builtin_amdgcn_readfirstlane(wave_id), lane = fresh_lane(), tid = wid * 64 + lane, r32 = lane & 31, hi = lane >> 5;
  char* V_lds = lds; char* K_lds = lds + 2 * SHM_V; char* P_lds = lds + 2 * SHM_V + 2 * SHM_K;
  float* ws = (float*)(lds + 2 * SHM_V + 2 * SHM_K + 2 * SHM_P) + wid * 64; float* li_l = ws; float* al_l = ws + 32;
  float m_reg = -1e30f, l_reg = 0; f32x16 o[4] = {}; bf16x8 qr[12 - NQL];
  char* qp = lds + SHM_QP + wid * (NQL * 1024) + lane * 16;
  const char* Qw = (const char*)Qb + (size_t)wid * (QBLK * QKD * 2); const int qoff = (r32 * QKD + hi * 8) * 2;
#pragma unroll
  for (int d0 = 0; d0 < 12 - NQL; ++d0) qr[d0] = *reinterpret_cast<const bf16x8*>(Qw + qoff + d0 * 32);
#pragma unroll
  for (int d0 = 0; d0 < NQL; ++d0) *reinterpret_cast<bf16x8*>(qp + d0 * 1024) = *reinterpret_cast<const bf16x8*>(Qw + qoff + (12 - NQL + d0) * 32);
  const int sr = tid >> 4, sc = (tid & 15) * 8, vst0 = v_st(sr, sc), vst1 = v_st(32 + sr, sc);
  const int pr = tid >> 3, pc = (tid & 7) * 8;
  const int vb0 = (int)(uintptr_t)V_lds + v_rd_base(lane);
  struct { bf16x8 vs0, vs1, ks0, ks1, ps; } sr_[1];
  const int kvoff = (sr * D + sc) * 2, poff = (pr * ROPE + pc) * 2;
#define SLOAD(i, k0) do { const char* vt_ = (const char*)Vh + (size_t)(k0) * (D * 2); const char* kt_ = (const char*)Kh + (size_t)(k0) * (D * 2); const char* pt_ = (const char*)Ph + (size_t)(k0) * (ROPE * 2); \
    sr_[i].vs0 = *(const bf16x8*)(vt_ + kvoff); sr_[i].vs1 = *(const bf16x8*)(vt_ + kvoff + 32 * D * 2); \
    sr_[i].ks0 = *(const bf16x8*)(kt_ + kvoff); sr_[i].ks1 = *(const bf16x8*)(kt_ + kvoff + 32 * D * 2); \
    sr_[i].ps = *(const bf16x8*)(pt_ + poff); } while (0)
#define SWRITE(b, i) do { *(bf16x8*)(V_lds + (b) * SHM_V + vst0) = sr_[i].vs0; *(bf16x8*)(V_lds + (b) * SHM_V + vst1) = sr_[i].vs1; int kc = sc * 2; \
    *(bf16x8*)(K_lds + (b) * SHM_K + KSWZ(sr, kc)) = sr_[i].ks0; *(bf16x8*)(K_lds + (b) * SHM_K + KSWZ(32 + sr, kc)) = sr_[i].ks1; \
    *(bf16x8*)(P_lds + (b) * SHM_P + PSWZ(pr, pc * 2)) = sr_[i].ps; } while (0)
#define SWAIT() asm volatile("s_waitcnt vmcnt(0)" ::: "memory")
#define RESC(a) do { if (__any((a) < 1.f)) { if (hi == 0) al_l[r32] = (a); asm volatile("s_waitcnt lgkmcnt(0)" ::: "memory"); \
    for (int d = 0; d < 4; ++d) for (int r = 0; r < 16; ++r) o[d][r] *= al_l[crow(r, hi)]; } } while (0)
  f32x16 pA0, pA1, pB0, pB1; float mnA, mnB, alA, alB; bf16x8 pa0, pa1, pa2, pa3; const int NT = seq / KVBLK;
  SLOAD(0, 0); asm volatile("s_waitcnt vmcnt(0)" ::: "memory"); SWRITE(0, 0); __syncthreads();
  qkt(pA0, pA1, K_lds, P_lds, qr, qp, r32, hi); partialSM(pA0, pA1, m_reg, mnA, alA);
  SLOAD(0, KVBLK);
  SWAIT(); SWRITE(1, 0); __syncthreads();
  for (int j = 1; j + 1 < NT; j += 2) {
    SBAR(); qkt(pB0, pB1, K_lds + SHM_K, P_lds + SHM_P, qr, qp, r32, hi);
    finishSM(pA0, pA1, alA, l_reg, pa0, pa1, pa2, pa3); SBAR();
    SLOAD(0, (j + 1) * KVBLK); SBAR();
    pv_d0(o, vb0, pa0, pa1, pa2, pa3); partialSM(pB0, pB1, m_reg, mnB, alB);
    __syncthreads(); SWAIT(); SWRITE(0, 0);
    RESC(alB); __syncthreads();
    SBAR(); qkt(pA0, pA1, K_lds, P_lds, qr, qp, r32, hi);
    finishSM(pB0, pB1, alB, l_reg, pa0, pa1, pa2, pa3); SBAR();
    SLOAD(0, (j + 2) * KVBLK); SBAR();
    pv_d0(o, vb0 + (int)SHM_V, pa0, pa1, pa2, pa3); partialSM(pA0, pA1, m_reg, mnA, alA);
    __syncthreads(); SWAIT(); SWRITE(1, 0);
    RESC(alA); __syncthreads();
  }
  SBAR(); qkt(pB0, pB1, K_lds + SHM_K, P_lds + SHM_P, qr, qp, r32, hi);
  finishSM(pA0, pA1, alA, l_reg, pa0, pa1, pa2, pa3); SBAR();
  pv_d0(o, vb0, pa0, pa1, pa2, pa3); partialSM(pB0, pB1, m_reg, mnB, alB);
  __syncthreads(); RESC(alB);
  finishSM(pB0, pB1, alB, l_reg, pa0, pa1, pa2, pa3); SBAR();
  pv_d0(o, vb0 + (int)SHM_V, pa0, pa1, pa2, pa3);
  if (hi == 0) li_l[r32] = l_reg; asm volatile("s_waitcnt lgkmcnt(0)" ::: "memory");
  float rli[16];
#pragma unroll
  for (int r = 0; r < 16; ++r) rli[r] = __builtin_amdgcn_rcpf(li_l[crow(r, hi)]);
  char* Ow = (char*)Ob + (size_t)wid * (QBLK * DM * 2); const int ooff = (4 * hi * DM + r32) * 2;
#pragma unroll
  for (int r = 0; r < 16; ++r) { const int orow = (r & 3) + 8 * (r >> 2);
#pragma unroll
    for (int d0 = 0; d0 < 4; ++d0) { const unsigned w = cvtpk(o[d0][r] * rli[r], 0.f); *(bf16*)(Ow + ooff + (orow * DM + d0 * 32) * 2) = (bf16)(w & 0xffffu); } }
  __syncthreads();
#undef SLOAD
#undef SWRITE
#undef SWAIT
#undef RESC
}
#undef KSWZ
#undef PSWZ
#undef SBAR
}

__global__ void __launch_bounds__(NWAVES * 64, 2) fwd_kernel(Args args) {
    extern __shared__ __attribute__((aligned(16))) unsigned char lds[];
    Frame F;
    F.lds = (LAS unsigned char*)lds;
    F.MISC = (volatile LAS unsigned*)(F.lds + MISC_OFF);
    F.tid = threadIdx.x; F.lane = F.tid & 63; F.wave = __builtin_amdgcn_readfirstlane(F.tid >> 6);
    F.G = gridDim.x; { const int bx = blockIdx.x; F.vcu = (F.G % 8 == 0) ? (bx % 8) * (F.G / 8) + bx / 8 : bx; }
    unsigned char* ws = args.ws;
    F.ctl = (gu32*)(ws + WS_CTL);
    for (int u = F.tid; u < (LDS_BYTES - LDSCTL_OFF) / 4; u += NWAVES * 64) ((LAS unsigned*)(F.lds + LDSCTL_OFF))[u] = 0u;
    __syncthreads();
    XcdBarrier bar = xcd_barrier_post((unsigned*)(F.ctl + CW_BAR), F.MISC + 8);
#define GRID_BAR() xcd_barrier(bar, F.wave)
#ifndef DROPMASK
#define DROPMASK 0
#endif
#ifndef PHMASK
#define PHMASK 0xffffffffu
#endif
#define PH(k) FRESH(); if constexpr (((PHMASK) >> (k)) & 1u)
#define FRESH() do { F.lane = fresh_lane(); F.tid = F.wave * 64 + F.lane; } while (0)
    unsigned char* ar = ws + WS_ARENA;
    float* const mod = (float*)(ws + WS_MOD); const float* const mod0 = mod; const float* const mod1 = mod + 9 * MODW;
    const float* const rope = (const float*)(ws + WS_ROPE);
    bf16* const XCb = nullptr; (void)XCb;
    float* const XC = (float*)(ar + AR_XC * MiB);
    bf16* const H = (bf16*)(ar + AR_H * MiB);
    PG8_LAS unsigned char* const ring = (PG8_LAS unsigned char*)(F.lds + RING_OFF);
    const int G = F.G, cid = (int)blockIdx.x;
#if SELFCHECK
    chk::Ctx CK{&args, ws, ar, (unsigned*)(ws + WS_CTL) + CW_DBG, mod, XC};
#define CHK(stmt) do { FRESH(); stmt; GRID_BAR(); } while (0)
#else
#define CHK(stmt) do { } while (0)
#endif

    PH(0) p0_prologue(F, args);
    GRID_BAR();
    CHK(chk::c_mod(F, CK));
    PH(1) norm_phase<false>(F, args, args.in[I_X], args.in[I_CTX], MALL, args.in[I_NORMG] + 0 * DM, mod0, 0, H);
    GRID_BAR();
    CHK(chk::c_norm(F, CK, 1, args.in[I_X], args.in[I_CTX], MALL, args.in[I_NORMG], mod0, 0, H));
    PH(2) { pg8::Gemm g{H, (const bf16*)(ws + WS_WIN), MALL, 2048, DM}; pg8::StaticOrder S; S.init(MALL, 2048, G, cid);
      epi::EpiMixIn E{(bf16*)(ar + AR_AG * MiB), (bf16*)(ar + AR_UG * MiB), (bf16*)(ar + AR_VG * MiB)};
      pg8::gemm_phase<epi::EpiMixIn, pg8::StaticOrder, true>(ring, g, S, E, F.wave); }
    GRID_BAR();
    CHK(chk::c_mixin(F, CK, H, (const bf16*)(ar + AR_AG * MiB), (const bf16*)(ar + AR_UG * MiB), (const bf16*)(ar + AR_VG * MiB)));
    PH(3) mixmid_phase(F, args, (const bf16*)(ar + AR_AG * MiB), (const bf16*)(ar + AR_UG * MiB), (const bf16*)(ar + AR_VG * MiB), (const bf16*)(ws + WS_WSB), H);
    GRID_BAR();
    CHK(chk::c_mixmid(F, CK, (const bf16*)(ar + AR_AG * MiB), (const bf16*)(ar + AR_UG * MiB), (const bf16*)(ar + AR_VG * MiB), H));
    PH(4) { pg8::Gemm g{H, (const bf16*)(ws + WS_WOUT), MALL, DM, DM}; pg8::StaticOrder S; S.init(MALL, DM, G, cid);
      epi::EpiResid E{args.in[I_X], args.in[I_CTX], args.out, XC, mod0 + 2 * DM, (DROPMASK & 1) ? 0.f : 1.f};
      pg8::gemm_phase<epi::EpiResid, pg8::StaticOrder, true>(ring, g, S, E, F.wave); }
    GRID_BAR();
    CHK(chk::c_resid(F, CK, 4, MALL, H, DM, args.in[I_EWOUT], mod0 + 2 * DM, args.in[I_X], args.in[I_CTX], false));
    PH(5) norm_phase<false>(F, args, args.out, XC, MALL, args.in[I_NORMG] + 1 * DM, mod0, 3, H);
    GRID_BAR();
    CHK(chk::c_norm(F, CK, 5, args.out, XC, MALL, args.in[I_NORMG] + DM, mod0, 3, H));
    PH(6) { pg8::Gemm g{H, (const bf16*)(ws + WS_W13), MALL, 2 * DFF, DM}; pg8::StaticOrder S; S.init(MALL, 2 * DFF, G, cid);
      epi::EpiSwiGlu E{(bf16*)(ar + AR_ACT * MiB), DFF, 2 * DFF / 256};
      pg8::gemm_phase<epi::EpiSwiGlu, pg8::StaticOrder, true>(ring, g, S, E, F.wave); }
    GRID_BAR();
    CHK(chk::c_swiglu(F, CK, H, (const bf16*)(ar + AR_ACT * MiB)));
    CHK(chk::c_capture(F, CK, 7, MALL));
    PH(7) { pg8::Gemm g{(const bf16*)(ar + AR_ACT * MiB), (const bf16*)(ws + WS_W2), MALL, DM, DFF}; pg8::StaticOrder S; S.init(MALL, DM, G, cid);
      epi::EpiResid E{args.out, XC, args.out, XC, mod0 + 5 * DM, (DROPMASK & 2) ? 0.f : 1.f};
      pg8::gemm_phase<epi::EpiResid, pg8::StaticOrder, true>(ring, g, S, E, F.wave); }
    GRID_BAR();
    CHK(chk::c_resid(F, CK, 7, MALL, (const bf16*)(ar + AR_ACT * MiB), DFF, args.in[I_FW2], mod0 + 5 * DM, nullptr, nullptr, true));
    PH(8) norm_phase<false>(F, args, args.out, XC, MALL, args.in[I_NORMG] + 2 * DM, mod1, 0, H);
    GRID_BAR();
    CHK(chk::c_norm(F, CK, 8, args.out, XC, MALL, args.in[I_NORMG] + 2 * DM, mod1, 0, H));
    PH(9) { pg8::Gemm g{H, (const bf16*)(ws + WS_WINO), MALL, INO_PAD, DM}; pg8::StaticOrder S; S.init(MALL, INO_PAD, G, cid);
      epi::EpiPlain E{(bf16*)(ar + AR_Z * MiB), INO_PAD};
      pg8::gemm_phase<epi::EpiPlain, pg8::StaticOrder, true>(ring, g, S, E, F.wave); }
    GRID_BAR();
    CHK(chk::c_z(F, CK, H, (const bf16*)(ar + AR_Z * MiB)));
    PH(10) zsplit_phase(F, args, (const bf16*)(ar + AR_Z * MiB), (bf16*)(ar + AR_QN * MiB), (bf16*)(ar + AR_KVN * MiB), (bf16*)(ar + AR_KPE * MiB), rope);
    GRID_BAR();
    CHK(chk::c_zsplit(F, CK, (const bf16*)(ar + AR_Z * MiB), (const bf16*)(ar + AR_QN * MiB), (const bf16*)(ar + AR_KVN * MiB), (const bf16*)(ar + AR_KPE * MiB)));
    PH(11) { pg8::Gemm g{(const bf16*)(ar + AR_QN * MiB), (const bf16*)(ws + WS_WUQ), NLAT, 1536, QRANK}; pg8::StaticOrder S; S.init(NLAT, 1536, G, cid);
      epi::EpiQ E{(bf16*)(ar + AR_Q * MiB), rope};
      pg8::gemm_phase<epi::EpiQ, pg8::StaticOrder, true>(ring, g, S, E, F.wave); }
    PH(12) { pg8::Gemm g{(const bf16*)(ar + AR_KVN * MiB), (const bf16*)(ws + WS_WUKV), MALL, 2048, KVRANK}; pg8::StaticOrder S; S.init(MALL, 2048, G, cid);
      epi::EpiKV E{(bf16*)(ar + AR_KN * MiB), (bf16*)(ar + AR_V * MiB)};
      pg8::gemm_phase<epi::EpiKV, pg8::StaticOrder, true>(ring, g, S, E, F.wave); }
    GRID_BAR();
    CHK(chk::c_qkv(F, CK, (const bf16*)(ar + AR_QN * MiB), (const bf16*)(ar + AR_KVN * MiB), (const bf16*)(ar + AR_Q * MiB), (const bf16*)(ar + AR_KN * MiB), (const bf16*)(ar + AR_V * MiB)));
    PH(13) { const bf16* Qg = (const bf16*)(ar + AR_Q * MiB); const bf16* Kg = (const bf16*)(ar + AR_KN * MiB); const bf16* Pg = (const bf16*)(ar + AR_KPE * MiB); const bf16* Vg = (const bf16*)(ar + AR_V * MiB);
      bf16* Og = (bf16*)(ar + AR_ATT * MiB);
      constexpr int NQB = SEQ / 256, NU = NB * NHEAD * NQB;
      for (int u = F.vcu; u < NU; u += G) { const int bh = u / NQB, qb = u - bh * NQB, b = bh / NHEAD, h = bh - b * NHEAD;
          att::attn_unit(Qg + ((size_t)bh * SEQ + qb * 256) * QKD, Kg + (size_t)bh * SKV * VHD, Pg + (size_t)b * SKV * ROPE, Vg + (size_t)bh * SKV * VHD,
                         Og + ((size_t)b * SEQ + qb * 256) * DM + h * VHD, SKV, (char*)lds + RING_OFF, F.wave); } }
    GRID_BAR();
    CHK(chk::c_attn(F, CK, (const bf16*)(ar + AR_Q * MiB), (const bf16*)(ar + AR_KN * MiB), (const bf16*)(ar + AR_KPE * MiB), (const bf16*)(ar + AR_V * MiB), (const bf16*)(ar + AR_ATT * MiB)));
    CHK(chk::c_capture(F, CK, 13, NLAT));
    PH(14) { pg8::Gemm g{(const bf16*)(ar + AR_ATT * MiB), (const bf16*)(ws + WS_WO), NLAT, DM, DM}; pg8::StaticOrder S; S.init(NLAT, DM, G, cid);
      epi::EpiResid E{args.out, XC, args.out, XC, mod1 + 2 * DM, (DROPMASK & 4) ? 0.f : 1.f};
      pg8::gemm_phase<epi::EpiResid, pg8::StaticOrder, true>(ring, g, S, E, F.wave); }
    GRID_BAR();
    CHK(chk::c_resid(F, CK, 13, NLAT, (const bf16*)(ar + AR_ATT * MiB), DM, args.in[I_WO], mod1 + 2 * DM, nullptr, nullptr, true));
    PH(15) norm_phase<true>(F, args, args.out, XC, NLAT, args.in[I_NORMG] + 3 * DM, mod1, 3, (bf16*)(ar + AR_H4 * MiB));
    GRID_BAR();
    CHK(chk::c_route(F, CK, mod1, ar + AR_H4 * MiB));
    LAS int* const tab = (LAS int*)(F.lds + MOET_OFF);
    { FRESH();
      if (F.tid == 0) { int base = 0;
          for (int e = 0; e < NEXP; ++e) { const int c = (int)__hip_atomic_load((unsigned*)F.ctl + CW_CNT + 64 * e, RLX_AGENT); tab[e] = base; tab[16 + e] = c; base += (c + 255) >> 8; }
          tab[8] = base; }
      __syncthreads(); }
    const int TT = tab[8];
    const unsigned* const list = (const unsigned*)(ws + WS_LIST);
    PH(16) { pg8::Gemm g{(const bf16*)(ar + AR_H4 * MiB), (const bf16*)(ws + WS_EW13), TT * 256, 2 * DEXP, DM / 2, 0x7f7f7f7f, SC_W13 * 0x01010101};
      MoeOrder S; S.so.init(TT * 256, 2 * DEXP, G, cid); S.nN = 2 * DEXP / 256; S.tab = tab; S.list = list; S.tok0 = 0;
      epi::EpiSwiGluF8 E{ar + AR_ACTE * MiB, DEXP, 2 * DEXP / 256};
      pg8::gemm_phase<epi::EpiSwiGluF8, MoeOrder, true, true, true>(ring, g, S, E, F.wave); }
    GRID_BAR();
    CHK(chk::c_moe_up(F, CK, tab, ar + AR_H4 * MiB, ar + AR_ACTE * MiB));
    PH(17) { pg8::Gemm g{(const bf16*)(ar + AR_ACTE * MiB), (const bf16*)(ws + WS_EW2), TT * 256, DM, DEXP / 2, 0x7f7f7f7f, SC_W2 * 0x01010101};
      MoeOrder S; S.so.init(TT * 256, DM, G, cid); S.nN = DM / 256; S.tab = tab; S.list = list; S.tok0 = 0;
      epi::EpiMoeDown E{(bf16*)(ar + AR_Y * MiB), list, tab};
      pg8::gemm_phase<epi::EpiMoeDown, MoeOrder, true, false, true>(ring, g, S, E, F.wave); }
    GRID_BAR();
    CHK(chk::c_moe_down(F, CK, tab, ar + AR_ACTE * MiB, (const bf16*)(ar + AR_Y * MiB)));
    CHK(chk::c_cap_rows(F, CK));
    PH(18) combine_phase(F, args, (const bf16*)(ar + AR_Y * MiB), mod1, (DROPMASK & 8) ? 0.f : 1.f);
#if SELFCHECK
    GRID_BAR(); CHK(chk::c_combine(F, CK, mod1, (const bf16*)(ar + AR_Y * MiB)));
    { FRESH(); int code = -1;
      for (int k = 39; k >= 0; --k) { const unsigned f = __hip_atomic_load(CK.dbg + 64 * k, RLX_AGENT), n = __hip_atomic_load(CK.dbg + 64 * k + 1, RLX_AGENT); if (f * 50u > n) code = k; }
      if (code >= 0) { const float v = sqrtf((float)(code + 1)); for (size_t i = (size_t)blockIdx.x * 512 + F.tid; i < (size_t)NLAT * DM; i += (size_t)gridDim.x * 512) args.out[i] = v; } }
#endif
#undef GRID_BAR
}

extern "C" void kernel_launch(void* const* d_in, const int* in_sizes, int n_in, void* d_out, int out_size, void* d_ws, size_t ws_size, hipStream_t stream) {
    static int grid = 0;
    if (grid == 0) {
        if (n_in != 31 || in_sizes[0] != NLAT * DM || out_size != NLAT * DM || ws_size < WS_END) {
            fprintf(stderr, "kernel_launch: shape mismatch: n_in %d in0 %d out %d ws %zu (need %zu); nothing launched\n", n_in, n_in > 0 ? in_sizes[0] : -1, out_size, ws_size, (size_t)WS_END); grid = -1; return; }
        int dev = 0, cus = 0, per_cu = 0;
        if (hipGetDevice(&dev) != hipSuccess || hipDeviceGetAttribute(&cus, hipDeviceAttributeMultiprocessorCount, dev) != hipSuccess) { fprintf(stderr, "kernel_launch: device query failed\n"); grid = -1; return; }
        if (hipFuncSetAttribute((const void*)fwd_kernel, hipFuncAttributeMaxDynamicSharedMemorySize, LDS_BYTES) != hipSuccess) { fprintf(stderr, "kernel_launch: hipFuncSetAttribute failed\n"); grid = -1; return; }
        if (hipOccupancyMaxActiveBlocksPerMultiprocessor(&per_cu, (const void*)fwd_kernel, NWAVES * 64, LDS_BYTES) != hipSuccess || per_cu < 1) {
            fprintf(stderr, "kernel_launch: occupancy query reports %d workgroups per CU; nothing launched\n", per_cu); (void)hipGetLastError(); grid = -1; return; }
        grid = cus;
    }
    if (grid < 0) return;
    if (hipMemsetAsync((char*)d_ws + WS_CTL, 0, CTL_ZERO_BYTES, stream) != hipSuccess) { fprintf(stderr, "kernel_launch: memset failed\n"); return; }
    Args a{};
    for (int i = 0; i < 31; ++i) a.in[i] = (const float*)d_in[i];
    a.out = (float*)d_out; a.ws = (unsigned char*)d_ws;
    hipLaunchKernelGGL(fwd_kernel, dim3(grid), dim3(NWAVES * 64), LDS_BYTES, stream, a);
    const hipError_t le = hipPeekAtLastError();
    if (le != hipSuccess) fprintf(stderr, "kernel_launch: launch failed: %s\n", hipGetErrorName(le));
}
```

```cpp
#include <hip/hip_runtime.h>
#include <cstdio>
#include <cstdint>
#ifndef DUPMASK
#define DUPMASK 0u
#endif
#ifndef FFN_FP8
#define FFN_FP8 2
#endif
#ifndef DROPMASK
#define DROPMASK 0
#endif

__device__ __forceinline__ int fresh_lane() { int l; asm volatile("v_mbcnt_lo_u32_b32 %0, -1, 0\n\tv_mbcnt_hi_u32_b32 %0, -1, %0" : "=v"(l)); return l; }
namespace pg8 {
#define PG8_LAS __attribute__((address_space(3)))
typedef unsigned short bf16_t;
typedef short bf16x8 __attribute__((ext_vector_type(8)));
typedef float f32x4 __attribute__((ext_vector_type(4)));
typedef unsigned u32x4 __attribute__((ext_vector_type(4)));
constexpr int BM = 256, BK = 64, HALF = 128, HTB = HALF * BK * 2  , STAGE_BYTES = 8 * HTB, NXCD = 8, WGM = 8;

__host__ __device__ __forceinline__ int lds_byte(int r, int c) { const int st = (r >> 4) * 2 + (c >> 5), rr = r & 15, cc = c & 31, ob = rr * 64 + cc * 2; return st * 1024 + (ob ^ (((ob >> 9) & 1) << 5)); }
__host__ __device__ __forceinline__ void stage_rc(int b, int& R, int& C) { const int st = b / 1024, sb = b % 1024, swz = sb ^ (((sb >> 9) & 1) << 5); R = (st >> 1) * 16 + swz / 64; C = (st & 1) * 32 + (swz % 64) / 2; }
__host__ __device__ __forceinline__ int perm32(int rho) { const int n = rho >> 4, i = rho & 15; return 8 * (i >> 2) + 4 * n + (i & 3); }

struct Unit { int pm, pn; };
struct Gemm { const bf16_t* A; const bf16_t* Bt; int M, N, K; int sa, sb; };
typedef int i32x4 __attribute__((ext_vector_type(4)));
typedef int i32x8 __attribute__((ext_vector_type(8)));

struct StaticOrder {
    int nM, nN, nwg, G, c;
    __host__ __device__ void init(int M, int N, int G_, int c_) { nM = M / BM; nN = N / BM; nwg = nM * nN; G = G_; c = c_; }
    __host__ __device__ bool next(int i, Unit& u) const {
        const long L = (long)i * G + c; if (L >= nwg) return false;
        int wgid = (int)L; { const int q = nwg / NXCD, r = nwg % NXCD, xcd = wgid % NXCD, off = wgid / NXCD; wgid = (xcd < r ? xcd * (q + 1) : r * (q + 1) + (xcd - r) * q) + off; }
        const int nig = WGM * nN, gid = wgid / nig, fm = gid * WGM, gsz = (nM - fm) < WGM ? (nM - fm) : WGM;
        u.pm = fm + ((wgid % nig) % gsz); u.pn = (wgid % nig) / gsz; return true;
    }
    __device__ __forceinline__ int arow(const Unit&, int) const { return 0; }
};

__device__ __forceinline__ unsigned cvt_pk_bf16(float lo, float hi) { unsigned r; asm volatile("v_cvt_pk_bf16_f32 %0, %1, %2" : "=v"(r) : "v"(lo), "v"(hi)); return r; }
__device__ __forceinline__ u32x4 pack8(const f32x4 a, const f32x4 b) { u32x4 w; w.x = cvt_pk_bf16(a[0], a[1]); w.y = cvt_pk_bf16(a[2], a[3]); w.z = cvt_pk_bf16(b[0], b[1]); w.w = cvt_pk_bf16(b[2], b[3]); return w; }

template <class Epi, class Sched, bool ALIGN_EPI = false, bool GATHER = false, bool FP8 = false>
__device__ __forceinline__ void gemm_phase(PG8_LAS unsigned char* lds, const Gemm g, const Sched& S, const Epi& E, int wave_id) {
    const int wid = __builtin_amdgcn_readfirstlane(wave_id), tid = wid * 64 + fresh_lane(), lane = tid & 63, wr = wid >> 2, wc = wid & 3, fr = lane & 15, fq = lane >> 4;
    const int K = g.K, nt = K / BK;
    unsigned voffA[2], voffB[2]; int RA[2], CA[2];
#pragma unroll
    for (int i = 0; i < 2; ++i) { int R, C; stage_rc(tid * 16 + i * 8192, R, C); const int Rb = Epi::PERM ? ((R & ~31) + perm32(R & 31)) : R;
        RA[i] = R; CA[i] = C; voffA[i] = (unsigned)(R * K + C) * 2u; voffB[i] = (unsigned)(Rb * K + C) * 2u; }
    const size_t kstep = (size_t)(BK * 2);
    const size_t hstep = (size_t)HALF * K * 2;
    const size_t tstep = 2 * hstep;
    const unsigned ldsw = (unsigned)wid * 1024u;
    const int aoff = lds_byte(wr * 64 + fr, fq * 8), boff = lds_byte(wc * 32 + fr, fq * 8);
#define PG8_SA(b, h) (((b) * 2 + (h)) * HTB)
#define PG8_SB(b, h) ((4 + (b) * 2 + (h)) * HTB)
#define PG8_GLDS(gp, loff) __builtin_amdgcn_global_load_lds((const unsigned*)(gp), (PG8_LAS unsigned*)(lds + (loff)), 16, 0, 0)
#define PG8_STAGE(bufoff, gbase, voff) do { _Pragma("unroll") for (int _i = 0; _i < 2; ++_i) PG8_GLDS((const char*)(gbase) + (voff)[_i], (bufoff) + ldsw + _i * 8192); } while (0)
#define PG8_STAGE_A(bufoff, ptr_ng, ptr_g, h, nx) do { if constexpr (GATHER) { const unsigned _o0 = (nx) ? gn[h][0] : gc[h][0], _o1 = (nx) ? gn[h][1] : gc[h][1]; \
        PG8_GLDS((const char*)(ptr_g) + _o0, (bufoff) + ldsw); PG8_GLDS((const char*)(ptr_g) + _o1, (bufoff) + ldsw + 8192); } \
    else { PG8_STAGE(bufoff, (const char*)(ptr_ng) + (h) * hstep, voffA); } } while (0)
#define PG8_MAP(u, go) do { _Pragma("unroll") for (int _h = 0; _h < 2; ++_h) _Pragma("unroll") for (int _i = 0; _i < 2; ++_i) go[_h][_i] = ((unsigned)S.arow(u, _h * HALF + RA[_i]) * (unsigned)K + (unsigned)CA[_i]) * 2u; } while (0)
#define PG8_LD16(off) (*(const PG8_LAS bf16x8*)(lds + (off)))
#define PG8_CAT(x0, x1) __builtin_shufflevector(__builtin_bit_cast(i32x4, x0), __builtin_bit_cast(i32x4, x1), 0, 1, 2, 3, 4, 5, 6, 7)
#define PG8_LDA(dst, b, h) do { if constexpr (FP8) { _Pragma("unroll") for (int m = 0; m < 4; ++m) dst##8[m] = PG8_CAT(PG8_LD16(PG8_SA(b, h) + aoff + m * 2048), PG8_LD16(PG8_SA(b, h) + aoff + m * 2048 + 1024)); } \
    else { _Pragma("unroll") for (int m = 0; m < 4; ++m) _Pragma("unroll") for (int k = 0; k < 2; ++k) dst[m][k] = PG8_LD16(PG8_SA(b, h) + aoff + m * 2048 + k * 1024); } } while (0)
#define PG8_LDB(dst, b, h) do { if constexpr (FP8) { _Pragma("unroll") for (int n = 0; n < 2; ++n) dst##8[n] = PG8_CAT(PG8_LD16(PG8_SB(b, h) + boff + n * 2048), PG8_LD16(PG8_SB(b, h) + boff + n * 2048 + 1024)); } \
    else { _Pragma("unroll") for (int n = 0; n < 2; ++n) _Pragma("unroll") for (int k = 0; k < 2; ++k) dst[n][k] = PG8_LD16(PG8_SB(b, h) + boff + n * 2048 + k * 1024); } } while (0)
#define PG8_MMA(ai, bj, At, Bt) do { __builtin_amdgcn_s_setprio(1); if constexpr (FP8) { _Pragma("unroll") for (int m = 0; m < 4; ++m) _Pragma("unroll") for (int n = 0; n < 2; ++n) \
        asm volatile("v_mfma_scale_f32_16x16x128_f8f6f4 %0, %1, %2, %0, %3, %4 op_sel_hi:[0,0,0]" : "+v"(acc[ai][bj][m][n]) : "v"(Bt##8[n]), "v"(At##8[m]), "v"(vsb), "v"(vsa)); } \
    else { _Pragma("unroll") for (int m = 0; m < 4; ++m) _Pragma("unroll") for (int n = 0; n < 2; ++n) _Pragma("unroll") for (int k = 0; k < 2; ++k) \
        acc[ai][bj][m][n] = __builtin_amdgcn_mfma_f32_16x16x32_bf16(Bt[n][k], At[m][k], acc[ai][bj][m][n], 0, 0, 0); } __builtin_amdgcn_s_setprio(0); } while (0)
#define PG8_WAIT_V(n) asm volatile("s_waitcnt vmcnt(" #n ")" ::: "memory")
#define PG8_WAIT_L(n) asm volatile("s_waitcnt lgkmcnt(" #n ")" ::: "memory")
#define PG8_BAR __builtin_amdgcn_s_barrier()
#define PG8_SCHED __builtin_amdgcn_sched_barrier(0)
    Unit cur, nxt; int ui = 0;
    if (!S.next(0, cur)) return;
    const int vsa = g.sa, vsb = g.sb; (void)vsa; (void)vsb;
    f32x4 acc[2][2][4][2];
#pragma unroll
    for (int a = 0; a < 2; ++a)
#pragma unroll
        for (int b = 0; b < 2; ++b)
#pragma unroll
            for (int m = 0; m < 4; ++m)
#pragma unroll
                for (int n = 0; n < 2; ++n) acc[a][b][m][n] = (f32x4){0.f, 0.f, 0.f, 0.f};
    bf16x8 At[4][2], B0[2][2], B1[2][2]; i32x8 At8[4], B08[2], B18[2];
    unsigned gc[2][2] = {{0u, 0u}, {0u, 0u}}, gn[2][2] = {{0u, 0u}, {0u, 0u}};
    if constexpr (GATHER) { PG8_MAP(cur, gc); }
    const char* const gA = (const char*)g.A;
    const char* cA = GATHER ? gA : gA + (size_t)cur.pm * tstep; const char* cB = (const char*)g.Bt + (size_t)cur.pn * tstep;
    PG8_STAGE(PG8_SB(0, 0), cB, voffB); PG8_STAGE(PG8_SB(0, 1), cB + hstep, voffB); PG8_STAGE_A(PG8_SA(0, 0), cA, gA, 0, false); PG8_STAGE_A(PG8_SA(0, 1), cA, gA, 1, false);
    if (wr == 1) PG8_BAR;
    PG8_WAIT_V(2); PG8_BAR;
    PG8_STAGE(PG8_SB(1, 0), cB + kstep, voffB); PG8_STAGE_A(PG8_SA(1, 0), cA + kstep, gA + kstep, 0, false); PG8_STAGE(PG8_SB(1, 1), cB + hstep + kstep, voffB);
    PG8_WAIT_V(6); PG8_BAR;
    for (;;) {
        const bool has_next = S.next(ui + 1, nxt);
        if constexpr (GATHER) { if (has_next) { PG8_MAP(nxt, gn); } else {
#pragma unroll
            for (int h = 0; h < 2; ++h)
#pragma unroll
                for (int i = 0; i < 2; ++i) gn[h][i] = gc[h][i]; } }
        const char* nA = GATHER ? gA : (has_next ? gA + (size_t)nxt.pm * tstep : cA); const char* nB = has_next ? (const char*)g.Bt + (size_t)nxt.pn * tstep : cB;
#pragma unroll 1
        for (int t = 0; t < nt; t += 2) {
            const bool last = (t == nt - 2);
            const char* a1 = cA + (size_t)(t + 1) * kstep;
            const char* a2 = last ? nA : cA + (size_t)(t + 2) * kstep; const char* b2 = last ? nB : cB + (size_t)(t + 2) * kstep;
            const char* a3 = a2 + kstep; const char* b3 = b2 + kstep;
            PG8_LDB(B0, 0, 0); PG8_LDB(B1, 0, 1); PG8_SCHED; PG8_LDA(At, 0, 0); PG8_STAGE_A(PG8_SA(1, 1), a1, a1, 1, false);
            PG8_WAIT_V(8); PG8_WAIT_L(0); PG8_BAR; PG8_MMA(0, 0, At, B0); PG8_MMA(0, 1, At, B1); PG8_BAR; PG8_SCHED;
            PG8_LDA(At, 0, 1); PG8_STAGE(PG8_SB(0, 0), b2, voffB); PG8_STAGE(PG8_SB(0, 1), b2 + hstep, voffB); PG8_STAGE_A(PG8_SA(0, 0), a2, a2, 0, last);
            PG8_WAIT_V(8); PG8_WAIT_L(0); PG8_BAR; PG8_MMA(1, 0, At, B0); PG8_MMA(1, 1, At, B1); PG8_BAR; PG8_SCHED;
            PG8_LDB(B0, 1, 0); PG8_LDB(B1, 1, 1); PG8_SCHED; PG8_LDA(At, 1, 0); PG8_STAGE_A(PG8_SA(0, 1), a2, a2, 1, last);
            PG8_WAIT_V(8); PG8_WAIT_L(0); PG8_BAR; PG8_MMA(0, 0, At, B0); PG8_MMA(0, 1, At, B1); PG8_BAR; PG8_SCHED;
            PG8_LDA(At, 1, 1); PG8_STAGE(PG8_SB(1, 0), b3, voffB); PG8_STAGE(PG8_SB(1, 1), b3 + hstep, voffB); PG8_STAGE_A(PG8_SA(1, 0), a3, a3, 0, last);
            PG8_WAIT_V(8); PG8_WAIT_L(0); PG8_BAR; PG8_MMA(1, 0, At, B0); PG8_MMA(1, 1, At, B1); PG8_BAR; PG8_SCHED;
        }
        if constexpr (ALIGN_EPI) { if (wr == 0) PG8_BAR; }
        if constexpr (FP8) { asm volatile("s_nop 15\n\ts_nop 15" ::: "memory"); }
        E(acc, cur, wr, wc, fr, fq);
        if (!has_next) break;
#pragma unroll
        for (int a = 0; a < 2; ++a)
#pragma unroll
            for (int b = 0; b < 2; ++b)
#pragma unroll
                for (int m = 0; m < 4; ++m)
#pragma unroll
                    for (int n = 0; n < 2; ++n) acc[a][b][m][n] = (f32x4){0.f, 0.f, 0.f, 0.f};
        cur = nxt; cA = nA; cB = nB; ++ui;
        if constexpr (GATHER) {
#pragma unroll
            for (int h = 0; h < 2; ++h)
#pragma unroll
                for (int i = 0; i < 2; ++i) gc[h][i] = gn[h][i]; }
        if constexpr (ALIGN_EPI) { if (wr == 1) PG8_BAR; }
    }
    PG8_WAIT_V(0);
    if constexpr (!ALIGN_EPI) { if (wr == 0) PG8_BAR; }
    PG8_BAR;
#undef PG8_SA
#undef PG8_SB
#undef PG8_GLDS
#undef PG8_STAGE
#undef PG8_STAGE_A
#undef PG8_MAP
#undef PG8_LDA
#undef PG8_LD16
#undef PG8_LDB
#undef PG8_MMA
#undef PG8_CAT
#undef PG8_WAIT_V
#undef PG8_WAIT_L
#undef PG8_BAR
#undef PG8_SCHED
}
}
constexpr int NWAVES = 8;
constexpr int DM = 1024, NB = 8, SEQ = 4096, CTXL = 256;
constexpr int NLAT = NB * SEQ, NCTX = NB * CTXL, MALL = NLAT + NCTX;
constexpr int ACH = 512, BCH = 512, CONVK = 31, CHUNK = 128;
constexpr int DFF = 2816, NEXP = 8, DEXP = 3584;
constexpr int QRANK = 384, KVRANK = 256, ROPE = 64, INO = 704, INO_PAD = 768, NHEAD = 8, QKD = 192, VHD = 128;
constexpr int SKV = CTXL + SEQ;
constexpr float EPS = 1e-6f;
constexpr float ATTN_SCALE = 0.07216878364870322f;
constexpr int LIST_CAP = NLAT;
constexpr int XROWS = 2 * NLAT + NEXP * 256;
constexpr int SC_W13 = 127 - 5, SC_W2 = 127 - 6;
constexpr int MODW = 6 * DM;

constexpr size_t MiB = 1u << 20;
constexpr size_t WS_CTL = 0, CTL_ZERO_BYTES = 1 * MiB;
constexpr size_t WS_MOD = 1 * MiB;
constexpr size_t WS_ROPE = 1 * MiB + 512 * 1024;
constexpr size_t WS_TOKG = 1 * MiB + 768 * 1024;
constexpr size_t WS_LIST = 2 * MiB;
constexpr size_t WS_WIN = 4 * MiB, WS_WOUT = 8 * MiB, WS_W13 = 10 * MiB, WS_W2 = 21 * MiB, WS_WINO = 27 * MiB, WS_WUQ = 29 * MiB, WS_WUKV = 31 * MiB, WS_WO = 32 * MiB;
constexpr size_t WS_WSB = 3 * MiB;
constexpr size_t WS_EW13 = 34 * MiB, WS_EW2 = 90 * MiB, WS_ARENA = 118 * MiB;
static_assert(WS_W2 + (size_t)DM * DFF * 2 <= WS_WINO && WS_WINO + (size_t)INO_PAD * DM * 2 <= WS_WUQ && WS_WUQ + (size_t)1536 * QRANK * 2 <= WS_WUKV && WS_WUKV + (size_t)2048 * KVRANK * 2 <= WS_WO && WS_WO + (size_t)DM * DM * 2 <= 34 * MiB && WS_LIST + (size_t)NEXP * LIST_CAP * 4 <= WS_WSB, "weight map");
static_assert(WS_EW13 + (size_t)NEXP * 2 * DEXP * DM == WS_EW2 && WS_EW2 + (size_t)NEXP * DM * DEXP == WS_ARENA, "expert weight map");
constexpr size_t AR_XC = 0, AR_H = 8, AR_AG = 76, AR_UG = 110, AR_VG = 144, AR_ACT = 76, AR_Z = 76, AR_QN = 127, AR_KVN = 151, AR_KPE = 168, AR_Q = 173, AR_KN = 0, AR_V = 269, AR_ATT = 68;
constexpr size_t AR_H4 = 0, AR_Y = 32, AR_ACTE = 160, AR_END = 392;
constexpr size_t WS_END = WS_ARENA + AR_END * MiB;
static_assert(AR_ACT * MiB + (size_t)MALL * DFF * 2 <= AR_V * MiB && AR_ACTE * MiB + (size_t)XROWS * DEXP <= AR_END * MiB && (AR_V + 68) <= AR_END, "arena");
constexpr int CW_TMO = 0, CW_CODE = 1, CW_BAR = 4096, CW_CNT = 16384;

constexpr int RING_OFF = 0, RING_BYTES = 139264;
constexpr int LDSCTL_OFF = RING_BYTES, MISC_OFF = LDSCTL_OFF + 320, MOET_OFF = LDSCTL_OFF + 512;
constexpr int LDS_BYTES = 147456;

#define GAS __attribute__((address_space(1)))
#define LAS __attribute__((address_space(3)))
typedef unsigned short bf16;
typedef unsigned v4u __attribute__((ext_vector_type(4)));
typedef unsigned v2u __attribute__((ext_vector_type(2)));
typedef float f32x4 __attribute__((ext_vector_type(4)));
typedef float f32x2 __attribute__((ext_vector_type(2)));
typedef short bf16x8 __attribute__((ext_vector_type(8)));
typedef GAS unsigned gu32;
#define RLX_AGENT __ATOMIC_RELAXED, __HIP_MEMORY_SCOPE_AGENT
#define LDS_WAIT() asm volatile("s_waitcnt lgkmcnt(0)" ::: "memory")
#define VM_WAIT() asm volatile("s_waitcnt vmcnt(0)" ::: "memory")
using pg8::cvt_pk_bf16; using pg8::pack8;
__device__ __forceinline__ float bf_lo(unsigned w) { return __builtin_bit_cast(float, w << 16); }
__device__ __forceinline__ float bf_hi(unsigned w) { return __builtin_bit_cast(float, w & 0xffff0000u); }
__device__ __forceinline__ unsigned pk_fp8x4(float a, float b, float c, float d) { int w = 0; w = __builtin_amdgcn_cvt_pk_fp8_f32(a, b, w, false); w = __builtin_amdgcn_cvt_pk_fp8_f32(c, d, w, true); return (unsigned)w; }
__device__ __forceinline__ float fsigmoid(float x) { return __builtin_amdgcn_rcpf(1.0f + __builtin_amdgcn_exp2f(-1.4426950408889634f * x)); }
__device__ __forceinline__ float fsilu(float x) { return x * fsigmoid(x); }
__device__ __forceinline__ float fgelu(float x) { const float u = 0.7978845608028654f * (x + 0.044715f * x * x * x); return x * fsigmoid(2.0f * u); }
template <int K> __device__ __forceinline__ float lane_xor(float v) { return __builtin_bit_cast(float, __builtin_amdgcn_ds_swizzle(__builtin_bit_cast(int, v), (K << 10) | 0x1f)); }
__device__ __forceinline__ float wave_sum(float v) {
    v += lane_xor<1>(v); v += lane_xor<2>(v); v += lane_xor<4>(v); v += lane_xor<8>(v); v += lane_xor<16>(v);
    return __builtin_bit_cast(float, __builtin_amdgcn_readlane(__builtin_bit_cast(int, v), 0)) + __builtin_bit_cast(float, __builtin_amdgcn_readlane(__builtin_bit_cast(int, v), 32));
}

#define XB_TMO      128
#define XB_XCNT(j)  (256  + 64 * (j))
#define XB_XSUB(j)  (1280 + 64 * (j))
#define XB_XGEN(j)  (2304 + 64 * (j))
#define XB_TOP      3328
#define XB_TOPGEN   3392
#define XCD_BAR_WORDS 3456
#define XB_SPIN_CAP (1u << 18)

__device__ __forceinline__ unsigned xb_ld(unsigned* p)              { return __hip_atomic_load(p, __ATOMIC_RELAXED, __HIP_MEMORY_SCOPE_AGENT); }
__device__ __forceinline__ unsigned xb_add(unsigned* p, unsigned v) { return __hip_atomic_fetch_add(p, v, __ATOMIC_RELAXED, __HIP_MEMORY_SCOPE_AGENT); }
__device__ __forceinline__ unsigned xb_xcc_id() { return (unsigned)__builtin_amdgcn_s_getreg((3 << 11) | 20) & 0xFu; }
#define XB_SPIN(cond, bar) do { unsigned _sp = 0; while (cond) { __builtin_amdgcn_s_sleep(1); \
    if ((++_sp & 255u) == 0u) { if (xb_ld(&(bar)[XB_TMO])) break; if (_sp > XB_SPIN_CAP) { atomicAdd(&(bar)[XB_TMO], 1u); break; } } } } while (0)

struct XcdBarrier {
    unsigned* bar; unsigned x;
    volatile LAS unsigned* st;
};

__device__ __forceinline__ XcdBarrier xcd_barrier_post(unsigned* bar, volatile LAS unsigned* st) {
    XcdBarrier b; b.bar = bar; b.x = xb_xcc_id(); b.st = st;
    if (threadIdx.x == 0) (void)xb_add(&bar[XB_XCNT(b.x)], 1u);
    return b;
}
__device__ __forceinline__ void xcd_barrier_complete(unsigned* bar, unsigned x, unsigned& nloc, unsigned& nx) {
    const unsigned G = gridDim.x * gridDim.y * gridDim.z;
    unsigned sum, cnt, mine, sp = 0u;
    for (;;) {
        sum = 0u; cnt = 0u; mine = 0u;
#pragma unroll
        for (unsigned j = 0; j < 16; ++j) { const unsigned c = xb_ld(&bar[XB_XCNT(j)]); sum += c; cnt += (c > 0u) ? 1u : 0u; mine = (j == x) ? c : mine; }
        if (sum == G) break;
        __builtin_amdgcn_s_sleep(1);
        if ((++sp & 255u) == 0u) { if (xb_ld(&bar[XB_TMO])) break; if (sp > XB_SPIN_CAP) { atomicAdd(&bar[XB_TMO], 1u); break; } }
    }
    nloc = mine > 0u ? mine : 1u; nx = cnt > 0u ? cnt : 1u;
}

__device__ __forceinline__ void xcd_barrier(const XcdBarrier& b, int wave_id) {
    const bool t0 = (wave_id == 0) && (fresh_lane() == 0);
    asm volatile("s_waitcnt vmcnt(0)" ::: "memory");
    __syncthreads();
    if (t0) {
        unsigned* bar = b.bar;
        __builtin_amdgcn_s_waitcnt(0);
        unsigned nloc = b.st[0], nx = b.st[1];
        if (nloc == 0u) { xcd_barrier_complete(bar, b.x, nloc, nx); b.st[0] = nloc; b.st[1] = nx; }
        const unsigned old = xb_add(&bar[XB_XSUB(b.x)], 1u);
        const unsigned gen = old / nloc;
        if (old + 1u == (gen + 1u) * nloc) {
            __builtin_amdgcn_fence(__ATOMIC_RELEASE, "agent");
            asm volatile("s_waitcnt vmcnt(0)" ::: "memory");
            const unsigned og = xb_add(&bar[XB_TOP], 1u);
            const unsigned tg = og / nx;
            if (og + 1u == (tg + 1u) * nx) xb_add(&bar[XB_TOPGEN], 1u);
            else XB_SPIN(xb_ld(&bar[XB_TOPGEN]) == tg, bar);
            __builtin_amdgcn_fence(__ATOMIC_ACQUIRE, "agent");
            xb_add(&bar[XB_XGEN(b.x)], 1u);
            asm volatile("s_waitcnt vmcnt(0)" ::: "memory");
        } else {
            XB_SPIN(xb_ld(&bar[XB_XGEN(b.x)]) == gen, bar);
            __builtin_amdgcn_fence(__ATOMIC_ACQUIRE, "agent");
            asm volatile("s_waitcnt vmcnt(0)" ::: "memory");
        }
    }
    __syncthreads();
}
namespace epi {
using pg8::Unit; using pg8::f32x4; using pg8::u32x4; using pg8::bf16_t; using pg8::HALF; using pg8::BM;
#define EPI_ST16(base, off, val) (*(u32x4*)((char*)(base) + (unsigned)(off)) = (val))
struct EpiMixIn {
    static constexpr bool PERM = true;
    bf16_t *AG, *UG, *VG;
    __device__ __forceinline__ void operator()(const f32x4 (&acc)[2][2][4][2], const Unit& u, int wr, int wc, int fr, int fq) const {
        const int cw = wc * 32 + 8 * fq;
        if (u.pn < 4) {
            char* tb = (char*)(AG + (size_t)u.pm * (BM * ACH)); const unsigned lo = (unsigned)((wr * 64 + fr) * ACH + u.pn * 128 + cw) * 2u;
#pragma unroll
            for (int ai = 0; ai < 2; ++ai)
#pragma unroll
                for (int m = 0; m < 4; ++m) { f32x4 o0, o1;
#pragma unroll
                    for (int e = 0; e < 4; ++e) { o0[e] = acc[ai][0][m][0][e] * fsigmoid(acc[ai][1][m][0][e]); o1[e] = acc[ai][0][m][1][e] * fsigmoid(acc[ai][1][m][1][e]); }
                    EPI_ST16(tb + (ai * HALF + m * 16) * ACH * 2, lo, pack8(o0, o1)); }
        } else {
            char* tb = (char*)(((u.pn < 6) ? UG : VG) + (size_t)u.pm * (BM * BCH)); const unsigned lo = (unsigned)((wr * 64 + fr) * BCH + (u.pn & 1) * 256 + cw) * 2u;
#pragma unroll
            for (int ai = 0; ai < 2; ++ai)
#pragma unroll
                for (int m = 0; m < 4; ++m)
#pragma unroll
                    for (int bj = 0; bj < 2; ++bj) { f32x4 o0, o1;
#pragma unroll
                        for (int e = 0; e < 4; ++e) { o0[e] = fgelu(acc[ai][bj][m][0][e]); o1[e] = fgelu(acc[ai][bj][m][1][e]); }
                        EPI_ST16(tb + ((ai * HALF + m * 16) * BCH + bj * HALF) * 2, lo, pack8(o0, o1)); }
        }
    }
};
struct EpiSwiGlu {
    static constexpr bool PERM = true;
    bf16_t* O; int ldc, npn;
    __device__ __forceinline__ void operator()(const f32x4 (&acc)[2][2][4][2], const Unit& u, int wr, int wc, int fr, int fq) const {
        char* tb = (char*)(O + (size_t)u.pm * BM * ldc); const unsigned lo = (unsigned)((wr * 64 + fr) * ldc + (u.pn % npn) * 128 + wc * 32 + 8 * fq) * 2u;
#pragma unroll
        for (int ai = 0; ai < 2; ++ai)
#pragma unroll
            for (int m = 0; m < 4; ++m) { f32x4 o0, o1;
#pragma unroll
                for (int e = 0; e < 4; ++e) { o0[e] = fsilu(acc[ai][0][m][0][e]) * acc[ai][1][m][0][e]; o1[e] = fsilu(acc[ai][0][m][1][e]) * acc[ai][1][m][1][e]; }
                EPI_ST16(tb + (size_t)(ai * HALF + m * 16) * ldc * 2, lo, pack8(o0, o1)); }
    }
};
struct EpiSwiGluF8 {
    static constexpr bool PERM = true;
    unsigned char* O; int ldc, npn;
    __device__ __forceinline__ void operator()(const f32x4 (&acc)[2][2][4][2], const Unit& u, int wr, int wc, int fr, int fq) const {
        char* tb = (char*)(O + (size_t)u.pm * BM * ldc); const unsigned lo = (unsigned)((wr * 64 + fr) * ldc + (u.pn % npn) * 128 + wc * 32 + 8 * fq);
#pragma unroll
        for (int ai = 0; ai < 2; ++ai)
#pragma unroll
            for (int m = 0; m < 4; ++m) { f32x4 o0, o1;
#pragma unroll
                for (int e = 0; e < 4; ++e) { o0[e] = fsilu(acc[ai][0][m][0][e]) * acc[ai][1][m][0][e]; o1[e] = fsilu(acc[ai][0][m][1][e]) * acc[ai][1][m][1][e]; }
                v2u w; w.x = pk_fp8x4(o0[0], o0[1], o0[2], o0[3]); w.y = pk_fp8x4(o1[0], o1[1], o1[2], o1[3]);
                *(v2u*)(tb + (size_t)(ai * HALF + m * 16) * ldc + lo) = w; }
    }
};
struct EpiPlain {
    static constexpr bool PERM = true;
    bf16_t* O; int ldc;
    __device__ __forceinline__ void operator()(const f32x4 (&acc)[2][2][4][2], const Unit& u, int wr, int wc, int fr, int fq) const {
        char* tb = (char*)(O + (size_t)u.pm * BM * ldc + u.pn * BM); const unsigned lo = (unsigned)((wr * 64 + fr) * ldc + wc * 32 + 8 * fq) * 2u;
#pragma unroll
        for (int ai = 0; ai < 2; ++ai)
#pragma unroll
            for (int m = 0; m < 4; ++m)
#pragma unroll
                for (int bj = 0; bj < 2; ++bj) EPI_ST16(tb + ((size_t)(ai * HALF + m * 16) * ldc + bj * HALF) * 2, lo, pack8(acc[ai][bj][m][0], acc[ai][bj][m][1]));
    }
};
struct EpiResid {
    static constexpr bool PERM = false;
    const float *srcL, *srcC; float *dstL, *dstC; const float* gate; float mul;
    __device__ __forceinline__ void operator()(const f32x4 (&acc)[2][2][4][2], const Unit& u, int wr, int wc, int fr, int fq) const {
        const bool lat = u.pm < NLAT / BM; const int bi = lat ? (u.pm >> 4) : 8;
        const size_t tb = (size_t)(lat ? u.pm : u.pm - NLAT / BM) * (BM * DM) + u.pn * BM;
        const char* src = (const char*)((lat ? srcL : srcC) + tb); char* dst = (char*)((lat ? dstL : dstC) + tb); const float* gp = gate + bi * MODW + u.pn * BM;
        const unsigned lo = (unsigned)((wr * 64 + fr) * DM + wc * 32 + 4 * fq) * 4u, lg = (unsigned)(wc * 32 + 4 * fq) * 4u;
        f32x4 gv[2][2];
#pragma unroll
        for (int bj = 0; bj < 2; ++bj)
#pragma unroll
            for (int n = 0; n < 2; ++n) gv[bj][n] = *(const f32x4*)((const char*)gp + (bj * HALF + n * 16) * 4 + lg) * mul;
#pragma unroll
        for (int ai = 0; ai < 2; ++ai)
#pragma unroll
            for (int m = 0; m < 4; ++m) {
#pragma unroll
                for (int bj = 0; bj < 2; ++bj)
#pragma unroll
                    for (int n = 0; n < 2; ++n) { const int co = ((ai * HALF + m * 16) * DM + bj * HALF + n * 16) * 4;
                        const f32x4 bs = *(const f32x4*)(src + co + lo); *(f32x4*)(dst + co + lo) = bs + gv[bj][n] * acc[ai][bj][m][n]; }
                if (m & 1) asm volatile("" ::: "memory"); }
    }
};
struct EpiQ {
    static constexpr bool PERM = true;
    bf16_t* Q; const float* rope;
    __device__ __forceinline__ void operator()(const f32x4 (&acc)[2][2][4][2], const Unit& u, int wr, int wc, int fr, int fq) const {
        const int b = u.pm >> 4, t0 = (u.pm & 15) * BM, rl = wr * 64 + fr;
        if (u.pn < 4) {
#pragma unroll
            for (int bj = 0; bj < 2; ++bj) { char* tb = (char*)(Q + ((size_t)(b * NHEAD + 2 * u.pn + bj) * SEQ + t0) * QKD); const unsigned lo = (unsigned)(rl * QKD + wc * 32 + 8 * fq) * 2u;
#pragma unroll
                for (int ai = 0; ai < 2; ++ai)
#pragma unroll
                    for (int m = 0; m < 4; ++m) EPI_ST16(tb + (ai * HALF + m * 16) * QKD * 2, lo, pack8(acc[ai][bj][m][0], acc[ai][bj][m][1])); }
        } else {
            const int h = 4 * (u.pn - 4) + wc, a = fq >> 1, f0 = 8 * (fq & 1);
            char* tb = (char*)(Q + ((size_t)(b * NHEAD + h) * SEQ + t0) * QKD + 128); const unsigned lo = (unsigned)(rl * QKD + a * 32 + f0) * 2u;
#pragma unroll
            for (int ai = 0; ai < 2; ++ai)
#pragma unroll
                for (int m = 0; m < 4; ++m) { const int t = t0 + rl + ai * HALF + m * 16, pos = a ? (t & 63) : (t >> 6);
                    const char* cs = (const char*)rope + (unsigned)((pos * 16 + f0) * 8); f32x4 o1[2], o2[2];
#pragma unroll
                    for (int n = 0; n < 2; ++n) { const f32x4 c0 = *(const f32x4*)(cs + n * 32), c1 = *(const f32x4*)(cs + n * 32 + 16);
                        const f32x4 x1 = acc[ai][0][m][n], x2 = acc[ai][1][m][n];
                        o1[n][0] = x1[0] * c0[0] - x2[0] * c0[1]; o2[n][0] = x1[0] * c0[1] + x2[0] * c0[0];
                        o1[n][1] = x1[1] * c0[2] - x2[1] * c0[3]; o2[n][1] = x1[1] * c0[3] + x2[1] * c0[2];
                        o1[n][2] = x1[2] * c1[0] - x2[2] * c1[1]; o2[n][2] = x1[2] * c1[1] + x2[2] * c1[0];
                        o1[n][3] = x1[3] * c1[2] - x2[3] * c1[3]; o2[n][3] = x1[3] * c1[3] + x2[3] * c1[2]; }
                    EPI_ST16(tb + (ai * HALF + m * 16) * QKD * 2, lo, pack8(o1[0], o1[1])); EPI_ST16(tb + (ai * HALF + m * 16) * QKD * 2 + 32, lo, pack8(o2[0], o2[1]));
                    asm volatile("" ::: "memory"); }
        }
    }
};
struct EpiKV {
    static constexpr bool PERM = true;
    bf16_t *KN, *V;
    __device__ __forceinline__ void operator()(const f32x4 (&acc)[2][2][4][2], const Unit& u, int wr, int wc, int fr, int fq) const {
        const bool lat = u.pm < NLAT / BM; const int b = lat ? (u.pm >> 4) : (u.pm - NLAT / BM), key0 = lat ? CTXL + (u.pm & 15) * BM : 0;
        const size_t te = ((size_t)(b * NHEAD + u.pn) * SKV + key0) * VHD; char* kb = (char*)(KN + te); char* vb = (char*)(V + te);
        const unsigned lo = (unsigned)((wr * 64 + fr) * VHD + wc * 32 + 8 * fq) * 2u;
#pragma unroll
        for (int ai = 0; ai < 2; ++ai)
#pragma unroll
            for (int m = 0; m < 4; ++m) { EPI_ST16(kb + (ai * HALF + m * 16) * VHD * 2, lo, pack8(acc[ai][0][m][0], acc[ai][0][m][1])); EPI_ST16(vb + (ai * HALF + m * 16) * VHD * 2, lo, pack8(acc[ai][1][m][0], acc[ai][1][m][1])); }
    }
};
struct EpiMoeDown {
    static constexpr bool PERM = true;
    bf16_t* Y; const unsigned* list; const LAS int* tab;
    __device__ __forceinline__ void operator()(const f32x4 (&acc)[2][2][4][2], const Unit& u, int wr, int wc, int fr, int fq) const {
        const int e = u.pn >> 2, pnl = u.pn & 3, cnt = tab[16 + e], s0 = (u.pm - tab[e]) * BM + wr * 64 + fr; const unsigned cb = (unsigned)(pnl * BM + wc * 32 + 8 * fq) * 2u;
        const char* lp = (const char*)(list + e * LIST_CAP);
#pragma unroll
        for (int ai = 0; ai < 2; ++ai)
#pragma unroll
            for (int m = 0; m < 4; ++m) { const int slot = s0 + ai * HALF + m * 16;
                if (slot < cnt) { const unsigned ent = *(const unsigned*)(lp + (unsigned)slot * 4u), ro = ent * (unsigned)(DM * 2) + cb;
#pragma unroll
                    for (int bj = 0; bj < 2; ++bj) EPI_ST16(Y, ro + bj * HALF * 2, pack8(acc[ai][bj][m][0], acc[ai][bj][m][1])); } }
    }
};
}
struct MoeOrder {
    pg8::StaticOrder so; int nN; const LAS int* tab; const unsigned* list; int tok0;
    __device__ __forceinline__ bool next(int i, pg8::Unit& u) const {
        if (!so.next(i, u)) return false;
        int e = 0;
#pragma unroll
        for (int k = 1; k < NEXP; ++k) e += (u.pm >= tab[k]) ? 1 : 0;
        u.pn += e * nN; return true;
    }
    __device__ __forceinline__ int arow(const pg8::Unit& u, int r) const {
        const int e = u.pn / nN, cnt = tab[16 + e], slot = (u.pm - tab[e]) * pg8::BM + r;
        const unsigned ent = list[e * LIST_CAP + (slot < cnt ? slot : 0)];
        return tok0 + (int)(ent >> 1);
    }
};
struct Args { const float* in[31]; float* out; unsigned char* ws; };
struct Frame {
    LAS unsigned char* lds; volatile LAS unsigned* MISC; gu32* ctl;
    int tid, lane, wave, vcu, G;
};
enum { I_X = 0, I_C, I_CTX, I_CCTX, I_WADA, I_BADA, I_NORMG, I_EWIN, I_CONVW, I_CONVB, I_LNAG, I_LNAB, I_LNVG, I_LNVB, I_WS, I_BS, I_EWOUT, I_FW1, I_FW3, I_FW2,
       I_OWIN, I_GQ, I_GKV, I_WUQ, I_WUKV, I_WO, I_ROUTER, I_XW1, I_XW3, I_XW2, I_FINALG };

struct MapId   { int off; __device__ __forceinline__ int operator()(int n) const { return off + n; } };
struct MapPair { int half; __device__ __forceinline__ int operator()(int n) const { return 256 * (n >> 7) + 128 * half + (n & 127); } };
struct MapMixIn { __device__ __forceinline__ int operator()(int n) const { if (n >= 1024) return n; const int j = n & 511, hf = n >> 9; return 256 * (j >> 7) + 128 * hf + (j & 127); } };
struct MapUq { __device__ __forceinline__ int operator()(int n) const { const int h = n / QKD, d = n - h * QKD; if (d < 128) return h * 128 + d;
    const int dd = d - 128, a = dd >> 5, p = (dd >> 4) & 1, f = dd & 15; return 1024 + 256 * (h >> 2) + 128 * p + (h & 3) * 32 + a * 16 + f; } };
template <class Map>
__device__ __forceinline__ void p0_transpose_item(const float* W, int K, int N, bf16* WT, const Map& map, LAS float* scr, int item, int lane) {
    const int nblk = N / 32, kb = item / nblk, nb = item - kb * nblk, k0 = 64 * kb, n0 = 32 * nb;
    float rg[32];
    const float* Wl = W + (size_t)(k0 + (lane >> 5)) * N + n0 + (lane & 31);
#pragma unroll
    for (int i = 0; i < 32; ++i) rg[i] = __builtin_nontemporal_load(Wl + (size_t)(2 * i) * N);
#pragma unroll
    for (int i = 0; i < 32; ++i) scr[(2 * i + (lane >> 5)) * 33 + (lane & 31)] = rg[i];
    LDS_WAIT(); asm volatile("" ::: "memory");
    const int c = lane & 7;
#pragma unroll
    for (int j = 0; j < 4; ++j) { const int n = (lane >> 3) + 8 * j; const LAS float* s = scr + (8 * c) * 33 + n;
        v4u o; o.x = cvt_pk_bf16(s[0 * 33], s[1 * 33]); o.y = cvt_pk_bf16(s[2 * 33], s[3 * 33]); o.z = cvt_pk_bf16(s[4 * 33], s[5 * 33]); o.w = cvt_pk_bf16(s[6 * 33], s[7 * 33]);
        *(GAS v4u*)(WT + (size_t)map(n0 + n) * K + k0 + 8 * c) = o; }
    LDS_WAIT(); asm volatile("" ::: "memory");
}
template <class Map>
__device__ __forceinline__ void p0_transpose_item_f8(const float* W, int K, int N, unsigned char* WT, const Map& map, float mul, LAS float* scr, int item, int lane) {
    const int nblk = N / 32, kb = item / nblk, nb = item - kb * nblk, k0 = 64 * kb, n0 = 32 * nb;
    float rg[32];
    const float* Wl = W + (size_t)(k0 + (lane >> 5)) * N + n0 + (lane & 31);
#pragma unroll
    for (int i = 0; i < 32; ++i) rg[i] = __builtin_nontemporal_load(Wl + (size_t)(2 * i) * N);
#pragma unroll
    for (int i = 0; i < 32; ++i) scr[(2 * i + (lane >> 5)) * 33 + (lane & 31)] = rg[i] * mul;
    LDS_WAIT(); asm volatile("" ::: "memory");
#pragma unroll
    for (int j = 0; j < 2; ++j) { const int idx = lane + 64 * j, n = idx >> 2, c = idx & 3; const LAS float* s = scr + (16 * c) * 33 + n;
        v4u o; o.x = pk_fp8x4(s[0 * 33], s[1 * 33], s[2 * 33], s[3 * 33]); o.y = pk_fp8x4(s[4 * 33], s[5 * 33], s[6 * 33], s[7 * 33]);
        o.z = pk_fp8x4(s[8 * 33], s[9 * 33], s[10 * 33], s[11 * 33]); o.w = pk_fp8x4(s[12 * 33], s[13 * 33], s[14 * 33], s[15 * 33]);
        *(GAS v4u*)(WT + (size_t)map(n0 + n) * K + k0 + 16 * c) = o; }
    LDS_WAIT(); asm volatile("" ::: "memory");
}
__device__ __forceinline__ void sincos_d(double th, float& c, float& s) {
    const double q = __builtin_rint(th * 0.63661977236758134308); const int n = (int)q;
    const double r = (th - q * 1.5707963267948966192) - q * 6.123233995736766036e-17, r2 = r * r;
    double sp = -7.6471637318198164759e-13; sp = sp * r2 + 1.6059043836821614599e-10; sp = sp * r2 - 2.5052108385441718775e-08; sp = sp * r2 + 2.7557319223985890653e-06;
    sp = sp * r2 - 1.9841269841269841253e-04; sp = sp * r2 + 8.3333333333333332177e-03; sp = sp * r2 - 1.6666666666666665741e-01; const double sr = r + r * r2 * sp;
    double cp = 4.7794773323873852974e-14; cp = cp * r2 - 1.1470745597729724714e-11; cp = cp * r2 + 2.0876756987868098979e-09; cp = cp * r2 - 2.7557319223985888e-07;
    cp = cp * r2 + 2.4801587301587301566e-05; cp = cp * r2 - 1.3888888888888889419e-03; cp = cp * r2 + 4.1666666666666664354e-02; const double cr = 1.0 - 0.5 * r2 + r2 * r2 * cp;
    const int k = n & 3; const double sv = (k == 0) ? sr : (k == 1) ? cr : (k == 2) ? -sr : -cr, cv = (k == 0) ? cr : (k == 1) ? -sr : (k == 2) ? -cr : sr;
    c = (float)cv; s = (float)sv;
}
__device__ __forceinline__ double inv_freq_d(int f) {
    const int q = f >> 2, r = f & 3; const double rr = (r == 0) ? 1.0 : (r == 1) ? 0.5623413251903491 : (r == 2) ? 0.31622776601683794 : 0.1778279410038923;
    const double qq = (q == 0) ? 1.0 : (q == 1) ? 0.1 : (q == 2) ? 0.01 : 0.001; return rr * qq;
}
template <int PART>
__device__ __forceinline__ void p0_prologue(Frame& F, const Args& A) {
    unsigned char* ws = A.ws;
    __syncthreads();
    if constexpr (PART == 0) {
    for (int rep_ = 0; rep_ < (((DUPMASK >> 24) & 1u) ? 2 : 1); ++rep_) {
        __syncthreads();
        LAS float* sv = (LAS float*)(F.lds + RING_OFF);
        LAS float* part = (LAS float*)(F.lds + RING_OFF + 9 * 1024 * 4);
        for (int i = F.tid; i < 9 * DM; i += NWAVES * 64) { const float v = (i < 8 * DM) ? A.in[I_C][i] : A.in[I_CCTX][i - 8 * DM]; sv[i] = fsilu(v); }
        __syncthreads();
        float* mod = (float*)(ws + WS_MOD);
        for (int it = F.vcu; it < 2 * MODW / 48; it += F.G) {
            const int l = it / (MODW / 48), j0 = (it - l * (MODW / 48)) * 48;
            const float* W = A.in[I_WADA] + (size_t)l * DM * MODW;
            if (F.tid < 480) { const int cc = F.tid % 48, ks = F.tid / 48, kbeg = ks * 103, kend = (kbeg + 103 < DM) ? kbeg + 103 : DM;
                float a[9];
#pragma unroll
                for (int b = 0; b < 9; ++b) a[b] = 0.f;
#pragma unroll 1
                for (int k8 = kbeg; k8 < kend; k8 += 13) { float w[13];
#pragma unroll
                    for (int i = 0; i < 13; ++i) w[i] = (k8 + i < kend) ? W[(size_t)(k8 + i) * MODW + j0 + cc] : 0.f;
#pragma unroll
                    for (int i = 0; i < 13; ++i) { const int k = (k8 + i < kend) ? k8 + i : kbeg;
#pragma unroll
                        for (int b = 0; b < 9; ++b) a[b] += sv[b * DM + k] * w[i]; } }
#pragma unroll
                for (int b = 0; b < 9; ++b) part[(ks * 9 + b) * 48 + cc] = a[b]; }
            __syncthreads();
            if (F.tid < 9 * 48) { const int b = F.tid / 48, cc = F.tid % 48; float s = A.in[I_BADA][l * MODW + j0 + cc];
#pragma unroll
                for (int ks = 0; ks < 10; ++ks) s += part[(ks * 9 + b) * 48 + cc];
                mod[(size_t)(l * 9 + b) * MODW + j0 + cc] = s; }
            __syncthreads();
        }
    }
    if (F.vcu == 0) for (int i = F.tid; i < 64 * 16; i += NWAVES * 64) { float c, s; sincos_d((double)(i >> 4) * inv_freq_d(i & 15), c, s); ((float*)(ws + WS_ROPE))[2 * i] = c; ((float*)(ws + WS_ROPE))[2 * i + 1] = s; }
    { const int gt = F.vcu * NWAVES * 64 + F.tid, NT = F.G * NWAVES * 64;
      for (int i = gt; i < NEXP * CHUNK * CHUNK / 4; i += NT) { const f32x4 v = ((const f32x4*)A.in[I_WS])[i]; v2u o; o.x = cvt_pk_bf16(v[0], v[1]); o.y = cvt_pk_bf16(v[2], v[3]); ((v2u*)(ws + WS_WSB))[i] = o; }
      for (int i = gt; i < (INO_PAD - INO) * DM * 2 / 16; i += NT) ((v4u*)(ws + WS_WINO + (size_t)INO * DM * 2))[i] = (v4u){0u, 0u, 0u, 0u}; }
    __syncthreads();
    }
    LAS float* scr = (LAS float*)(F.lds + RING_OFF + F.wave * 16384);
    const int gw = F.vcu * NWAVES + F.wave, NGW = F.G * NWAVES;
#define ITEMS(K_, N_) (((K_) / 64) * ((N_) / 32))
    constexpr int I_1 = ITEMS(DM, 2048), I_2 = ITEMS(DM, DM), I_3 = ITEMS(DM, DFF), I_4 = ITEMS(DFF, DM), I_5 = ITEMS(DM, INO), I_6 = ITEMS(QRANK, 1536), I_7 = ITEMS(KVRANK, 2048), I_8 = ITEMS(DM, DM);
    constexpr int I_E1 = ITEMS(DM, DEXP), I_E2 = ITEMS(DEXP, DM);
    constexpr int NSMALL = I_1 + I_2 + 2 * I_3 + I_4 + I_5 + I_6 + I_7 + I_8, NITEMS = NSMALL + NEXP * (2 * I_E1 + I_E2);
    constexpr int IT_LO = PART == 0 ? 0 : NSMALL, IT_HI = PART == 0 ? NSMALL : NITEMS;
    for (int rep_ = 0; rep_ < (((DUPMASK >> 25) & 1u) ? 2 : 1); ++rep_)
    for (int it = IT_LO + gw; it < IT_HI; it += NGW) {
        int r = it;
        if (r < I_1) { p0_transpose_item(A.in[I_EWIN], DM, 2048, (bf16*)(ws + WS_WIN), MapMixIn{}, scr, r, F.lane); continue; } r -= I_1;
        if (r < I_2) { p0_transpose_item(A.in[I_EWOUT], DM, DM, (bf16*)(ws + WS_WOUT), MapId{0}, scr, r, F.lane); continue; } r -= I_2;
        if (r < I_3) { if (FFN_FP8 == 1) p0_transpose_item_f8(A.in[I_FW1], DM, DFF, ws + WS_W13, MapPair{0}, 32.0f, scr, r, F.lane); else p0_transpose_item(A.in[I_FW1], DM, DFF, (bf16*)(ws + WS_W13), MapPair{0}, scr, r, F.lane); continue; } r -= I_3;
        if (r < I_3) { if (FFN_FP8 == 1) p0_transpose_item_f8(A.in[I_FW3], DM, DFF, ws + WS_W13, MapPair{1}, 32.0f, scr, r, F.lane); else p0_transpose_item(A.in[I_FW3], DM, DFF, (bf16*)(ws + WS_W13), MapPair{1}, scr, r, F.lane); continue; } r -= I_3;
        if (r < I_4) { if (FFN_FP8) p0_transpose_item_f8(A.in[I_FW2], DFF, DM, ws + WS_W2, MapId{0}, 64.0f, scr, r, F.lane); else p0_transpose_item(A.in[I_FW2], DFF, DM, (bf16*)(ws + WS_W2), MapId{0}, scr, r, F.lane); continue; } r -= I_4;
        if (r < I_5) { p0_transpose_item(A.in[I_OWIN], DM, INO, (bf16*)(ws + WS_WINO), MapId{0}, scr, r, F.lane); continue; } r -= I_5;
        if (r < I_6) { p0_transpose_item(A.in[I_WUQ], QRANK, 1536, (bf16*)(ws + WS_WUQ), MapUq{}, scr, r, F.lane); continue; } r -= I_6;
        if (r < I_7) { p0_transpose_item(A.in[I_WUKV], KVRANK, 2048, (bf16*)(ws + WS_WUKV), MapId{0}, scr, r, F.lane); continue; } r -= I_7;
        if (r < I_8) { p0_transpose_item(A.in[I_WO], DM, DM, (bf16*)(ws + WS_WO), MapId{0}, scr, r, F.lane); continue; } r -= I_8;
        { const int per = 2 * I_E1 + I_E2, e = r / per; r -= e * per;
          if (r < I_E1) { p0_transpose_item_f8(A.in[I_XW1] + (size_t)e * DM * DEXP, DM, DEXP, ws + WS_EW13 + (size_t)e * 2 * DEXP * DM, MapPair{0}, 32.0f, scr, r, F.lane); continue; } r -= I_E1;
          if (r < I_E1) { p0_transpose_item_f8(A.in[I_XW3] + (size_t)e * DM * DEXP, DM, DEXP, ws + WS_EW13 + (size_t)e * 2 * DEXP * DM, MapPair{1}, 32.0f, scr, r, F.lane); continue; } r -= I_E1;
          p0_transpose_item_f8(A.in[I_XW2] + (size_t)e * DEXP * DM, DEXP, DM, ws + WS_EW2 + (size_t)e * DM * DEXP, MapId{0}, 64.0f, scr, r, F.lane); }
    }
#undef ITEMS
}

template <bool ROUTE, bool OUT8 = ROUTE>
__device__ __forceinline__ void norm_phase(Frame& F, const Args& A, const float* srcL, const float* srcC, int nrows, const float* g, const float* modl, int shift_slot, bf16* H) {
    LAS float* rt = (LAS float*)(F.lds + RING_OFF);
    if constexpr (ROUTE) { for (int i = F.tid; i < DM * NEXP; i += NWAVES * 64) { const int k = i >> 3, e = i & 7; rt[e * DM + k] = A.in[I_ROUTER][i]; } __syncthreads(); }
    const int gw = F.vcu * NWAVES + F.wave, NGW = F.G * NWAVES;
    for (int row = gw; row < nrows; row += NGW) {
        const bool lat = row < NLAT; const float* src = lat ? srcL + (size_t)row * DM : srcC + (size_t)(row - NLAT) * DM; const int bi = lat ? (row >> 12) : 8;
        const float* sh = modl + bi * MODW + shift_slot * DM; const float* sc = sh + DM;
        f32x4 v[4]; float ss = 0.f;
#pragma unroll
        for (int j = 0; j < 4; ++j) { v[j] = ((const f32x4*)src)[F.lane + 64 * j]; ss += (v[j][0] * v[j][0] + v[j][1] * v[j][1]) + (v[j][2] * v[j][2] + v[j][3] * v[j][3]); }
        const float r = 1.0f / sqrtf(wave_sum(ss) * (1.0f / DM) + EPS);
        float lg[NEXP];
        if constexpr (ROUTE) {
#pragma unroll
            for (int e = 0; e < NEXP; ++e) lg[e] = 0.f; }
#pragma unroll
        for (int j = 0; j < 4; ++j) { const int c = 4 * F.lane + 256 * j; const f32x4 gv = *(const f32x4*)(g + c), s1 = *(const f32x4*)(sc + c), s0 = *(const f32x4*)(sh + c);
            const f32x4 y = (v[j] * r) * gv * (s1 + 1.0f) + s0;
            if constexpr (ROUTE) {
#pragma unroll
                for (int e = 0; e < NEXP; ++e) { const f32x4 w = *(const LAS f32x4*)(rt + e * DM + c); lg[e] += (y[0] * w[0] + y[1] * w[1]) + (y[2] * w[2] + y[3] * w[3]); } }
            if constexpr (OUT8) { *(unsigned*)((unsigned char*)H + (size_t)row * DM + c) = pk_fp8x4(y[0], y[1], y[2], y[3]); }
            else { v2u o; o.x = cvt_pk_bf16(y[0], y[1]); o.y = cvt_pk_bf16(y[2], y[3]); *(v2u*)(H + (size_t)row * DM + c) = o; } }
        if constexpr (ROUTE) {
#pragma unroll
            for (int e = 0; e < NEXP; ++e) lg[e] = wave_sum(lg[e]);
            int i0 = 0; float v0 = lg[0];
#pragma unroll
            for (int e = 1; e < NEXP; ++e) if (lg[e] > v0) { v0 = lg[e]; i0 = e; }
            int i1 = -1; float v1 = -3.0e38f;
#pragma unroll
            for (int e = 0; e < NEXP; ++e) if (e != i0 && lg[e] > v1) { v1 = lg[e]; i1 = e; }
            if (F.lane == 0) {
                const float ex = __expf(v1 - v0), g0 = 1.0f / (1.0f + ex), g1 = ex * g0;
                unsigned* list = (unsigned*)(A.ws + WS_LIST);
                const unsigned p0 = __hip_atomic_fetch_add((unsigned*)F.ctl + CW_CNT + 64 * i0, 1u, RLX_AGENT);
                const unsigned p1 = __hip_atomic_fetch_add((unsigned*)F.ctl + CW_CNT + 64 * i1, 1u, RLX_AGENT);
                list[i0 * LIST_CAP + p0] = (unsigned)row * 2u; list[i1 * LIST_CAP + p1] = (unsigned)row * 2u + 1u;
                *(f32x2*)(A.ws + WS_TOKG + (size_t)row * 8) = (f32x2){g0, g1};
            }
        }
    }
}

__device__ __forceinline__ void mixmid_conv(Frame& F, const Args& A, int ch, int hf, const bf16* AG, bf16* A2) {
    const int R0 = ch * CHUNK + hf * 64;
    int s_lo, s_hi; if (R0 < NLAT) { s_lo = R0 & ~(SEQ - 1); s_hi = s_lo + SEQ; } else { s_lo = NLAT + ((R0 - NLAT) & ~(CTXL - 1)); s_hi = s_lo + CTXL; }
    const int p = (F.wave & 3) * 64 + F.lane, gq = F.wave >> 2;
    LAS float* red = (LAS float*)(F.lds + RING_OFF);
    float w0[CONVK], w1[CONVK];
#pragma unroll
    for (int k = 0; k < CONVK; ++k) { const f32x2 w = *(const f32x2*)(A.in[I_CONVW] + k * ACH + 2 * p); w0[k] = w[0]; w1[k] = w[1]; }
    const f32x2 cb = *(const f32x2*)(A.in[I_CONVB] + 2 * p), lg = *(const f32x2*)(A.in[I_LNAG] + 2 * p), lb = *(const f32x2*)(A.in[I_LNAB] + 2 * p);
#pragma unroll 1
    for (int it = 0; it < 4; ++it) {
        const int t0 = R0 + 8 * (gq + 2 * it);
        float o0[8], o1[8];
#pragma unroll
        for (int t = 0; t < 8; ++t) { o0[t] = cb[0]; o1[t] = cb[1]; }
#pragma unroll
        for (int i = 0; i < 38; ++i) { const int rr = t0 - 15 + i; const unsigned wv = (rr >= s_lo && rr < s_hi) ? *(const unsigned*)((const char*)(AG + (size_t)rr * ACH) + 4 * p) : 0u;
            const float x0 = bf_lo(wv), x1 = bf_hi(wv);
#pragma unroll
            for (int t = 0; t < 8; ++t) { const int k = i - t; if (k >= 0 && k < CONVK) { o0[t] += w0[k] * x0; o1[t] += w1[k] * x1; } }
            if ((i & 7) == 7) asm volatile("" ::: "memory"); }
        LAS float* rd = red + ((it & 1) * 2 + gq) * (4 * 8 * 2);
#pragma unroll
        for (int t = 0; t < 8; ++t) { const float s = wave_sum(o0[t] + o1[t]), q = wave_sum(o0[t] * o0[t] + o1[t] * o1[t]);
            if (F.lane == 0) { rd[((F.wave & 3) * 8 + t) * 2] = s; rd[((F.wave & 3) * 8 + t) * 2 + 1] = q; } }
        __syncthreads();
#pragma unroll
        for (int t = 0; t < 8; ++t) { float s = 0.f, q = 0.f;
#pragma unroll
            for (int w = 0; w < 4; ++w) { s += rd[(w * 8 + t) * 2]; q += rd[(w * 8 + t) * 2 + 1]; }
            const float mu = s * (1.0f / ACH); float var = q * (1.0f / ACH) - mu * mu; var = var > 0.f ? var : 0.f; const float rs = 1.0f / sqrtf(var + EPS);
            const float y0 = (o0[t] - mu) * rs * lg[0] + lb[0], y1 = (o1[t] - mu) * rs * lg[1] + lb[1];
            *(unsigned*)((char*)(A2 + (size_t)(t0 + t) * DM) + 4 * p) = (DROPMASK & 16) ? 0u : cvt_pk_bf16(fsilu(y0), fsilu(y1)); }
    }
    __syncthreads();
}
__device__ __forceinline__ void mixmid_gmlp(Frame& F, const Args& A, int ch, int hg, const bf16* UG, const bf16* VG, const bf16* WSB, bf16* A2) {
    const int R0 = ch * CHUNK;
    LAS f32x2* st = (LAS f32x2*)(F.lds + RING_OFF);
    LAS bf16* vnT = (LAS bf16*)(F.lds + RING_OFF + 1024);
    constexpr int VP = 136;
    for (int i = 0; i < 16; ++i) { const int j = F.wave * 16 + i; const v4u x = *(const v4u*)(VG + (size_t)(R0 + j) * BCH + 8 * F.lane);
        float s = 0.f, q = 0.f;
#pragma unroll
        for (int e = 0; e < 4; ++e) { const float a = bf_lo(x[e]), b = bf_hi(x[e]); s += a + b; q += a * a + b * b; }
        s = wave_sum(s); q = wave_sum(q); const float mu = s * (1.0f / BCH); float var = q * (1.0f / BCH) - mu * mu; var = var > 0.f ? var : 0.f;
        if (F.lane == 0) st[j] = (f32x2){mu, 1.0f / sqrtf(var + EPS)}; }
    __syncthreads();
    { const int j = F.tid >> 2, cq = (F.tid & 3) * 16; const f32x2 ms = st[j];
#pragma unroll
      for (int hh = 0; hh < 4; ++hh) { const int c0 = (4 * hg + hh) * 64 + cq;
#pragma unroll
        for (int q = 0; q < 2; ++q) { const v4u x = *(const v4u*)(VG + (size_t)(R0 + j) * BCH + c0 + 8 * q);
#pragma unroll
            for (int e = 0; e < 4; ++e) { const int c = c0 + 8 * q + 2 * e; const f32x2 gg = *(const f32x2*)(A.in[I_LNVG] + c), bb = *(const f32x2*)(A.in[I_LNVB] + c);
                const float y0 = (bf_lo(x[e]) - ms[0]) * ms[1] * gg[0] + bb[0], y1 = (bf_hi(x[e]) - ms[0]) * ms[1] * gg[1] + bb[1];
                const unsigned pk = cvt_pk_bf16(y0, y1); const int d = cq + 8 * q + 2 * e;
                vnT[(hh * 64 + d) * VP + j] = (bf16)(pk & 0xffffu); vnT[(hh * 64 + d + 1) * VP + j] = (bf16)(pk >> 16); } } } }
    __syncthreads();
    { const int hh = F.wave >> 1, h = 4 * hg + hh, ib0 = (F.wave & 1) * 4, lr = F.lane & 15, lq = F.lane >> 4;
      f32x4 acc[4][4];
#pragma unroll
      for (int a = 0; a < 4; ++a)
#pragma unroll
          for (int b = 0; b < 4; ++b) acc[a][b] = (f32x4){0.f, 0.f, 0.f, 0.f};
#pragma unroll
      for (int kk = 0; kk < 4; ++kk) { bf16x8 wf[4], vf[4];
#pragma unroll
          for (int ib = 0; ib < 4; ++ib) wf[ib] = *(const bf16x8*)(WSB + ((size_t)h * CHUNK + (ib0 + ib) * 16 + lr) * CHUNK + kk * 32 + 8 * lq);
#pragma unroll
          for (int db = 0; db < 4; ++db) vf[db] = *(const LAS bf16x8*)(vnT + (hh * 64 + db * 16 + lr) * VP + kk * 32 + 8 * lq);
#pragma unroll
          for (int ib = 0; ib < 4; ++ib)
#pragma unroll
              for (int db = 0; db < 4; ++db) acc[ib][db] = __builtin_amdgcn_mfma_f32_16x16x32_bf16(vf[db], wf[ib], acc[ib][db], 0, 0, 0); }
#pragma unroll
      for (int ib = 0; ib < 4; ++ib) { const int i = (ib0 + ib) * 16 + lr; const float bsv = A.in[I_BS][h * CHUNK + i];
#pragma unroll
          for (int db = 0; db < 4; ++db) { const int c = h * 64 + db * 16 + 4 * lq; const v2u uu = *(const v2u*)(UG + (size_t)(R0 + i) * BCH + c);
              const f32x4 s = acc[ib][db] + bsv; v2u o; o.x = cvt_pk_bf16(bf_lo(uu.x) * s[0], bf_hi(uu.x) * s[1]); o.y = cvt_pk_bf16(bf_lo(uu.y) * s[2], bf_hi(uu.y) * s[3]);
              if (DROPMASK & 32) { o.x = 0u; o.y = 0u; }
              *(v2u*)(A2 + (size_t)(R0 + i) * DM + ACH + c) = o; } } }
    __syncthreads();
}
__device__ __forceinline__ void mixmid_phase(Frame& F, const Args& A, const bf16* AG, const bf16* UG, const bf16* VG, const bf16* WSB, bf16* A2) {
    constexpr int NU = (MALL / CHUNK) * 4;
    for (int u = F.vcu; u < NU; u += F.G) { const int part = u / (MALL / CHUNK), ch = u - part * (MALL / CHUNK);
#if !defined(MIX_ONLY) || MIX_ONLY == 1
        if (part < 2) mixmid_conv(F, A, ch, part, AG, A2);
#endif
#if !defined(MIX_ONLY) || MIX_ONLY == 2
        if (part >= 2) mixmid_gmlp(F, A, ch, part - 2, UG, VG, WSB, A2);
#endif
    }
}

__device__ __forceinline__ void zsplit_phase(Frame& F, const Args& A, const bf16* Z, bf16* QN, bf16* KVN, bf16* KPE, const float* rope) {
    const int gw = F.vcu * NWAVES + F.wave, NGW = F.G * NWAVES, l = F.lane;
    for (int row = gw; row < MALL; row += NGW) {
        const bf16* z = Z + (size_t)row * INO_PAD; float x[3][4];
#pragma unroll
        for (int j = 0; j < 3; ++j) { const v2u w = *(const v2u*)(z + 4 * l + 256 * j); x[j][0] = bf_lo(w.x); x[j][1] = bf_hi(w.x); x[j][2] = bf_lo(w.y); x[j][3] = bf_hi(w.y); }
        float q0 = 0.f, q1 = 0.f, q2 = 0.f;
#pragma unroll
        for (int e = 0; e < 4; ++e) { q0 += x[0][e] * x[0][e]; q1 += x[1][e] * x[1][e]; q2 += x[2][e] * x[2][e]; }
        const float sq = wave_sum(q0 + (l < 32 ? q1 : 0.f)), skv = wave_sum((l >= 32 ? q1 : 0.f) + (l < 32 ? q2 : 0.f));
        const float rq = 1.0f / sqrtf(sq * (1.0f / QRANK) + EPS), rkv = 1.0f / sqrtf(skv * (1.0f / KVRANK) + EPS);
        const bool lat = row < NLAT;
        if (lat) { const f32x4 g0 = *(const f32x4*)(A.in[I_GQ] + 4 * l); v2u o; o.x = cvt_pk_bf16(x[0][0] * rq * g0[0], x[0][1] * rq * g0[1]); o.y = cvt_pk_bf16(x[0][2] * rq * g0[2], x[0][3] * rq * g0[3]);
            *(v2u*)(QN + (size_t)row * QRANK + 4 * l) = o;
            if (l < 32) { const f32x4 g1 = *(const f32x4*)(A.in[I_GQ] + 256 + 4 * l); v2u o1; o1.x = cvt_pk_bf16(x[1][0] * rq * g1[0], x[1][1] * rq * g1[1]); o1.y = cvt_pk_bf16(x[1][2] * rq * g1[2], x[1][3] * rq * g1[3]);
                *(v2u*)(QN + (size_t)row * QRANK + 256 + 4 * l) = o1; } }
        { const int jj = (l >= 32) ? 1 : 2, kc = (l >= 32) ? 4 * (l - 32) : 128 + 4 * l; const f32x4 gk = *(const f32x4*)(A.in[I_GKV] + kc);
          const float a0 = (jj == 1) ? x[1][0] : x[2][0], a1 = (jj == 1) ? x[1][1] : x[2][1], a2 = (jj == 1) ? x[1][2] : x[2][2], a3 = (jj == 1) ? x[1][3] : x[2][3];
          v2u o; o.x = cvt_pk_bf16(a0 * rkv * gk[0], a1 * rkv * gk[1]); o.y = cvt_pk_bf16(a2 * rkv * gk[2], a3 * rkv * gk[3]);
          *(v2u*)(KVN + (size_t)row * KVRANK + kc) = o; }
        float y[4];
#pragma unroll
        for (int e = 0; e < 4; ++e) y[e] = lane_xor<4>(x[2][e]);
        if (l >= 32 && l < 48) { const int m = l - 32; int b, key, t = 0;
            if (lat) { b = row >> 12; t = row & (SEQ - 1); key = CTXL + t; } else { const int rc = row - NLAT; b = rc >> 8; key = rc & (CTXL - 1); }
            float o[4];
            if (lat) { const int a = m >> 3, pp = (m >> 2) & 1, f0 = 4 * (m & 3), pos = a ? (t & 63) : (t >> 6);
#pragma unroll
                for (int e = 0; e < 4; ++e) { const f32x2 cs = *(const f32x2*)(rope + (pos * 16 + f0 + e) * 2); const float x1 = pp ? y[e] : x[2][e], x2 = pp ? x[2][e] : y[e];
                    o[e] = pp ? (x1 * cs[1] + x2 * cs[0]) : (x1 * cs[0] - x2 * cs[1]); } }
            else {
#pragma unroll
                for (int e = 0; e < 4; ++e) o[e] = x[2][e]; }
            v2u w; w.x = cvt_pk_bf16(o[0], o[1]); w.y = cvt_pk_bf16(o[2], o[3]);
            *(v2u*)(KPE + ((size_t)b * SKV + key) * ROPE + 4 * m) = w; }
    }
}

__device__ __forceinline__ void combine_phase(Frame& F, const Args& A, const bf16* Y, const float* mod1, float mul) {
    const int gw = F.vcu * NWAVES + F.wave, NGW = F.G * NWAVES;
    for (int tl = gw; tl < NLAT; tl += NGW) { const int row = tl, bi = row >> 12;
        float* xr = A.out + (size_t)row * DM; const float* gate = mod1 + bi * MODW + 5 * DM; const f32x2 gg = *(const f32x2*)(A.ws + WS_TOKG + (size_t)row * 8);
        const bf16* y0 = Y + (size_t)(2 * tl) * DM; const bf16* y1 = y0 + DM;
        f32x4 v[4]; float ss = 0.f;
#pragma unroll
        for (int j = 0; j < 4; ++j) { const int c = 4 * F.lane + 256 * j; const f32x4 x = *(const f32x4*)(xr + c), gt = *(const f32x4*)(gate + c); const v2u a = *(const v2u*)(y0 + c), b = *(const v2u*)(y1 + c);
            f32x4 m; m[0] = gg[0] * bf_lo(a.x) + gg[1] * bf_lo(b.x); m[1] = gg[0] * bf_hi(a.x) + gg[1] * bf_hi(b.x); m[2] = gg[0] * bf_lo(a.y) + gg[1] * bf_lo(b.y); m[3] = gg[0] * bf_hi(a.y) + gg[1] * bf_hi(b.y);
            v[j] = x + gt * m * mul; ss += (v[j][0] * v[j][0] + v[j][1] * v[j][1]) + (v[j][2] * v[j][2] + v[j][3] * v[j][3]); }
        const float r = 1.0f / sqrtf(wave_sum(ss) * (1.0f / DM) + EPS);
#pragma unroll
        for (int j = 0; j < 4; ++j) { const int c = 4 * F.lane + 256 * j; const f32x4 fg = *(const f32x4*)(A.in[I_FINALG] + c); *(f32x4*)(xr + c) = v[j] * r * fg; }
    }
}
#if SELFCHECK
namespace chk {
__device__ __forceinline__ float bff(bf16 v) { return __builtin_bit_cast(float, (unsigned)v << 16); }
__device__ __forceinline__ float bfr(float f) { unsigned u = __builtin_bit_cast(unsigned, f); u = (u + 0x7fffu + ((u >> 16) & 1u)) & 0xffff0000u; return __builtin_bit_cast(float, u); }
__device__ __forceinline__ unsigned hsh(unsigned x) { x ^= x >> 16; x *= 0x7feb352du; x ^= x >> 15; x *= 0x846ca68bu; x ^= x >> 16; return x; }
__device__ __forceinline__ float dot_w(const bf16* a, const float* W, int K, int N, int n) { float s = 0.f; for (int k = 0; k < K; ++k) s += bff(a[k]) * bfr(W[(size_t)k * N + n]); return s; }
__device__ __forceinline__ float f8f(unsigned char v) { return __builtin_amdgcn_cvt_f32_fp8((int)v, 0); }
__device__ __forceinline__ float f8r(float x) { const int w = __builtin_amdgcn_cvt_pk_fp8_f32(x, 0.f, 0, false); return __builtin_amdgcn_cvt_f32_fp8(w, 0); }
__device__ __forceinline__ float dot_w8(const unsigned char* a, const float* W, int K, int N, int n, float mul) { float s = 0.f; for (int k = 0; k < K; ++k) s += f8f(a[k]) * f8r(W[(size_t)k * N + n] * mul); return s / mul; }
__device__ __forceinline__ float sigm(float x) { return 1.0f / (1.0f + __expf(-x)); }
__device__ __forceinline__ float gelu_t(float x) { return 0.5f * x * (1.0f + tanhf(0.7978845608028654f * (x + 0.044715f * x * x * x))); }
__device__ __forceinline__ void report(unsigned* dbg, int k, float got, float ref, float rel, float abs_) {
    const float err = fabsf(got - ref); const bool bad = !(err <= rel * fabsf(ref) + abs_);
    atomicAdd(dbg + 64 * k + 1, 1u); if (bad) atomicAdd(dbg + 64 * k, 1u);
}
}
#define CHK_LOOP(NS) for (int s_ = (int)(blockIdx.x * 512 + F.tid); s_ < (NS); s_ += (int)(gridDim.x * 512))
#endif
#if SELFCHECK
constexpr int CW_DBG = 32768;
constexpr size_t WS_CAP = 3 * MiB + 512 * 1024;
namespace chk {
struct Ctx { const Args* A; unsigned char* ws; unsigned char* ar; unsigned* dbg; const float* mod; float* XC; };
#define CK_IN(i) (C.A->in[i])
__device__ __forceinline__ const float* xrow(const Ctx& C, const float* L, const float* Cx, int row) { return row < NLAT ? L + (size_t)row * DM : Cx + (size_t)(row - NLAT) * DM; }
__device__ __forceinline__ void c_mod(Frame& F, const Ctx& C) {
    CHK_LOOP(2048) { const unsigned h = hsh(s_); const int l = h & 1, bi = (h >> 1) % 9, j = (h >> 8) % MODW;
        const float* cv = bi < 8 ? CK_IN(I_C) + bi * DM : CK_IN(I_CCTX); float s = CK_IN(I_BADA)[l * MODW + j];
        for (int k = 0; k < DM; ++k) { const float c = cv[k]; s += (c * sigm(c)) * CK_IN(I_WADA)[((size_t)l * DM + k) * MODW + j]; }
        report(C.dbg, 0, C.mod[(size_t)(l * 9 + bi) * MODW + j], s, 2e-3f, 2e-3f); }
}
__device__ __forceinline__ void c_norm(Frame& F, const Ctx& C, int k, const float* L, const float* Cx, int nrows, const float* g, const float* modl, int slot, const bf16* H) {
    CHK_LOOP(2048) { const unsigned h = hsh(s_ + 7919u * k); const int row = h % nrows, col = (h >> 16) % DM; const float* x = xrow(C, L, Cx, row); const int bi = row < NLAT ? row >> 12 : 8;
        float ss = 0.f; for (int i = 0; i < DM; ++i) ss += x[i] * x[i];
        const float r = 1.0f / sqrtf(ss / DM + EPS), y = x[col] * r * g[col] * (1.0f + modl[bi * MODW + (slot + 1) * DM + col]) + modl[bi * MODW + slot * DM + col];
        report(C.dbg, row < NLAT ? k : k + 20, bff(H[(size_t)row * DM + col]), y, 0.01f, 0.01f); }
}
__device__ __forceinline__ void c_mixin(Frame& F, const Ctx& C, const bf16* H, const bf16* AG, const bf16* UG, const bf16* VG) {
    CHK_LOOP(2048) { const unsigned h = hsh(s_ + 111u); const int row = h % MALL, c = (h >> 16) % 1536; const bf16* a = H + (size_t)row * DM; const float* W = CK_IN(I_EWIN); float ref, got;
        if (c < 512) { ref = dot_w(a, W, DM, 2048, c) * sigm(dot_w(a, W, DM, 2048, 512 + c)); got = bff(AG[(size_t)row * ACH + c]); }
        else if (c < 1024) { ref = gelu_t(dot_w(a, W, DM, 2048, 512 + c)); got = bff(UG[(size_t)row * BCH + c - 512]); }
        else { ref = gelu_t(dot_w(a, W, DM, 2048, 512 + c)); got = bff(VG[(size_t)row * BCH + c - 1024]); }
        report(C.dbg, 2, got, ref, 0.02f, 0.02f); }
}
__device__ __forceinline__ void c_mixmid(Frame& F, const Ctx& C, const bf16* AG, const bf16* UG, const bf16* VG, const bf16* A2) {
    CHK_LOOP(512) { const unsigned h = hsh(s_ + 222u); const int row = h % MALL, c = (h >> 16) % DM; float ref;
        if (c < ACH) { int s_lo, s_hi; if (row < NLAT) { s_lo = row & ~(SEQ - 1); s_hi = s_lo + SEQ; } else { s_lo = NLAT + ((row - NLAT) & ~(CTXL - 1)); s_hi = s_lo + CTXL; }
            float s = 0.f, q = 0.f, vc = 0.f;
            for (int ch = 0; ch < ACH; ++ch) { float v = CK_IN(I_CONVB)[ch];
                for (int k = 0; k < CONVK; ++k) { const int rr = row + k - 15; if (rr >= s_lo && rr < s_hi) v += CK_IN(I_CONVW)[k * ACH + ch] * bff(AG[(size_t)rr * ACH + ch]); }
                s += v; q += v * v; if (ch == c) vc = v; }
            const float mu = s / ACH, var = q / ACH - mu * mu, y = (vc - mu) / sqrtf(var + EPS) * CK_IN(I_LNAG)[c] + CK_IN(I_LNAB)[c]; ref = y * sigm(y);
        } else { const int cc = c - ACH, hh = cc >> 6, R0 = row & ~(CHUNK - 1), i = row - R0; float sv = CK_IN(I_BS)[hh * CHUNK + i];
            for (int j = 0; j < CHUNK; ++j) { const bf16* vr = VG + (size_t)(R0 + j) * BCH; float s = 0.f, q = 0.f;
                for (int ch = 0; ch < BCH; ++ch) { const float v = bff(vr[ch]); s += v; q += v * v; }
                const float mu = s / BCH, var = q / BCH - mu * mu, vn = (bff(vr[cc]) - mu) / sqrtf(var + EPS) * CK_IN(I_LNVG)[cc] + CK_IN(I_LNVB)[cc];
                sv += bfr(CK_IN(I_WS)[((size_t)hh * CHUNK + i) * CHUNK + j]) * bfr(vn); }
            ref = bff(UG[(size_t)row * BCH + cc]) * sv; }
        report(C.dbg, 3, bff(A2[(size_t)row * DM + c]), ref, 0.02f, 0.02f); }
}
__device__ __forceinline__ void c_resid(Frame& F, const Ctx& C, int k, int nrows, const bf16* Ain, int K, const float* W, const float* gate, const float* baseL, const float* baseC, bool captured) {
    CHK_LOOP(2048) { const unsigned h = hsh(s_ + 333u * k); const int row = h % nrows, col = (h >> 16) % DM, bi = row < NLAT ? row >> 12 : 8;
        const float base = captured ? ((const float*)(C.ws + WS_CAP))[s_] : xrow(C, baseL, baseC, row)[col];
        const float ref = base + gate[bi * MODW + col] * dot_w(Ain + (size_t)row * K, W, K, DM, col), got = xrow(C, C.A->out, C.XC, row)[col];
        report(C.dbg, k, got, ref, 0.01f, 0.01f); }
}
__device__ __forceinline__ void c_capture(Frame& F, const Ctx& C, int k, int nrows) {
    CHK_LOOP(2048) { const unsigned h = hsh(s_ + 333u * k); const int row = h % nrows, col = (h >> 16) % DM; ((float*)(C.ws + WS_CAP))[s_] = xrow(C, C.A->out, C.XC, row)[col]; }
}
__device__ __forceinline__ void c_swiglu(Frame& F, const Ctx& C, const bf16* H, const bf16* ACT) {
    CHK_LOOP(2048) { const unsigned h = hsh(s_ + 444u); const int row = h % MALL, j = (h >> 16) % DFF; const bf16* a = H + (size_t)row * DM;
        const float p = dot_w(a, CK_IN(I_FW1), DM, DFF, j), q = dot_w(a, CK_IN(I_FW3), DM, DFF, j);
        report(C.dbg, 6, bff(ACT[(size_t)row * DFF + j]), p * sigm(p) * q, 0.02f, 0.02f); }
}
__device__ __forceinline__ void c_z(Frame& F, const Ctx& C, const bf16* H, const bf16* Z) {
    CHK_LOOP(2048) { const unsigned h = hsh(s_ + 555u); const int row = h % MALL, j = (h >> 16) % INO;
        report(C.dbg, 9, bff(Z[(size_t)row * INO_PAD + j]), dot_w(H + (size_t)row * DM, CK_IN(I_OWIN), DM, INO, j), 0.02f, 0.02f); }
}
__device__ __forceinline__ float rope_ref(float x1, float x2, int p, int a, int f, int t) {
    const int pos = a ? (t & 63) : (t >> 6); const float ang = (float)pos * powf(10000.0f, -(float)f / 16.0f), c = cosf(ang), s = sinf(ang);
    return p ? (x1 * s + x2 * c) : (x1 * c - x2 * s);
}
__device__ __forceinline__ void c_zsplit(Frame& F, const Ctx& C, const bf16* Z, const bf16* QN, const bf16* KVN, const bf16* KPE) {
    CHK_LOOP(3072) { const unsigned h = hsh(s_ + 666u); const int kind = s_ % 3; const bf16* z;
        if (kind == 0) { const int row = h % NLAT, c = (h >> 16) % QRANK; z = Z + (size_t)row * INO_PAD; float ss = 0.f; for (int i = 0; i < QRANK; ++i) ss += bff(z[i]) * bff(z[i]);
            report(C.dbg, 10, bff(QN[(size_t)row * QRANK + c]), bff(z[c]) / sqrtf(ss / QRANK + EPS) * CK_IN(I_GQ)[c], 0.01f, 0.01f); }
        else if (kind == 1) { const int row = h % MALL, c = (h >> 16) % KVRANK; z = Z + (size_t)row * INO_PAD; float ss = 0.f; for (int i = 0; i < KVRANK; ++i) ss += bff(z[QRANK + i]) * bff(z[QRANK + i]);
            report(C.dbg, 10, bff(KVN[(size_t)row * KVRANK + c]), bff(z[QRANK + c]) / sqrtf(ss / KVRANK + EPS) * CK_IN(I_GKV)[c], 0.01f, 0.01f); }
        else { const int row = h % MALL, dd = (h >> 16) % ROPE; z = Z + (size_t)row * INO_PAD + QRANK + KVRANK; int b, key; float ref;
            if (row < NLAT) { b = row >> 12; const int t = row & (SEQ - 1); key = CTXL + t; const int a = dd >> 5, p = (dd >> 4) & 1, f = dd & 15; ref = rope_ref(bff(z[a * 32 + f]), bff(z[a * 32 + 16 + f]), p, a, f, t); }
            else { const int rc = row - NLAT; b = rc >> 8; key = rc & (CTXL - 1); ref = bff(z[dd]); }
            report(C.dbg, 10, bff(KPE[((size_t)b * SKV + key) * ROPE + dd]), ref, 0.01f, 0.01f); } }
}
__device__ __forceinline__ void c_qkv(Frame& F, const Ctx& C, const bf16* QN, const bf16* KVN, const bf16* Q, const bf16* KN, const bf16* V) {
    CHK_LOOP(3072) { const unsigned h = hsh(s_ + 777u), h2 = hsh(s_ + 778u); const int kind = s_ % 3, b = h % NB, hd = (h >> 8) % NHEAD;
        if (kind == 0) { const int t = (h >> 16) % SEQ, d = h2 % QKD, row = b * SEQ + t; const bf16* a = QN + (size_t)row * QRANK; float ref;
            if (d < 128) ref = dot_w(a, CK_IN(I_WUQ), QRANK, 1536, hd * QKD + d);
            else { const int dd = d - 128, aa = dd >> 5, p = (dd >> 4) & 1, f = dd & 15;
                ref = rope_ref(dot_w(a, CK_IN(I_WUQ), QRANK, 1536, hd * QKD + 128 + aa * 32 + f), dot_w(a, CK_IN(I_WUQ), QRANK, 1536, hd * QKD + 128 + aa * 32 + 16 + f), p, aa, f, t); }
            report(C.dbg, 11, bff(Q[((size_t)(b * NHEAD + hd) * SEQ + t) * QKD + d]), ref, 0.02f, 0.02f); }
        else { const int key = (h >> 16) % SKV, d = h2 % VHD, row = key < CTXL ? NLAT + b * CTXL + key : b * SEQ + key - CTXL; const bf16* a = KVN + (size_t)row * KVRANK;
            const float ref = dot_w(a, CK_IN(I_WUKV), KVRANK, 2048, hd * 256 + (kind == 1 ? 0 : 128) + d); const bf16* O = kind == 1 ? KN : V;
            report(C.dbg, 11, bff(O[((size_t)(b * NHEAD + hd) * SKV + key) * VHD + d]), ref, 0.02f, 0.02f); } }
}
__device__ __forceinline__ void c_attn(Frame& F, const Ctx& C, const bf16* Q, const bf16* KN, const bf16* KPE, const bf16* V, const bf16* ATT) {
    CHK_LOOP(256) { const unsigned h = hsh(s_ + 888u), h2 = hsh(s_ + 889u); const int b = h % NB, hd = (h >> 8) % NHEAD, t = (h >> 16) % SEQ, d = h2 % VHD;
        const bf16* q = Q + ((size_t)(b * NHEAD + hd) * SEQ + t) * QKD; float m = -1e30f, l = 0.f, o = 0.f;
        for (int k = 0; k < SKV; ++k) { const bf16* kn = KN + ((size_t)(b * NHEAD + hd) * SKV + k) * VHD; const bf16* kp = KPE + ((size_t)b * SKV + k) * ROPE; float sc = 0.f;
            for (int i = 0; i < 128; ++i) sc += bff(q[i]) * bff(kn[i]);
            for (int i = 0; i < 64; ++i) sc += bff(q[128 + i]) * bff(kp[i]);
            sc *= ATTN_SCALE; const float mn = fmaxf(m, sc), al = __expf(m - mn), p = __expf(sc - mn); l = l * al + p; o = o * al + p * bff(V[((size_t)(b * NHEAD + hd) * SKV + k) * VHD + d]); m = mn; }
        report(C.dbg, 12, bff(ATT[((size_t)b * SEQ + t) * DM + hd * VHD + d]), o / l, 0.03f, 0.01f); }
}
__device__ __forceinline__ void c_route(Frame& F, const Ctx& C, const float* modl, const unsigned char* H4) {
    CHK_LOOP(128) { const unsigned h = hsh(s_ + 999u); const int row = h % NLAT, col = (h >> 16) % DM, bi = row >> 12; const float* x = C.A->out + (size_t)row * DM; const float* g = CK_IN(I_NORMG) + 3 * DM;
        float ss = 0.f; for (int i = 0; i < DM; ++i) ss += x[i] * x[i]; const float r = 1.0f / sqrtf(ss / DM + EPS); float lg[NEXP]; float ycol = 0.f;
#pragma unroll
        for (int e = 0; e < NEXP; ++e) lg[e] = 0.f;
        for (int i = 0; i < DM; ++i) { const float y = x[i] * r * g[i] * (1.0f + modl[bi * MODW + 4 * DM + i]) + modl[bi * MODW + 3 * DM + i]; if (i == col) ycol = y;
#pragma unroll
            for (int e = 0; e < NEXP; ++e) lg[e] += y * CK_IN(I_ROUTER)[i * NEXP + e]; }
        report(C.dbg, 14, f8f(H4[(size_t)row * DM + col]), ycol, 0.07f, 0.01f);
        int i0 = 0; float v0 = lg[0];
#pragma unroll
        for (int e = 1; e < NEXP; ++e) if (lg[e] > v0) { v0 = lg[e]; i0 = e; }
        int i1 = 0; float v1 = -3.0e38f;
#pragma unroll
        for (int e = 0; e < NEXP; ++e) if (e != i0 && lg[e] > v1) { v1 = lg[e]; i1 = e; }
        float v2 = -3.0e38f;
#pragma unroll
        for (int e = 0; e < NEXP; ++e) if (e != i0 && e != i1 && lg[e] > v2) v2 = lg[e];
        if (v1 - v2 > 1e-3f && v0 - v1 > 1e-3f) {
            const float ex = __expf(v1 - v0), g0 = 1.0f / (1.0f + ex); const f32x2 tg = *(const f32x2*)(C.ws + WS_TOKG + (size_t)row * 8);
            report(C.dbg, 14, tg[0], g0, 0.01f, 0.002f); report(C.dbg, 14, tg[1], 1.0f - g0, 0.01f, 0.002f);
            const int tl = row; const unsigned* list = (const unsigned*)(C.ws + WS_LIST);
            const int c0 = (int)((const unsigned*)(C.ws + WS_CTL))[CW_CNT + 64 * i0], c1 = (int)((const unsigned*)(C.ws + WS_CTL))[CW_CNT + 64 * i1];
            float f0 = 0.f, f1 = 0.f; for (int i = 0; i < c0; ++i) if (list[i0 * LIST_CAP + i] == (unsigned)tl * 2u) f0 += 1.f; for (int i = 0; i < c1; ++i) if (list[i1 * LIST_CAP + i] == (unsigned)tl * 2u + 1u) f1 += 1.f;
            report(C.dbg, 14, f0, 1.0f, 0.f, 0.01f); report(C.dbg, 14, f1, 1.0f, 0.f, 0.01f); } }
}
__device__ __forceinline__ void c_moe_up(Frame& F, const Ctx& C, const LAS int* tab, const unsigned char* H4, const unsigned char* ACTE) {
    const unsigned* list = (const unsigned*)(C.ws + WS_LIST);
    CHK_LOOP(2048) { const unsigned h = hsh(s_ + 1111u), h2 = hsh(s_ + 1112u); const int e = h % NEXP, cnt = tab[16 + e]; if (cnt == 0) continue; const int slot = (h >> 8) % cnt, j = h2 % DEXP;
        const int tok = (int)(list[e * LIST_CAP + slot] >> 1); const unsigned char* a = H4 + (size_t)tok * DM;
        const float p = dot_w8(a, CK_IN(I_XW1) + (size_t)e * DM * DEXP, DM, DEXP, j, 32.f), q = dot_w8(a, CK_IN(I_XW3) + (size_t)e * DM * DEXP, DM, DEXP, j, 32.f);
        report(C.dbg, 15, f8f(ACTE[((size_t)tab[e] * 256 + slot) * DEXP + j]), p * sigm(p) * q, 0.08f, 0.02f); }
}
__device__ __forceinline__ void c_moe_down(Frame& F, const Ctx& C, const LAS int* tab, const unsigned char* ACTE, const bf16* Y) {
    const unsigned* list = (const unsigned*)(C.ws + WS_LIST);
    CHK_LOOP(2048) { const unsigned h = hsh(s_ + 2222u), h2 = hsh(s_ + 2223u); const int e = h % NEXP, cnt = tab[16 + e]; if (cnt == 0) continue; const int slot = (h >> 8) % cnt, col = h2 % DM;
        const unsigned ent = list[e * LIST_CAP + slot];
        report(C.dbg, 16, bff(Y[(size_t)ent * DM + col]), dot_w8(ACTE + ((size_t)tab[e] * 256 + slot) * DEXP, CK_IN(I_XW2) + (size_t)e * DEXP * DM, DEXP, DM, col, 64.f), 0.02f, 0.02f); }
}
__device__ __forceinline__ void c_cap_rows(Frame& F, const Ctx& C) {
    float* cap = (float*)(C.ws + WS_CAP + 65536);
    for (int i = (int)(blockIdx.x * 512 + F.tid); i < 64 * DM; i += (int)(gridDim.x * 512)) { const int r = i >> 10, c = i & (DM - 1), tl = hsh(r + 3333u) % NLAT; cap[i] = C.A->out[(size_t)tl * DM + c]; }
}
__device__ __forceinline__ void c_combine(Frame& F, const Ctx& C, const float* mod1, const bf16* Y) {
    const float* cap = (const float*)(C.ws + WS_CAP + 65536);
    CHK_LOOP(64 * 16) { const int r = s_ >> 4, tl = hsh(r + 3333u) % NLAT, row = tl, bi = row >> 12, col = hsh(s_ + 4444u) % DM; const f32x2 tg = *(const f32x2*)(C.ws + WS_TOKG + (size_t)row * 8);
        float ss = 0.f, vc = 0.f; for (int i = 0; i < DM; ++i) { const float v = cap[r * DM + i] + mod1[bi * MODW + 5 * DM + i] * (tg[0] * bff(Y[(size_t)(2 * tl) * DM + i]) + tg[1] * bff(Y[(size_t)(2 * tl + 1) * DM + i])); ss += v * v; if (i == col) vc = v; }
        report(C.dbg, 17, C.A->out[(size_t)row * DM + col], vc / sqrtf(ss / DM + EPS) * CK_IN(I_FINALG)[col], 0.005f, 0.005f); }
}
}
#endif
namespace att {
using bf16x8 = __attribute__((ext_vector_type(8))) short;
using s16x4  = __attribute__((ext_vector_type(4))) short;
using f32x16 = __attribute__((ext_vector_type(16))) float;
using u32x4  = __attribute__((ext_vector_type(4))) unsigned;
constexpr int D = 128, NW = 8, QBLK = 32, KVBLK = 64;
constexpr float THR = 8.f, SCALE = ATTN_SCALE;
constexpr int SHM_V = KVBLK * D * 2, SHM_K = KVBLK * D * 2, SHM_P = KVBLK * ROPE * 2, SHM_QP = 2 * SHM_V + 2 * SHM_K + 2 * SHM_P + NW * 64 * 4, NQL = 6  , SHM_ATTN = SHM_QP + NW * NQL * 1024;
static_assert(SHM_ATTN <= RING_BYTES, "attention LDS");
#define KSWZ(row, colB) ((row) * 256 + ((colB) ^ (((row) & 7) << 4)))
#define PSWZ(row, colB) ((row) * 128 + ((colB) ^ (((row) & 7) << 4)))
#define SBAR() __builtin_amdgcn_sched_barrier(0)
__device__ __forceinline__ int crow(int r, int hi) { return (r & 3) + 8 * (r >> 2) + 4 * hi; }
__device__ __forceinline__ unsigned cvtpk(float lo, float hi) { unsigned r; asm volatile("v_cvt_pk_bf16_f32 %0, %1, %2" : "=v"(r) : "v"(lo), "v"(hi)); return r; }
__device__ __forceinline__ void swap32(unsigned& a, unsigned& b) { asm volatile("s_nop 1\n\tv_permlane32_swap_b32 %0, %1\n\ts_nop 0" : "+v"(a), "+v"(b)); }
__device__ __forceinline__ void partialSM(f32x16& p0, f32x16& p1, float& m_reg, float& mn, float& alpha) {
  constexpr float C = SCALE * 1.4426950408889634f;
  float pmax = p0[0]; for (int r = 1; r < 16; ++r) pmax = fmaxf(pmax, p0[r]); for (int r = 0; r < 16; ++r) pmax = fmaxf(pmax, p1[r]);
  { unsigned a_ = __float_as_uint(pmax), b_ = a_; swap32(a_, b_); pmax = fmaxf(__uint_as_float(a_), __uint_as_float(b_)); }
  if (__builtin_expect(__all(pmax - m_reg <= THR / SCALE), 1)) { mn = m_reg; alpha = 1.f; }
  else { mn = fmaxf(m_reg, pmax); alpha = __builtin_amdgcn_exp2f((m_reg - mn) * C); m_reg = mn; }
  float mnC = -mn * C;
  for (int r = 0; r < 16; ++r) p0[r] = fmaf(p0[r], C, mnC); for (int r = 0; r < 16; ++r) p1[r] = fmaf(p1[r], C, mnC);
  for (int r = 0; r < 16; ++r) p0[r] = __builtin_amdgcn_exp2f(p0[r]);
}
__device__ __forceinline__ void finishSM(f32x16& p0, f32x16& p1, float alpha, float& l_reg, bf16x8& pa0, bf16x8& pa1, bf16x8& pa2, bf16x8& pa3) {
  for (int r = 0; r < 16; ++r) p1[r] = __builtin_amdgcn_exp2f(p1[r]);
  float ps = 0; for (int r = 0; r < 16; ++r) ps += p0[r]; for (int r = 0; r < 16; ++r) ps += p1[r];
  { unsigned a_ = __float_as_uint(ps), b_ = a_; swap32(a_, b_); ps = __uint_as_float(a_) + __uint_as_float(b_); }
  l_reg = l_reg * alpha + ps;
#define PK4(P, BASE, OUT) do { unsigned a0 = cvtpk(P[BASE + 0], P[BASE + 1]), a1 = cvtpk(P[BASE + 2], P[BASE + 3]);   \
    unsigned b0 = cvtpk(P[BASE + 4], P[BASE + 5]), b1 = cvtpk(P[BASE + 6], P[BASE + 7]);                              \
    auto r0 = __builtin_amdgcn_permlane32_swap(a0, b0, false, false); auto r1 = __builtin_amdgcn_permlane32_swap(a1, b1, false, false); \
    u32x4 w = {r0[0], r1[0], r0[1], r1[1]}; OUT = *reinterpret_cast<bf16x8*>(&w); } while (0)
  PK4(p0, 0, pa0); PK4(p0, 8, pa1); PK4(p1, 0, pa2); PK4(p1, 8, pa3);
#undef PK4
}
__device__ __forceinline__ void qkt(f32x16& p0, f32x16& p1, const char* Ks, const char* Ps, const bf16x8* qr, const char* qp, int r32, int hi) {
  p0 = f32x16{}; p1 = f32x16{};
#pragma unroll
  for (int d0 = 0; d0 < 8; ++d0) { int cb = (d0 * 16 + hi * 8) * 2;
    bf16x8 b0 = *reinterpret_cast<const bf16x8*>(Ks + KSWZ(r32, cb));
    bf16x8 b1 = *reinterpret_cast<const bf16x8*>(Ks + KSWZ(32 + r32, cb));
    const bf16x8 qf = (d0 < 12 - NQL) ? qr[d0 < 12 - NQL ? d0 : 0] : *reinterpret_cast<const bf16x8*>(qp + (d0 - (12 - NQL)) * 1024);
    p0 = __builtin_amdgcn_mfma_f32_32x32x16_bf16(b0, qf, p0, 0, 0, 0);
    p1 = __builtin_amdgcn_mfma_f32_32x32x16_bf16(b1, qf, p1, 0, 0, 0); }
#pragma unroll
  for (int d0 = 0; d0 < 4; ++d0) { int cb = (d0 * 16 + hi * 8) * 2;
    bf16x8 b0 = *reinterpret_cast<const bf16x8*>(Ps + PSWZ(r32, cb));
    bf16x8 b1 = *reinterpret_cast<const bf16x8*>(Ps + PSWZ(32 + r32, cb));
    const bf16x8 qf = *reinterpret_cast<const bf16x8*>(qp + (8 + d0 - (12 - NQL)) * 1024);
    p0 = __builtin_amdgcn_mfma_f32_32x32x16_bf16(b0, qf, p0, 0, 0, 0);
    p1 = __builtin_amdgcn_mfma_f32_32x32x16_bf16(b1, qf, p1, 0, 0, 0); }
}
__device__ __forceinline__ int v_st(int k, int c) { const int kk = (k & ~0xC) | ((k & 4) << 1) | ((k & 8) >> 1); return ((kk >> 3) * 4 + (c >> 5)) * 512 + ((kk & 7) * 32 + (c & 31)) * 2; }
__device__ __forceinline__ int v_rd_base(int lane) { return ((lane & 3) << 3) | (((lane >> 2) & 3) << 6) | (((lane >> 4) & 1) << 5) | (((lane >> 5) & 1) << 8); }
constexpr int v_rd_off(int d0, int ks, int half) { return d0 * 512 + ks * 4096 + half * 2048; }
template <int OFF> __device__ __forceinline__ s16x4 tr_read(int vb) {
  s16x4 r; asm volatile("ds_read_b64_tr_b16 %0, %1 offset:%2" : "=&v"(r) : "v"(vb), "i"(OFF) : "memory"); return r;
}
template <int D0> __device__ __forceinline__ void pv_one(f32x16& od, int vb, bf16x8 pa0, bf16x8 pa1, bf16x8 pa2, bf16x8 pa3) {
  const s16x4 l0 = tr_read<v_rd_off(D0, 0, 0)>(vb), h0 = tr_read<v_rd_off(D0, 0, 1)>(vb), l1 = tr_read<v_rd_off(D0, 1, 0)>(vb), h1 = tr_read<v_rd_off(D0, 1, 1)>(vb);
  const s16x4 l2 = tr_read<v_rd_off(D0, 2, 0)>(vb), h2 = tr_read<v_rd_off(D0, 2, 1)>(vb), l3 = tr_read<v_rd_off(D0, 3, 0)>(vb), h3 = tr_read<v_rd_off(D0, 3, 1)>(vb);
  asm volatile("s_waitcnt lgkmcnt(0)" ::: "memory"); SBAR();
#define PK(L, H) (bf16x8){L[0], L[1], L[2], L[3], H[0], H[1], H[2], H[3]}
  od = __builtin_amdgcn_mfma_f32_32x32x16_bf16(pa0, PK(l0, h0), od, 0, 0, 0);
  od = __builtin_amdgcn_mfma_f32_32x32x16_bf16(pa1, PK(l1, h1), od, 0, 0, 0);
  od = __builtin_amdgcn_mfma_f32_32x32x16_bf16(pa2, PK(l2, h2), od, 0, 0, 0);
  od = __builtin_amdgcn_mfma_f32_32x32x16_bf16(pa3, PK(l3, h3), od, 0, 0, 0);
#undef PK
}
__device__ __forceinline__ void pv_d0(f32x16* o, int vb, bf16x8 pa0, bf16x8 pa1, bf16x8 pa2, bf16x8 pa3) {
  pv_one<0>(o[0], vb, pa0, pa1, pa2, pa3); pv_one<1>(o[1], vb, pa0, pa1, pa2, pa3); pv_one<2>(o[2], vb, pa0, pa1, pa2, pa3); pv_one<3>(o[3], vb, pa0, pa1, pa2, pa3);
}
__device__ __forceinline__ void attn_unit(const bf16* __restrict__ Qb, const bf16* __restrict__ Kh, const bf16* __restrict__ Ph, const bf16* __restrict__ Vh, bf16* __restrict__ Ob, int seq, char* lds, int wave_id) {
  const int wid = __builtin_amdgcn_readfirstlane(wave_id), lane = fresh_lane(), tid = wid * 64 + lane, r32 = lane & 31, hi = lane >> 5;
  char* V_lds = lds; char* K_lds = lds + 2 * SHM_V; char* P_lds = lds + 2 * SHM_V + 2 * SHM_K;
  float* ws = (float*)(lds + 2 * SHM_V + 2 * SHM_K + 2 * SHM_P) + wid * 64; float* li_l = ws; float* al_l = ws + 32;
  float m_reg = -1e30f, l_reg = 0; f32x16 o[4] = {}; bf16x8 qr[12 - NQL];
  char* qp = lds + SHM_QP + wid * (NQL * 1024) + lane * 16;
  const char* Qw = (const char*)Qb + (size_t)wid * (QBLK * QKD * 2); const int qoff = (r32 * QKD + hi * 8) * 2;
#pragma unroll
  for (int d0 = 0; d0 < 12 - NQL; ++d0) qr[d0] = *reinterpret_cast<const bf16x8*>(Qw + qoff + d0 * 32);
#pragma unroll
  for (int d0 = 0; d0 < NQL; ++d0) *reinterpret_cast<bf16x8*>(qp + d0 * 1024) = *reinterpret_cast<const bf16x8*>(Qw + qoff + (12 - NQL + d0) * 32);
  const int sr = tid >> 4, sc = (tid & 15) * 8, vst0 = v_st(sr, sc), vst1 = v_st(32 + sr, sc);
  const int pr = tid >> 3, pc = (tid & 7) * 8;
  const int vb0 = (int)(uintptr_t)V_lds + v_rd_base(lane);
  struct { bf16x8 vs0, vs1, ks0, ks1, ps; } sr_[1];
  const int kvoff = (sr * D + sc) * 2, poff = (pr * ROPE + pc) * 2;
#define SLOAD(i, k0) do { const char* vt_ = (const char*)Vh + (size_t)(k0) * (D * 2); const char* kt_ = (const char*)Kh + (size_t)(k0) * (D * 2); const char* pt_ = (const char*)Ph + (size_t)(k0) * (ROPE * 2); \
    sr_[i].vs0 = *(const bf16x8*)(vt_ + kvoff); sr_[i].vs1 = *(const bf16x8*)(vt_ + kvoff + 32 * D * 2); \
    sr_[i].ks0 = *(const bf16x8*)(kt_ + kvoff); sr_[i].ks1 = *(const bf16x8*)(kt_ + kvoff + 32 * D * 2); \
    sr_[i].ps = *(const bf16x8*)(pt_ + poff); } while (0)
#define SWRITE(b, i) do { *(bf16x8*)(V_lds + (b) * SHM_V + vst0) = sr_[i].vs0; *(bf16x8*)(V_lds + (b) * SHM_V + vst1) = sr_[i].vs1; int kc = sc * 2; \
    *(bf16x8*)(K_lds + (b) * SHM_K + KSWZ(sr, kc)) = sr_[i].ks0; *(bf16x8*)(K_lds + (b) * SHM_K + KSWZ(32 + sr, kc)) = sr_[i].ks1; \
    *(bf16x8*)(P_lds + (b) * SHM_P + PSWZ(pr, pc * 2)) = sr_[i].ps; } while (0)
#define SWAIT() asm volatile("s_waitcnt vmcnt(0)" ::: "memory")
#define RESC(a) do { if (__any((a) < 1.f)) { if (hi == 0) al_l[r32] = (a); asm volatile("s_waitcnt lgkmcnt(0)" ::: "memory"); \
    for (int d = 0; d < 4; ++d) for (int r = 0; r < 16; ++r) o[d][r] *= al_l[crow(r, hi)]; } } while (0)
  f32x16 pA0, pA1, pB0, pB1; float mnA, mnB, alA, alB; bf16x8 pa0, pa1, pa2, pa3; const int NT = seq / KVBLK;
  SLOAD(0, 0); asm volatile("s_waitcnt vmcnt(0)" ::: "memory"); SWRITE(0, 0); __syncthreads();
  qkt(pA0, pA1, K_lds, P_lds, qr, qp, r32, hi); partialSM(pA0, pA1, m_reg, mnA, alA);
  SLOAD(0, KVBLK);
  SWAIT(); SWRITE(1, 0); __syncthreads();
  for (int j = 1; j + 1 < NT; j += 2) {
    SBAR(); qkt(pB0, pB1, K_lds + SHM_K, P_lds + SHM_P, qr, qp, r32, hi);
    finishSM(pA0, pA1, alA, l_reg, pa0, pa1, pa2, pa3); SBAR();
    SLOAD(0, (j + 1) * KVBLK); SBAR();
    pv_d0(o, vb0, pa0, pa1, pa2, pa3); partialSM(pB0, pB1, m_reg, mnB, alB);
    __syncthreads(); SWAIT(); SWRITE(0, 0);
    RESC(alB); __syncthreads();
    SBAR(); qkt(pA0, pA1, K_lds, P_lds, qr, qp, r32, hi);
    finishSM(pB0, pB1, alB, l_reg, pa0, pa1, pa2, pa3); SBAR();
    SLOAD(0, (j + 2) * KVBLK); SBAR();
    pv_d0(o, vb0 + (int)SHM_V, pa0, pa1, pa2, pa3); partialSM(pA0, pA1, m_reg, mnA, alA);
    __syncthreads(); SWAIT(); SWRITE(1, 0);
    RESC(alA); __syncthreads();
  }
  SBAR(); qkt(pB0, pB1, K_lds + SHM_K, P_lds + SHM_P, qr, qp, r32, hi);
  finishSM(pA0, pA1, alA, l_reg, pa0, pa1, pa2, pa3); SBAR();
  pv_d0(o, vb0, pa0, pa1, pa2, pa3); partialSM(pB0, pB1, m_reg, mnB, alB);
  __syncthreads(); RESC(alB);
  finishSM(pB0, pB1, alB, l_reg, pa0, pa1, pa2, pa3); SBAR();
  pv_d0(o, vb0 + (int)SHM_V, pa0, pa1, pa2, pa3);
  if (hi == 0) li_l[r32] = l_reg; asm volatile("s_waitcnt lgkmcnt(0)" ::: "memory");
  float rli[16];
#pragma unroll
  for (int r = 0; r < 16; ++r) rli[r] = __builtin_amdgcn_rcpf(li_l[crow(r, hi)]);
  char* Ow = (char*)Ob + (size_t)wid * (QBLK * DM * 2); const int ooff = (4 * hi * DM + r32) * 2;
#pragma unroll
  for (int r = 0; r < 16; ++r) { const int orow = (r & 3) + 8 * (r >> 2);
#pragma unroll
    for (int d0 = 0; d0 < 4; ++d0) { const unsigned w = cvtpk(o[d0][r] * rli[r], 0.f); *(bf16*)(Ow + ooff + (orow * DM + d0 * 32) * 2) = (bf16)(w & 0xffffu); } }
  __syncthreads();
#undef SLOAD
#undef SWRITE
#undef SWAIT
#undef RESC
}
#undef KSWZ
#undef PSWZ
#undef SBAR
}

__global__ void __launch_bounds__(NWAVES * 64, 2) fwd_kernel(Args args) {
    extern __shared__ __attribute__((aligned(16))) unsigned char lds[];
    Frame F;
    F.lds = (LAS unsigned char*)lds;
    F.MISC = (volatile LAS unsigned*)(F.lds + MISC_OFF);
    F.tid = threadIdx.x; F.lane = F.tid & 63; F.wave = __builtin_amdgcn_readfirstlane(F.tid >> 6);
    F.G = gridDim.x; { const int bx = blockIdx.x; F.vcu = (F.G % 8 == 0) ? (bx % 8) * (F.G / 8) + bx / 8 : bx; }
    unsigned char* ws = args.ws;
    F.ctl = (gu32*)(ws + WS_CTL);
    for (int u = F.tid; u < (LDS_BYTES - LDSCTL_OFF) / 4; u += NWAVES * 64) ((LAS unsigned*)(F.lds + LDSCTL_OFF))[u] = 0u;
    __syncthreads();
    XcdBarrier bar = xcd_barrier_post((unsigned*)(F.ctl + CW_BAR), F.MISC + 8);
#define GRID_BAR() xcd_barrier(bar, F.wave)
#ifndef DROPMASK
#define DROPMASK 0
#endif
#ifndef PHMASK
#define PHMASK 0xffffffffu
#endif
#ifndef DUPMASK
#define DUPMASK 0u
#endif
#define PH(k) FRESH(); if constexpr (((PHMASK) >> (k)) & 1u) for (int rep_ = 0; rep_ < ((((DUPMASK) >> (k)) & 1u) ? 2 : 1); ++rep_)
#define FRESH() do { F.lane = fresh_lane(); F.tid = F.wave * 64 + F.lane; } while (0)
    unsigned char* ar = ws + WS_ARENA;
    float* const mod = (float*)(ws + WS_MOD); const float* const mod0 = mod; const float* const mod1 = mod + 9 * MODW;
    const float* const rope = (const float*)(ws + WS_ROPE);
    bf16* const XCb = nullptr; (void)XCb;
    float* const XC = (float*)(ar + AR_XC * MiB);
    bf16* const H = (bf16*)(ar + AR_H * MiB);
    PG8_LAS unsigned char* const ring = (PG8_LAS unsigned char*)(F.lds + RING_OFF);
    const int G = F.G, cid = (int)blockIdx.x;
#if SELFCHECK
    chk::Ctx CK{&args, ws, ar, (unsigned*)(ws + WS_CTL) + CW_DBG, mod, XC};
#define CHK(stmt) do { FRESH(); stmt; GRID_BAR(); } while (0)
#else
#define CHK(stmt) do { } while (0)
#endif

#ifndef XW_LATE
#define XW_LATE 1
#endif
    PH(0) { p0_prologue<0>(F, args); if (!XW_LATE) p0_prologue<1>(F, args); }
    GRID_BAR();
    CHK(chk::c_mod(F, CK));
    PH(1) norm_phase<false>(F, args, args.in[I_X], args.in[I_CTX], MALL, args.in[I_NORMG] + 0 * DM, mod0, 0, H);
    GRID_BAR();
    CHK(chk::c_norm(F, CK, 1, args.in[I_X], args.in[I_CTX], MALL, args.in[I_NORMG], mod0, 0, H));
    PH(2) { pg8::Gemm g{H, (const bf16*)(ws + WS_WIN), MALL, 2048, DM}; pg8::StaticOrder S; S.init(MALL, 2048, G, cid);
      epi::EpiMixIn E{(bf16*)(ar + AR_AG * MiB), (bf16*)(ar + AR_UG * MiB), (bf16*)(ar + AR_VG * MiB)};
      pg8::gemm_phase<epi::EpiMixIn, pg8::StaticOrder, true>(ring, g, S, E, F.wave); }
    GRID_BAR();
    CHK(chk::c_mixin(F, CK, H, (const bf16*)(ar + AR_AG * MiB), (const bf16*)(ar + AR_UG * MiB), (const bf16*)(ar + AR_VG * MiB)));
    PH(3) mixmid_phase(F, args, (const bf16*)(ar + AR_AG * MiB), (const bf16*)(ar + AR_UG * MiB), (const bf16*)(ar + AR_VG * MiB), (const bf16*)(ws + WS_WSB), H);
    GRID_BAR();
    CHK(chk::c_mixmid(F, CK, (const bf16*)(ar + AR_AG * MiB), (const bf16*)(ar + AR_UG * MiB), (const bf16*)(ar + AR_VG * MiB), H));
    PH(4) { pg8::Gemm g{H, (const bf16*)(ws + WS_WOUT), MALL, DM, DM}; pg8::StaticOrder S; S.init(MALL, DM, G, cid);
      epi::EpiResid E{args.in[I_X], args.in[I_CTX], args.out, XC, mod0 + 2 * DM, (DROPMASK & 1) ? 0.f : 1.f};
      pg8::gemm_phase<epi::EpiResid, pg8::StaticOrder, true>(ring, g, S, E, F.wave); }
    GRID_BAR();
    CHK(chk::c_resid(F, CK, 4, MALL, H, DM, args.in[I_EWOUT], mod0 + 2 * DM, args.in[I_X], args.in[I_CTX], false));
    PH(5) norm_phase<false, FFN_FP8 == 1>(F, args, args.out, XC, MALL, args.in[I_NORMG] + 1 * DM, mod0, 3, H);
    GRID_BAR();
#if !FFN_FP8
    CHK(chk::c_norm(F, CK, 5, args.out, XC, MALL, args.in[I_NORMG] + DM, mod0, 3, H));
#endif
#if FFN_FP8
#if FFN_FP8 == 1
    PH(6) { pg8::Gemm g{H, (const bf16*)(ws + WS_W13), MALL, 2 * DFF, DM / 2, 0x7f7f7f7f, SC_W13 * 0x01010101}; pg8::StaticOrder S; S.init(MALL, 2 * DFF, G, cid);
      epi::EpiSwiGluF8 E{ar + AR_ACT * MiB, DFF, 2 * DFF / 256};
      pg8::gemm_phase<epi::EpiSwiGluF8, pg8::StaticOrder, true, false, true>(ring, g, S, E, F.wave); }
#else
    PH(6) { pg8::Gemm g{H, (const bf16*)(ws + WS_W13), MALL, 2 * DFF, DM}; pg8::StaticOrder S; S.init(MALL, 2 * DFF, G, cid);
      epi::EpiSwiGluF8 E{ar + AR_ACT * MiB, DFF, 2 * DFF / 256};
      pg8::gemm_phase<epi::EpiSwiGluF8, pg8::StaticOrder, true>(ring, g, S, E, F.wave); }
#endif
    GRID_BAR();
    PH(7) { pg8::Gemm g{(const bf16*)(ar + AR_ACT * MiB), (const bf16*)(ws + WS_W2), MALL, DM, DFF / 2, 0x7f7f7f7f, SC_W2 * 0x01010101}; pg8::StaticOrder S; S.init(MALL, DM, G, cid);
      epi::EpiResid E{args.out, XC, args.out, XC, mod0 + 5 * DM, ((DROPMASK & 2) || rep_) ? 0.f : 1.f};
      pg8::gemm_phase<epi::EpiResid, pg8::StaticOrder, true, false, true>(ring, g, S, E, F.wave); }
    GRID_BAR();
#else
    PH(6) { pg8::Gemm g{H, (const bf16*)(ws + WS_W13), MALL, 2 * DFF, DM}; pg8::StaticOrder S; S.init(MALL, 2 * DFF, G, cid);
      epi::EpiSwiGlu E{(bf16*)(ar + AR_ACT * MiB), DFF, 2 * DFF / 256};
      pg8::gemm_phase<epi::EpiSwiGlu, pg8::StaticOrder, true>(ring, g, S, E, F.wave); }
    GRID_BAR();
    CHK(chk::c_swiglu(F, CK, H, (const bf16*)(ar + AR_ACT * MiB)));
    CHK(chk::c_capture(F, CK, 7, MALL));
    PH(7) { pg8::Gemm g{(const bf16*)(ar + AR_ACT * MiB), (const bf16*)(ws + WS_W2), MALL, DM, DFF}; pg8::StaticOrder S; S.init(MALL, DM, G, cid);
      epi::EpiResid E{args.out, XC, args.out, XC, mod0 + 5 * DM, ((DROPMASK & 2) || rep_) ? 0.f : 1.f};
      pg8::gemm_phase<epi::EpiResid, pg8::StaticOrder, true>(ring, g, S, E, F.wave); }
    GRID_BAR();
    CHK(chk::c_resid(F, CK, 7, MALL, (const bf16*)(ar + AR_ACT * MiB), DFF, args.in[I_FW2], mod0 + 5 * DM, nullptr, nullptr, true));
#endif
    PH(8) norm_phase<false>(F, args, args.out, XC, MALL, args.in[I_NORMG] + 2 * DM, mod1, 0, H);
    GRID_BAR();
    CHK(chk::c_norm(F, CK, 8, args.out, XC, MALL, args.in[I_NORMG] + 2 * DM, mod1, 0, H));
    PH(9) { pg8::Gemm g{H, (const bf16*)(ws + WS_WINO), MALL, INO_PAD, DM}; pg8::StaticOrder S; S.init(MALL, INO_PAD, G, cid);
      epi::EpiPlain E{(bf16*)(ar + AR_Z * MiB), INO_PAD};
      pg8::gemm_phase<epi::EpiPlain, pg8::StaticOrder, true>(ring, g, S, E, F.wave); }
    GRID_BAR();
    CHK(chk::c_z(F, CK, H, (const bf16*)(ar + AR_Z * MiB)));
    PH(10) zsplit_phase(F, args, (const bf16*)(ar + AR_Z * MiB), (bf16*)(ar + AR_QN * MiB), (bf16*)(ar + AR_KVN * MiB), (bf16*)(ar + AR_KPE * MiB), rope);
    GRID_BAR();
    CHK(chk::c_zsplit(F, CK, (const bf16*)(ar + AR_Z * MiB), (const bf16*)(ar + AR_QN * MiB), (const bf16*)(ar + AR_KVN * MiB), (const bf16*)(ar + AR_KPE * MiB)));
    PH(11) { pg8::Gemm g{(const bf16*)(ar + AR_QN * MiB), (const bf16*)(ws + WS_WUQ), NLAT, 1536, QRANK}; pg8::StaticOrder S; S.init(NLAT, 1536, G, cid);
      epi::EpiQ E{(bf16*)(ar + AR_Q * MiB), rope};
      pg8::gemm_phase<epi::EpiQ, pg8::StaticOrder, true>(ring, g, S, E, F.wave); }
    PH(12) { pg8::Gemm g{(const bf16*)(ar + AR_KVN * MiB), (const bf16*)(ws + WS_WUKV), MALL, 2048, KVRANK}; pg8::StaticOrder S; S.init(MALL, 2048, G, cid);
      epi::EpiKV E{(bf16*)(ar + AR_KN * MiB), (bf16*)(ar + AR_V * MiB)};
      pg8::gemm_phase<epi::EpiKV, pg8::StaticOrder, true>(ring, g, S, E, F.wave); }
    GRID_BAR();
    CHK(chk::c_qkv(F, CK, (const bf16*)(ar + AR_QN * MiB), (const bf16*)(ar + AR_KVN * MiB), (const bf16*)(ar + AR_Q * MiB), (const bf16*)(ar + AR_KN * MiB), (const bf16*)(ar + AR_V * MiB)));
    PH(13) { const bf16* Qg = (const bf16*)(ar + AR_Q * MiB); const bf16* Kg = (const bf16*)(ar + AR_KN * MiB); const bf16* Pg = (const bf16*)(ar + AR_KPE * MiB); const bf16* Vg = (const bf16*)(ar + AR_V * MiB);
      bf16* Og = (bf16*)(ar + AR_ATT * MiB);
      constexpr int NQB = SEQ / 256, NU = NB * NHEAD * NQB;
      for (int u = F.vcu; u < NU; u += G) { const int bh = u / NQB, qb = u - bh * NQB, b = bh / NHEAD, h = bh - b * NHEAD;
          att::attn_unit(Qg + ((size_t)bh * SEQ + qb * 256) * QKD, Kg + (size_t)bh * SKV * VHD, Pg + (size_t)b * SKV * ROPE, Vg + (size_t)bh * SKV * VHD,
                         Og + ((size_t)b * SEQ + qb * 256) * DM + h * VHD, SKV, (char*)lds + RING_OFF, F.wave); } }
    GRID_BAR();
    CHK(chk::c_attn(F, CK, (const bf16*)(ar + AR_Q * MiB), (const bf16*)(ar + AR_KN * MiB), (const bf16*)(ar + AR_KPE * MiB), (const bf16*)(ar + AR_V * MiB), (const bf16*)(ar + AR_ATT * MiB)));
    CHK(chk::c_capture(F, CK, 13, NLAT));
    PH(14) { pg8::Gemm g{(const bf16*)(ar + AR_ATT * MiB), (const bf16*)(ws + WS_WO), NLAT, DM, DM}; pg8::StaticOrder S; S.init(NLAT, DM, G, cid);
      epi::EpiResid E{args.out, XC, args.out, XC, mod1 + 2 * DM, ((DROPMASK & 4) || rep_) ? 0.f : 1.f};
      pg8::gemm_phase<epi::EpiResid, pg8::StaticOrder, true>(ring, g, S, E, F.wave); }
    GRID_BAR();
    CHK(chk::c_resid(F, CK, 13, NLAT, (const bf16*)(ar + AR_ATT * MiB), DM, args.in[I_WO], mod1 + 2 * DM, nullptr, nullptr, true));
    PH(15) norm_phase<true>(F, args, args.out, XC, NLAT, args.in[I_NORMG] + 3 * DM, mod1, 3, (bf16*)(ar + AR_H4 * MiB));
    GRID_BAR();
    CHK(chk::c_route(F, CK, mod1, ar + AR_H4 * MiB));
    if (XW_LATE) { PH(19) p0_prologue<1>(F, args); GRID_BAR(); }
    LAS int* const tab = (LAS int*)(F.lds + MOET_OFF);
    { FRESH();
      if (F.tid == 0) { int base = 0;
          for (int e = 0; e < NEXP; ++e) { const int c = (int)__hip_atomic_load((unsigned*)F.ctl + CW_CNT + 64 * e, RLX_AGENT); tab[e] = base; tab[16 + e] = c; base += (c + 255) >> 8; }
          tab[8] = base; }
      __syncthreads(); }
    const int TT = tab[8];
    const unsigned* const list = (const unsigned*)(ws + WS_LIST);
    PH(16) { pg8::Gemm g{(const bf16*)(ar + AR_H4 * MiB), (const bf16*)(ws + WS_EW13), TT * 256, 2 * DEXP, DM / 2, 0x7f7f7f7f, SC_W13 * 0x01010101};
      MoeOrder S; S.so.init(TT * 256, 2 * DEXP, G, cid); S.nN = 2 * DEXP / 256; S.tab = tab; S.list = list; S.tok0 = 0;
      epi::EpiSwiGluF8 E{ar + AR_ACTE * MiB, DEXP, 2 * DEXP / 256};
      pg8::gemm_phase<epi::EpiSwiGluF8, MoeOrder, true, true, true>(ring, g, S, E, F.wave); }
    GRID_BAR();
    CHK(chk::c_moe_up(F, CK, tab, ar + AR_H4 * MiB, ar + AR_ACTE * MiB));
    PH(17) { pg8::Gemm g{(const bf16*)(ar + AR_ACTE * MiB), (const bf16*)(ws + WS_EW2), TT * 256, DM, DEXP / 2, 0x7f7f7f7f, SC_W2 * 0x01010101};
      MoeOrder S; S.so.init(TT * 256, DM, G, cid); S.nN = DM / 256; S.tab = tab; S.list = list; S.tok0 = 0;
      epi::EpiMoeDown E{(bf16*)(ar + AR_Y * MiB), list, tab};
      pg8::gemm_phase<epi::EpiMoeDown, MoeOrder, true, false, true>(ring, g, S, E, F.wave); }
    GRID_BAR();
    CHK(chk::c_moe_down(F, CK, tab, ar + AR_ACTE * MiB, (const bf16*)(ar + AR_Y * MiB)));
    CHK(chk::c_cap_rows(F, CK));
    PH(18) combine_phase(F, args, (const bf16*)(ar + AR_Y * MiB), mod1, (DROPMASK & 8) ? 0.f : 1.f);
#if SELFCHECK
    GRID_BAR(); CHK(chk::c_combine(F, CK, mod1, (const bf16*)(ar + AR_Y * MiB)));
    { FRESH(); int code = -1;
      for (int k = 39; k >= 0; --k) { const unsigned f = __hip_atomic_load(CK.dbg + 64 * k, RLX_AGENT), n = __hip_atomic_load(CK.dbg + 64 * k + 1, RLX_AGENT); if (f * 50u > n) code = k; }
      if (code >= 0) { const float v = sqrtf((float)(code + 1)); for (size_t i = (size_t)blockIdx.x * 512 + F.tid; i < (size_t)NLAT * DM; i += (size_t)gridDim.x * 512) args.out[i] = v; } }
#endif
#undef GRID_BAR
}

extern "C" void kernel_launch(void* const* d_in, const int* in_sizes, int n_in, void* d_out, int out_size, void* d_ws, size_t ws_size, hipStream_t stream) {
    static int grid = 0;
    if (grid == 0) {
        if (n_in != 31 || in_sizes[0] != NLAT * DM || out_size != NLAT * DM || ws_size < WS_END) {
            fprintf(stderr, "kernel_launch: shape mismatch: n_in %d in0 %d out %d ws %zu (need %zu); nothing launched\n", n_in, n_in > 0 ? in_sizes[0] : -1, out_size, ws_size, (size_t)WS_END); grid = -1; return; }
        int dev = 0, cus = 0, per_cu = 0;
        if (hipGetDevice(&dev) != hipSuccess || hipDeviceGetAttribute(&cus, hipDeviceAttributeMultiprocessorCount, dev) != hipSuccess) { fprintf(stderr, "kernel_launch: device query failed\n"); grid = -1; return; }
        if (hipFuncSetAttribute((const void*)fwd_kernel, hipFuncAttributeMaxDynamicSharedMemorySize, LDS_BYTES) != hipSuccess) { fprintf(stderr, "kernel_launch: hipFuncSetAttribute failed\n"); grid = -1; return; }
        if (hipOccupancyMaxActiveBlocksPerMultiprocessor(&per_cu, (const void*)fwd_kernel, NWAVES * 64, LDS_BYTES) != hipSuccess || per_cu < 1) {
            fprintf(stderr, "kernel_launch: occupancy query reports %d workgroups per CU; nothing launched\n", per_cu); (void)hipGetLastError(); grid = -1; return; }
        grid = cus;
    }
    if (grid < 0) return;
    if (hipMemsetAsync((char*)d_ws + WS_CTL, 0, CTL_ZERO_BYTES, stream) != hipSuccess) { fprintf(stderr, "kernel_launch: memset failed\n"); return; }
    Args a{};
    for (int i = 0; i < 31; ++i) a.in[i] = (const float*)d_in[i];
    a.out = (float*)d_out; a.ws = (unsigned char*)d_ws;
    hipLaunchKernelGGL(fwd_kernel, dim3(grid), dim3(NWAVES * 64), LDS_BYTES, stream, a);
    const hipError_t le = hipPeekAtLastError();
    if (le != hipSuccess) fprintf(stderr, "kernel_launch: launch failed: %s\n", hipGetErrorName(le));
}
```

```cpp
#include <hip/hip_runtime.h>
#include <cstdio>
#include <cstdint>
#ifndef DUPMASK
#define DUPMASK 0u
#endif
#ifndef FFN_FP8
#define FFN_FP8 2
#endif
#ifndef DROPMASK
#define DROPMASK 0
#endif

__device__ __forceinline__ int fresh_lane() { int l; asm volatile("v_mbcnt_lo_u32_b32 %0, -1, 0\n\tv_mbcnt_hi_u32_b32 %0, -1, %0" : "=v"(l)); return l; }
namespace pg8 {
#define PG8_LAS __attribute__((address_space(3)))
typedef unsigned short bf16_t;
typedef short bf16x8 __attribute__((ext_vector_type(8)));
typedef float f32x4 __attribute__((ext_vector_type(4)));
typedef unsigned u32x4 __attribute__((ext_vector_type(4)));
constexpr int BM = 256, BK = 64, HALF = 128, HTB = HALF * BK * 2  , STAGE_BYTES = 8 * HTB, NXCD = 8, WGM = 8;

__host__ __device__ __forceinline__ int lds_byte(int r, int c) { const int st = (r >> 4) * 2 + (c >> 5), rr = r & 15, cc = c & 31, ob = rr * 64 + cc * 2; return st * 1024 + (ob ^ (((ob >> 9) & 1) << 5)); }
__host__ __device__ __forceinline__ void stage_rc(int b, int& R, int& C) { const int st = b / 1024, sb = b % 1024, swz = sb ^ (((sb >> 9) & 1) << 5); R = (st >> 1) * 16 + swz / 64; C = (st & 1) * 32 + (swz % 64) / 2; }
__host__ __device__ __forceinline__ int perm32(int rho) { const int n = rho >> 4, i = rho & 15; return 8 * (i >> 2) + 4 * n + (i & 3); }

struct Unit { int pm, pn; };
struct Gemm { const bf16_t* A; const bf16_t* Bt; int M, N, K; int sa, sb; };
typedef int i32x4 __attribute__((ext_vector_type(4)));
typedef int i32x8 __attribute__((ext_vector_type(8)));

struct StaticOrder {
    int nM, nN, nwg, G, c;
    __host__ __device__ void init(int M, int N, int G_, int c_) { nM = M / BM; nN = N / BM; nwg = nM * nN; G = G_; c = c_; }
    __host__ __device__ bool next(int i, Unit& u) const {
        const long L = (long)i * G + c; if (L >= nwg) return false;
        int wgid = (int)L; { const int q = nwg / NXCD, r = nwg % NXCD, xcd = wgid % NXCD, off = wgid / NXCD; wgid = (xcd < r ? xcd * (q + 1) : r * (q + 1) + (xcd - r) * q) + off; }
        const int nig = WGM * nN, gid = wgid / nig, fm = gid * WGM, gsz = (nM - fm) < WGM ? (nM - fm) : WGM;
        u.pm = fm + ((wgid % nig) % gsz); u.pn = (wgid % nig) / gsz; return true;
    }
    __device__ __forceinline__ int arow(const Unit&, int) const { return 0; }
};

__device__ __forceinline__ unsigned cvt_pk_bf16(float lo, float hi) { unsigned r; asm volatile("v_cvt_pk_bf16_f32 %0, %1, %2" : "=v"(r) : "v"(lo), "v"(hi)); return r; }
__device__ __forceinline__ u32x4 pack8(const f32x4 a, const f32x4 b) { u32x4 w; w.x = cvt_pk_bf16(a[0], a[1]); w.y = cvt_pk_bf16(a[2], a[3]); w.z = cvt_pk_bf16(b[0], b[1]); w.w = cvt_pk_bf16(b[2], b[3]); return w; }

template <class Epi, class Sched, bool ALIGN_EPI = false, bool GATHER = false, bool FP8 = false>
__device__ __forceinline__ void gemm_phase(PG8_LAS unsigned char* lds, const Gemm g, const Sched& S, const Epi& E, int wave_id) {
    const int wid = __builtin_amdgcn_readfirstlane(wave_id), tid = wid * 64 + fresh_lane(), lane = tid & 63, wr = wid >> 2, wc = wid & 3, fr = lane & 15, fq = lane >> 4;
    const int K = g.K, nt = K / BK;
    unsigned voffA[2], voffB[2]; int RA[2], CA[2];
#pragma unroll
    for (int i = 0; i < 2; ++i) { int R, C; stage_rc(tid * 16 + i * 8192, R, C); const int Rb = Epi::PERM ? ((R & ~31) + perm32(R & 31)) : R;
        RA[i] = R; CA[i] = C; voffA[i] = (unsigned)(R * K + C) * 2u; voffB[i] = (unsigned)(Rb * K + C) * 2u; }
    const size_t kstep = (size_t)(BK * 2);
    const size_t hstep = (size_t)HALF * K * 2;
    const size_t tstep = 2 * hstep;
    const unsigned ldsw = (unsigned)wid * 1024u;
    const int aoff = lds_byte(wr * 64 + fr, fq * 8), boff = lds_byte(wc * 32 + fr, fq * 8);
#define PG8_SA(b, h) (((b) * 2 + (h)) * HTB)
#define PG8_SB(b, h) ((4 + (b) * 2 + (h)) * HTB)
#define PG8_GLDS(gp, loff) __builtin_amdgcn_global_load_lds((const unsigned*)(gp), (PG8_LAS unsigned*)(lds + (loff)), 16, 0, 0)
#define PG8_STAGE(bufoff, gbase, voff) do { _Pragma("unroll") for (int _i = 0; _i < 2; ++_i) PG8_GLDS((const char*)(gbase) + (voff)[_i], (bufoff) + ldsw + _i * 8192); } while (0)
#define PG8_STAGE_A(bufoff, ptr_ng, ptr_g, h, nx) do { if constexpr (GATHER) { const unsigned _o0 = (nx) ? gn[h][0] : gc[h][0], _o1 = (nx) ? gn[h][1] : gc[h][1]; \
        PG8_GLDS((const char*)(ptr_g) + _o0, (bufoff) + ldsw); PG8_GLDS((const char*)(ptr_g) + _o1, (bufoff) + ldsw + 8192); } \
    else { PG8_STAGE(bufoff, (const char*)(ptr_ng) + (h) * hstep, voffA); } } while (0)
#define PG8_MAP(u, go) do { _Pragma("unroll") for (int _h = 0; _h < 2; ++_h) _Pragma("unroll") for (int _i = 0; _i < 2; ++_i) go[_h][_i] = ((unsigned)S.arow(u, _h * HALF + RA[_i]) * (unsigned)K + (unsigned)CA[_i]) * 2u; } while (0)
#define PG8_LD16(off) (*(const PG8_LAS bf16x8*)(lds + (off)))
#define PG8_CAT(x0, x1) __builtin_shufflevector(__builtin_bit_cast(i32x4, x0), __builtin_bit_cast(i32x4, x1), 0, 1, 2, 3, 4, 5, 6, 7)
#define PG8_LDA(dst, b, h) do { if constexpr (FP8) { _Pragma("unroll") for (int m = 0; m < 4; ++m) dst##8[m] = PG8_CAT(PG8_LD16(PG8_SA(b, h) + aoff + m * 2048), PG8_LD16(PG8_SA(b, h) + aoff + m * 2048 + 1024)); } \
    else { _Pragma("unroll") for (int m = 0; m < 4; ++m) _Pragma("unroll") for (int k = 0; k < 2; ++k) dst[m][k] = PG8_LD16(PG8_SA(b, h) + aoff + m * 2048 + k * 1024); } } while (0)
#define PG8_LDB(dst, b, h) do { if constexpr (FP8) { _Pragma("unroll") for (int n = 0; n < 2; ++n) dst##8[n] = PG8_CAT(PG8_LD16(PG8_SB(b, h) + boff + n * 2048), PG8_LD16(PG8_SB(b, h) + boff + n * 2048 + 1024)); } \
    else { _Pragma("unroll") for (int n = 0; n < 2; ++n) _Pragma("unroll") for (int k = 0; k < 2; ++k) dst[n][k] = PG8_LD16(PG8_SB(b, h) + boff + n * 2048 + k * 1024); } } while (0)
#define PG8_MMA(ai, bj, At, Bt) do { __builtin_amdgcn_s_setprio(1); if constexpr (FP8) { _Pragma("unroll") for (int m = 0; m < 4; ++m) _Pragma("unroll") for (int n = 0; n < 2; ++n) \
        asm volatile("v_mfma_scale_f32_16x16x128_f8f6f4 %0, %1, %2, %0, %3, %4 op_sel_hi:[0,0,0]" : "+v"(acc[ai][bj][m][n]) : "v"(Bt##8[n]), "v"(At##8[m]), "v"(vsb), "v"(vsa)); } \
    else { _Pragma("unroll") for (int m = 0; m < 4; ++m) _Pragma("unroll") for (int n = 0; n < 2; ++n) _Pragma("unroll") for (int k = 0; k < 2; ++k) \
        acc[ai][bj][m][n] = __builtin_amdgcn_mfma_f32_16x16x32_bf16(Bt[n][k], At[m][k], acc[ai][bj][m][n], 0, 0, 0); } __builtin_amdgcn_s_setprio(0); } while (0)
#define PG8_WAIT_V(n) asm volatile("s_waitcnt vmcnt(" #n ")" ::: "memory")
#define PG8_WAIT_L(n) asm volatile("s_waitcnt lgkmcnt(" #n ")" ::: "memory")
#define PG8_BAR __builtin_amdgcn_s_barrier()
#define PG8_SCHED __builtin_amdgcn_sched_barrier(0)
    Unit cur, nxt; int ui = 0;
    if (!S.next(0, cur)) return;
    const int vsa = g.sa, vsb = g.sb; (void)vsa; (void)vsb;
    f32x4 acc[2][2][4][2];
#pragma unroll
    for (int a = 0; a < 2; ++a)
#pragma unroll
        for (int b = 0; b < 2; ++b)
#pragma unroll
            for (int m = 0; m < 4; ++m)
#pragma unroll
                for (int n = 0; n < 2; ++n) acc[a][b][m][n] = (f32x4){0.f, 0.f, 0.f, 0.f};
    bf16x8 At[4][2], B0[2][2], B1[2][2]; i32x8 At8[4], B08[2], B18[2];
    unsigned gc[2][2] = {{0u, 0u}, {0u, 0u}}, gn[2][2] = {{0u, 0u}, {0u, 0u}};
    if constexpr (GATHER) { PG8_MAP(cur, gc); }
    const char* const gA = (const char*)g.A;
    const char* cA = GATHER ? gA : gA + (size_t)cur.pm * tstep; const char* cB = (const char*)g.Bt + (size_t)cur.pn * tstep;
    PG8_STAGE(PG8_SB(0, 0), cB, voffB); PG8_STAGE(PG8_SB(0, 1), cB + hstep, voffB); PG8_STAGE_A(PG8_SA(0, 0), cA, gA, 0, false); PG8_STAGE_A(PG8_SA(0, 1), cA, gA, 1, false);
    if (wr == 1) PG8_BAR;
    PG8_WAIT_V(2); PG8_BAR;
    PG8_STAGE(PG8_SB(1, 0), cB + kstep, voffB); PG8_STAGE_A(PG8_SA(1, 0), cA + kstep, gA + kstep, 0, false); PG8_STAGE(PG8_SB(1, 1), cB + hstep + kstep, voffB);
    PG8_WAIT_V(6); PG8_BAR;
    for (;;) {
        const bool has_next = S.next(ui + 1, nxt);
        if constexpr (GATHER) { if (has_next) { PG8_MAP(nxt, gn); } else {
#pragma unroll
            for (int h = 0; h < 2; ++h)
#pragma unroll
                for (int i = 0; i < 2; ++i) gn[h][i] = gc[h][i]; } }
        const char* nA = GATHER ? gA : (has_next ? gA + (size_t)nxt.pm * tstep : cA); const char* nB = has_next ? (const char*)g.Bt + (size_t)nxt.pn * tstep : cB;
#pragma unroll 1
        for (int t = 0; t < nt; t += 2) {
            const bool last = (t == nt - 2);
            const char* a1 = cA + (size_t)(t + 1) * kstep;
            const char* a2 = last ? nA : cA + (size_t)(t + 2) * kstep; const char* b2 = last ? nB : cB + (size_t)(t + 2) * kstep;
            const char* a3 = a2 + kstep; const char* b3 = b2 + kstep;
            PG8_LDB(B0, 0, 0); PG8_LDB(B1, 0, 1); PG8_SCHED; PG8_LDA(At, 0, 0); PG8_STAGE_A(PG8_SA(1, 1), a1, a1, 1, false);
            PG8_WAIT_V(8); PG8_WAIT_L(0); PG8_BAR; PG8_MMA(0, 0, At, B0); PG8_MMA(0, 1, At, B1); PG8_BAR; PG8_SCHED;
            PG8_LDA(At, 0, 1); PG8_STAGE(PG8_SB(0, 0), b2, voffB); PG8_STAGE(PG8_SB(0, 1), b2 + hstep, voffB); PG8_STAGE_A(PG8_SA(0, 0), a2, a2, 0, last);
            PG8_WAIT_V(8); PG8_WAIT_L(0); PG8_BAR; PG8_MMA(1, 0, At, B0); PG8_MMA(1, 1, At, B1); PG8_BAR; PG8_SCHED;
            PG8_LDB(B0, 1, 0); PG8_LDB(B1, 1, 1); PG8_SCHED; PG8_LDA(At, 1, 0); PG8_STAGE_A(PG8_SA(0, 1), a2, a2, 1, last);
            PG8_WAIT_V(8); PG8_WAIT_L(0); PG8_BAR; PG8_MMA(0, 0, At, B0); PG8_MMA(0, 1, At, B1); PG8_BAR; PG8_SCHED;
            PG8_LDA(At, 1, 1); PG8_STAGE(PG8_SB(1, 0), b3, voffB); PG8_STAGE(PG8_SB(1, 1), b3 + hstep, voffB); PG8_STAGE_A(PG8_SA(1, 0), a3, a3, 0, last);
            PG8_WAIT_V(8); PG8_WAIT_L(0); PG8_BAR; PG8_MMA(1, 0, At, B0); PG8_MMA(1, 1, At, B1); PG8_BAR; PG8_SCHED;
        }
        if constexpr (ALIGN_EPI) { if (wr == 0) PG8_BAR; }
        if constexpr (FP8) { asm volatile("s_nop 15\n\ts_nop 15" ::: "memory"); }
        E(acc, cur, wr, wc, fr, fq);
        if (!has_next) break;
#pragma unroll
        for (int a = 0; a < 2; ++a)
#pragma unroll
            for (int b = 0; b < 2; ++b)
#pragma unroll
                for (int m = 0; m < 4; ++m)
#pragma unroll
                    for (int n = 0; n < 2; ++n) acc[a][b][m][n] = (f32x4){0.f, 0.f, 0.f, 0.f};
        cur = nxt; cA = nA; cB = nB; ++ui;
        if constexpr (GATHER) {
#pragma unroll
            for (int h = 0; h < 2; ++h)
#pragma unroll
                for (int i = 0; i < 2; ++i) gc[h][i] = gn[h][i]; }
        if constexpr (ALIGN_EPI) { if (wr == 1) PG8_BAR; }
    }
    PG8_WAIT_V(0);
    if constexpr (!ALIGN_EPI) { if (wr == 0) PG8_BAR; }
    PG8_BAR;
#undef PG8_SA
#undef PG8_SB
#undef PG8_GLDS
#undef PG8_STAGE
#undef PG8_STAGE_A
#undef PG8_MAP
#undef PG8_LDA
#undef PG8_LD16
#undef PG8_LDB
#undef PG8_MMA
#undef PG8_CAT
#undef PG8_WAIT_V
#undef PG8_WAIT_L
#undef PG8_BAR
#undef PG8_SCHED
}
}
constexpr int NWAVES = 8;
constexpr int DM = 1024, NB = 8, SEQ = 4096, CTXL = 256;
constexpr int NLAT = NB * SEQ, NCTX = NB * CTXL, MALL = NLAT + NCTX;
constexpr int ACH = 512, BCH = 512, CONVK = 31, CHUNK = 128;
constexpr int DFF = 2816, NEXP = 8, DEXP = 3584;
constexpr int QRANK = 384, KVRANK = 256, ROPE = 64, INO = 704, INO_PAD = 768, NHEAD = 8, QKD = 192, VHD = 128;
constexpr int SKV = CTXL + SEQ;
constexpr float EPS = 1e-6f;
constexpr float ATTN_SCALE = 0.07216878364870322f;
constexpr int LIST_CAP = NLAT;
constexpr int XROWS = 2 * NLAT + NEXP * 256;
constexpr int SC_W13 = 127 - 5, SC_W2 = 127 - 6;
constexpr int MODW = 6 * DM;

constexpr size_t MiB = 1u << 20;
constexpr size_t WS_CTL = 0, CTL_ZERO_BYTES = 1 * MiB;
constexpr size_t WS_MOD = 1 * MiB;
constexpr size_t WS_ROPE = 1 * MiB + 512 * 1024;
constexpr size_t WS_TOKG = 1 * MiB + 768 * 1024;
constexpr size_t WS_LIST = 2 * MiB;
constexpr size_t WS_WIN = 4 * MiB, WS_WOUT = 8 * MiB, WS_W13 = 10 * MiB, WS_W2 = 21 * MiB, WS_WINO = 27 * MiB, WS_WUQ = 29 * MiB, WS_WUKV = 31 * MiB, WS_WO = 32 * MiB;
constexpr size_t WS_WSB = 3 * MiB;
constexpr size_t WS_EW13 = 34 * MiB, WS_EW2 = 90 * MiB, WS_ARENA = 118 * MiB;
static_assert(WS_W2 + (size_t)DM * DFF * 2 <= WS_WINO && WS_WINO + (size_t)INO_PAD * DM * 2 <= WS_WUQ && WS_WUQ + (size_t)1536 * QRANK * 2 <= WS_WUKV && WS_WUKV + (size_t)2048 * KVRANK * 2 <= WS_WO && WS_WO + (size_t)DM * DM * 2 <= 34 * MiB && WS_LIST + (size_t)NEXP * LIST_CAP * 4 <= WS_WSB, "weight map");
static_assert(WS_EW13 + (size_t)NEXP * 2 * DEXP * DM == WS_EW2 && WS_EW2 + (size_t)NEXP * DM * DEXP == WS_ARENA, "expert weight map");
constexpr size_t AR_XC = 0, AR_H = 8, AR_AG = 76, AR_UG = 110, AR_VG = 144, AR_ACT = 76, AR_Z = 76, AR_QN = 127, AR_KVN = 151, AR_KPE = 168, AR_Q = 173, AR_KN = 0, AR_V = 269, AR_ATT = 68;
constexpr size_t AR_H4 = 0, AR_Y = 32, AR_ACTE = 160, AR_END = 392;
constexpr size_t WS_END = WS_ARENA + AR_END * MiB;
static_assert(AR_ACT * MiB + (size_t)MALL * DFF * 2 <= AR_V * MiB && AR_ACTE * MiB + (size_t)XROWS * DEXP <= AR_END * MiB && (AR_V + 68) <= AR_END, "arena");
constexpr int CW_TMO = 0, CW_CODE = 1, CW_BAR = 4096, CW_CNT = 16384;

constexpr int RING_OFF = 0, RING_BYTES = 139264;
constexpr int LDSCTL_OFF = RING_BYTES, MISC_OFF = LDSCTL_OFF + 320, MOET_OFF = LDSCTL_OFF + 512;
constexpr int LDS_BYTES = 147456;

#define GAS __attribute__((address_space(1)))
#define LAS __attribute__((address_space(3)))
typedef unsigned short bf16;
typedef unsigned v4u __attribute__((ext_vector_type(4)));
typedef unsigned v2u __attribute__((ext_vector_type(2)));
typedef float f32x4 __attribute__((ext_vector_type(4)));
typedef float f32x2 __attribute__((ext_vector_type(2)));
typedef short bf16x8 __attribute__((ext_vector_type(8)));
typedef GAS unsigned gu32;
#define RLX_AGENT __ATOMIC_RELAXED, __HIP_MEMORY_SCOPE_AGENT
#define LDS_WAIT() asm volatile("s_waitcnt lgkmcnt(0)" ::: "memory")
#define VM_WAIT() asm volatile("s_waitcnt vmcnt(0)" ::: "memory")
using pg8::cvt_pk_bf16; using pg8::pack8;
__device__ __forceinline__ float bf_lo(unsigned w) { return __builtin_bit_cast(float, w << 16); }
__device__ __forceinline__ float bf_hi(unsigned w) { return __builtin_bit_cast(float, w & 0xffff0000u); }
__device__ __forceinline__ unsigned pk_fp8x4(float a, float b, float c, float d) { int w = 0; w = __builtin_amdgcn_cvt_pk_fp8_f32(a, b, w, false); w = __builtin_amdgcn_cvt_pk_fp8_f32(c, d, w, true); return (unsigned)w; }
__device__ __forceinline__ float fsigmoid(float x) { return __builtin_amdgcn_rcpf(1.0f + __builtin_amdgcn_exp2f(-1.4426950408889634f * x)); }
__device__ __forceinline__ float fsilu(float x) { return x * fsigmoid(x); }
__device__ __forceinline__ float fgelu(float x) { const float u = 0.7978845608028654f * (x + 0.044715f * x * x * x); return x * fsigmoid(2.0f * u); }
template <int K> __device__ __forceinline__ float lane_xor(float v) { return __builtin_bit_cast(float, __builtin_amdgcn_ds_swizzle(__builtin_bit_cast(int, v), (K << 10) | 0x1f)); }
__device__ __forceinline__ float wave_sum(float v) {
    v += lane_xor<1>(v); v += lane_xor<2>(v); v += lane_xor<4>(v); v += lane_xor<8>(v); v += lane_xor<16>(v);
    return __builtin_bit_cast(float, __builtin_amdgcn_readlane(__builtin_bit_cast(int, v), 0)) + __builtin_bit_cast(float, __builtin_amdgcn_readlane(__builtin_bit_cast(int, v), 32));
}

#define XB_TMO      128
#define XB_XCNT(j)  (256  + 64 * (j))
#define XB_XSUB(j)  (1280 + 64 * (j))
#define XB_XGEN(j)  (2304 + 64 * (j))
#define XB_TOP      3328
#define XB_TOPGEN   3392
#define XCD_BAR_WORDS 3456
#define XB_SPIN_CAP (1u << 18)

__device__ __forceinline__ unsigned xb_ld(unsigned* p)              { return __hip_atomic_load(p, __ATOMIC_RELAXED, __HIP_MEMORY_SCOPE_AGENT); }
__device__ __forceinline__ unsigned xb_add(unsigned* p, unsigned v) { return __hip_atomic_fetch_add(p, v, __ATOMIC_RELAXED, __HIP_MEMORY_SCOPE_AGENT); }
__device__ __forceinline__ unsigned xb_xcc_id() { return (unsigned)__builtin_amdgcn_s_getreg((3 << 11) | 20) & 0xFu; }
#define XB_SPIN(cond, bar) do { unsigned _sp = 0; while (cond) { __builtin_amdgcn_s_sleep(1); \
    if ((++_sp & 255u) == 0u) { if (xb_ld(&(bar)[XB_TMO])) break; if (_sp > XB_SPIN_CAP) { atomicAdd(&(bar)[XB_TMO], 1u); break; } } } } while (0)

struct XcdBarrier {
    unsigned* bar; unsigned x;
    volatile LAS unsigned* st;
};

__device__ __forceinline__ XcdBarrier xcd_barrier_post(unsigned* bar, volatile LAS unsigned* st) {
    XcdBarrier b; b.bar = bar; b.x = xb_xcc_id(); b.st = st;
    if (threadIdx.x == 0) (void)xb_add(&bar[XB_XCNT(b.x)], 1u);
    return b;
}
__device__ __forceinline__ void xcd_barrier_complete(unsigned* bar, unsigned x, unsigned& nloc, unsigned& nx) {
    const unsigned G = gridDim.x * gridDim.y * gridDim.z;
    unsigned sum, cnt, mine, sp = 0u;
    for (;;) {
        sum = 0u; cnt = 0u; mine = 0u;
#pragma unroll
        for (unsigned j = 0; j < 16; ++j) { const unsigned c = xb_ld(&bar[XB_XCNT(j)]); sum += c; cnt += (c > 0u) ? 1u : 0u; mine = (j == x) ? c : mine; }
        if (sum == G) break;
        __builtin_amdgcn_s_sleep(1);
        if ((++sp & 255u) == 0u) { if (xb_ld(&bar[XB_TMO])) break; if (sp > XB_SPIN_CAP) { atomicAdd(&bar[XB_TMO], 1u); break; } }
    }
    nloc = mine > 0u ? mine : 1u; nx = cnt > 0u ? cnt : 1u;
}

__device__ __forceinline__ void xcd_barrier(const XcdBarrier& b, int wave_id) {
    const bool t0 = (wave_id == 0) && (fresh_lane() == 0);
    asm volatile("s_waitcnt vmcnt(0)" ::: "memory");
    __syncthreads();
    if (t0) {
        unsigned* bar = b.bar;
        __builtin_amdgcn_s_waitcnt(0);
        unsigned nloc = b.st[0], nx = b.st[1];
        if (nloc == 0u) { xcd_barrier_complete(bar, b.x, nloc, nx); b.st[0] = nloc; b.st[1] = nx; }
        const unsigned old = xb_add(&bar[XB_XSUB(b.x)], 1u);
        const unsigned gen = old / nloc;
        if (old + 1u == (gen + 1u) * nloc) {
            __builtin_amdgcn_fence(__ATOMIC_RELEASE, "agent");
            asm volatile("s_waitcnt vmcnt(0)" ::: "memory");
            const unsigned og = xb_add(&bar[XB_TOP], 1u);
            const unsigned tg = og / nx;
            if (og + 1u == (tg + 1u) * nx) xb_add(&bar[XB_TOPGEN], 1u);
            else XB_SPIN(xb_ld(&bar[XB_TOPGEN]) == tg, bar);
            __builtin_amdgcn_fence(__ATOMIC_ACQUIRE, "agent");
            xb_add(&bar[XB_XGEN(b.x)], 1u);
            asm volatile("s_waitcnt vmcnt(0)" ::: "memory");
        } else {
            XB_SPIN(xb_ld(&bar[XB_XGEN(b.x)]) == gen, bar);
            __builtin_amdgcn_fence(__ATOMIC_ACQUIRE, "agent");
            asm volatile("s_waitcnt vmcnt(0)" ::: "memory");
        }
    }
    __syncthreads();
}
namespace epi {
using pg8::Unit; using pg8::f32x4; using pg8::u32x4; using pg8::bf16_t; using pg8::HALF; using pg8::BM;
#define EPI_ST16(base, off, val) (*(u32x4*)((char*)(base) + (unsigned)(off)) = (val))
#define EPI_ST8F(base, off, a, b) do { v2u w_; w_.x = pk_fp8x4((a)[0], (a)[1], (a)[2], (a)[3]); w_.y = pk_fp8x4((b)[0], (b)[1], (b)[2], (b)[3]); *(v2u*)((char*)(base) + (unsigned)(off)) = w_; } while (0)
struct EpiMixIn {
    static constexpr bool PERM = true;
    bf16_t *AG, *UG, *VG;
    __device__ __forceinline__ void operator()(const f32x4 (&acc)[2][2][4][2], const Unit& u, int wr, int wc, int fr, int fq) const {
        const int cw = wc * 32 + 8 * fq;
        if (u.pn < 4) {
            char* tb = (char*)(AG + (size_t)u.pm * (BM * ACH)); const unsigned lo = (unsigned)((wr * 64 + fr) * ACH + u.pn * 128 + cw) * 2u;
#pragma unroll
            for (int ai = 0; ai < 2; ++ai)
#pragma unroll
                for (int m = 0; m < 4; ++m) { f32x4 o0, o1;
#pragma unroll
                    for (int e = 0; e < 4; ++e) { o0[e] = acc[ai][0][m][0][e] * fsigmoid(acc[ai][1][m][0][e]); o1[e] = acc[ai][0][m][1][e] * fsigmoid(acc[ai][1][m][1][e]); }
                    EPI_ST16(tb + (ai * HALF + m * 16) * ACH * 2, lo, pack8(o0, o1)); }
        } else {
            char* tb = (char*)(((u.pn < 6) ? UG : VG) + (size_t)u.pm * (BM * BCH)); const unsigned lo = (unsigned)((wr * 64 + fr) * BCH + (u.pn & 1) * 256 + cw) * 2u;
#pragma unroll
            for (int ai = 0; ai < 2; ++ai)
#pragma unroll
                for (int m = 0; m < 4; ++m)
#pragma unroll
                    for (int bj = 0; bj < 2; ++bj) { f32x4 o0, o1;
#pragma unroll
                        for (int e = 0; e < 4; ++e) { o0[e] = fgelu(acc[ai][bj][m][0][e]); o1[e] = fgelu(acc[ai][bj][m][1][e]); }
                        EPI_ST16(tb + ((ai * HALF + m * 16) * BCH + bj * HALF) * 2, lo, pack8(o0, o1)); }
        }
    }
};
struct EpiSwiGlu {
    static constexpr bool PERM = true;
    bf16_t* O; int ldc, npn;
    __device__ __forceinline__ void operator()(const f32x4 (&acc)[2][2][4][2], const Unit& u, int wr, int wc, int fr, int fq) const {
        char* tb = (char*)(O + (size_t)u.pm * BM * ldc); const unsigned lo = (unsigned)((wr * 64 + fr) * ldc + (u.pn % npn) * 128 + wc * 32 + 8 * fq) * 2u;
#pragma unroll
        for (int ai = 0; ai < 2; ++ai)
#pragma unroll
            for (int m = 0; m < 4; ++m) { f32x4 o0, o1;
#pragma unroll
                for (int e = 0; e < 4; ++e) { o0[e] = fsilu(acc[ai][0][m][0][e]) * acc[ai][1][m][0][e]; o1[e] = fsilu(acc[ai][0][m][1][e]) * acc[ai][1][m][1][e]; }
                EPI_ST16(tb + (size_t)(ai * HALF + m * 16) * ldc * 2, lo, pack8(o0, o1)); }
    }
};
struct EpiSwiGluF8 {
    static constexpr bool PERM = true;
    unsigned char* O; int ldc, npn;
    __device__ __forceinline__ void operator()(const f32x4 (&acc)[2][2][4][2], const Unit& u, int wr, int wc, int fr, int fq) const {
        char* tb = (char*)(O + (size_t)u.pm * BM * ldc); const unsigned lo = (unsigned)((wr * 64 + fr) * ldc + (u.pn % npn) * 128 + wc * 32 + 8 * fq);
#pragma unroll
        for (int ai = 0; ai < 2; ++ai)
#pragma unroll
            for (int m = 0; m < 4; ++m) { f32x4 o0, o1;
#pragma unroll
                for (int e = 0; e < 4; ++e) { o0[e] = fsilu(acc[ai][0][m][0][e]) * acc[ai][1][m][0][e]; o1[e] = fsilu(acc[ai][0][m][1][e]) * acc[ai][1][m][1][e]; }
                v2u w; w.x = pk_fp8x4(o0[0], o0[1], o0[2], o0[3]); w.y = pk_fp8x4(o1[0], o1[1], o1[2], o1[3]);
                *(v2u*)(tb + (size_t)(ai * HALF + m * 16) * ldc + lo) = w; }
    }
};
struct EpiPlain {
    static constexpr bool PERM = true;
    bf16_t* O; int ldc;
    __device__ __forceinline__ void operator()(const f32x4 (&acc)[2][2][4][2], const Unit& u, int wr, int wc, int fr, int fq) const {
        char* tb = (char*)(O + (size_t)u.pm * BM * ldc + u.pn * BM); const unsigned lo = (unsigned)((wr * 64 + fr) * ldc + wc * 32 + 8 * fq) * 2u;
#pragma unroll
        for (int ai = 0; ai < 2; ++ai)
#pragma unroll
            for (int m = 0; m < 4; ++m)
#pragma unroll
                for (int bj = 0; bj < 2; ++bj) EPI_ST16(tb + ((size_t)(ai * HALF + m * 16) * ldc + bj * HALF) * 2, lo, pack8(acc[ai][bj][m][0], acc[ai][bj][m][1]));
    }
};
struct EpiResid {
    static constexpr bool PERM = false;
    const float *srcL, *srcC; float *dstL, *dstC; const float* gate; float mul;
    __device__ __forceinline__ void operator()(const f32x4 (&acc)[2][2][4][2], const Unit& u, int wr, int wc, int fr, int fq) const {
        const bool lat = u.pm < NLAT / BM; const int bi = lat ? (u.pm >> 4) : 8;
        const size_t tb = (size_t)(lat ? u.pm : u.pm - NLAT / BM) * (BM * DM) + u.pn * BM;
        const char* src = (const char*)((lat ? srcL : srcC) + tb); char* dst = (char*)((lat ? dstL : dstC) + tb); const float* gp = gate + bi * MODW + u.pn * BM;
        const unsigned lo = (unsigned)((wr * 64 + fr) * DM + wc * 32 + 4 * fq) * 4u, lg = (unsigned)(wc * 32 + 4 * fq) * 4u;
        f32x4 gv[2][2];
#pragma unroll
        for (int bj = 0; bj < 2; ++bj)
#pragma unroll
            for (int n = 0; n < 2; ++n) gv[bj][n] = *(const f32x4*)((const char*)gp + (bj * HALF + n * 16) * 4 + lg) * mul;
#pragma unroll
        for (int ai = 0; ai < 2; ++ai)
#pragma unroll
            for (int m = 0; m < 4; ++m) {
#pragma unroll
                for (int bj = 0; bj < 2; ++bj)
#pragma unroll
                    for (int n = 0; n < 2; ++n) { const int co = ((ai * HALF + m * 16) * DM + bj * HALF + n * 16) * 4;
                        const f32x4 bs = *(const f32x4*)(src + co + lo); *(f32x4*)(dst + co + lo) = bs + gv[bj][n] * acc[ai][bj][m][n]; }
                if (m & 1) asm volatile("" ::: "memory"); }
    }
};
struct EpiQ {
    static constexpr bool PERM = true;
    unsigned char* Q; const float* rope;
    __device__ __forceinline__ void operator()(const f32x4 (&acc)[2][2][4][2], const Unit& u, int wr, int wc, int fr, int fq) const {
        const int b = u.pm >> 4, t0 = (u.pm & 15) * BM, rl = wr * 64 + fr;
        if (u.pn < 4) {
#pragma unroll
            for (int bj = 0; bj < 2; ++bj) { char* tb = (char*)(Q + ((size_t)(b * NHEAD + 2 * u.pn + bj) * SEQ + t0) * QKD); const unsigned lo = (unsigned)(rl * QKD + wc * 32 + 8 * fq);
#pragma unroll
                for (int ai = 0; ai < 2; ++ai)
#pragma unroll
                    for (int m = 0; m < 4; ++m) EPI_ST8F(tb + (ai * HALF + m * 16) * QKD, lo, acc[ai][bj][m][0], acc[ai][bj][m][1]); }
        } else {
            const int h = 4 * (u.pn - 4) + wc, a = fq >> 1, f0 = 8 * (fq & 1);
            char* tb = (char*)(Q + ((size_t)(b * NHEAD + h) * SEQ + t0) * QKD + 128); const unsigned lo = (unsigned)(rl * QKD + a * 32 + f0);
#pragma unroll
            for (int ai = 0; ai < 2; ++ai)
#pragma unroll
                for (int m = 0; m < 4; ++m) { const int t = t0 + rl + ai * HALF + m * 16, pos = a ? (t & 63) : (t >> 6);
                    const char* cs = (const char*)rope + (unsigned)((pos * 16 + f0) * 8); f32x4 o1[2], o2[2];
#pragma unroll
                    for (int n = 0; n < 2; ++n) { const f32x4 c0 = *(const f32x4*)(cs + n * 32), c1 = *(const f32x4*)(cs + n * 32 + 16);
                        const f32x4 x1 = acc[ai][0][m][n], x2 = acc[ai][1][m][n];
                        o1[n][0] = x1[0] * c0[0] - x2[0] * c0[1]; o2[n][0] = x1[0] * c0[1] + x2[0] * c0[0];
                        o1[n][1] = x1[1] * c0[2] - x2[1] * c0[3]; o2[n][1] = x1[1] * c0[3] + x2[1] * c0[2];
                        o1[n][2] = x1[2] * c1[0] - x2[2] * c1[1]; o2[n][2] = x1[2] * c1[1] + x2[2] * c1[0];
                        o1[n][3] = x1[3] * c1[2] - x2[3] * c1[3]; o2[n][3] = x1[3] * c1[3] + x2[3] * c1[2]; }
                    EPI_ST8F(tb + (ai * HALF + m * 16) * QKD, lo, o1[0], o1[1]); EPI_ST8F(tb + (ai * HALF + m * 16) * QKD + 16, lo, o2[0], o2[1]);
                    asm volatile("" ::: "memory"); }
        }
    }
};
struct EpiKV {
    static constexpr bool PERM = true;
    unsigned char* KN; bf16_t* V;
    __device__ __forceinline__ void operator()(const f32x4 (&acc)[2][2][4][2], const Unit& u, int wr, int wc, int fr, int fq) const {
        const bool lat = u.pm < NLAT / BM; const int b = lat ? (u.pm >> 4) : (u.pm - NLAT / BM), key0 = lat ? CTXL + (u.pm & 15) * BM : 0;
        const size_t te = ((size_t)(b * NHEAD + u.pn) * SKV + key0) * VHD; char* kb = (char*)(KN + te); char* vb = (char*)(V + te);
        const unsigned lo = (unsigned)((wr * 64 + fr) * VHD + wc * 32 + 8 * fq);
#pragma unroll
        for (int ai = 0; ai < 2; ++ai)
#pragma unroll
            for (int m = 0; m < 4; ++m) { EPI_ST8F(kb + (ai * HALF + m * 16) * VHD, lo, acc[ai][0][m][0], acc[ai][0][m][1]); EPI_ST16(vb + (ai * HALF + m * 16) * VHD * 2, lo * 2u, pack8(acc[ai][1][m][0], acc[ai][1][m][1])); }
    }
};
struct EpiMoeDown {
    static constexpr bool PERM = true;
    bf16_t* Y; const unsigned* list; const LAS int* tab;
    __device__ __forceinline__ void operator()(const f32x4 (&acc)[2][2][4][2], const Unit& u, int wr, int wc, int fr, int fq) const {
        const int e = u.pn >> 2, pnl = u.pn & 3, cnt = tab[16 + e], s0 = (u.pm - tab[e]) * BM + wr * 64 + fr; const unsigned cb = (unsigned)(pnl * BM + wc * 32 + 8 * fq) * 2u;
        const char* lp = (const char*)(list + e * LIST_CAP);
#pragma unroll
        for (int ai = 0; ai < 2; ++ai)
#pragma unroll
            for (int m = 0; m < 4; ++m) { const int slot = s0 + ai * HALF + m * 16;
                if (slot < cnt) { const unsigned ent = *(const unsigned*)(lp + (unsigned)slot * 4u), ro = ent * (unsigned)(DM * 2) + cb;
#pragma unroll
                    for (int bj = 0; bj < 2; ++bj) EPI_ST16(Y, ro + bj * HALF * 2, pack8(acc[ai][bj][m][0], acc[ai][bj][m][1])); } }
    }
};
}
struct MoeOrder {
    pg8::StaticOrder so; int nN; const LAS int* tab; const unsigned* list; int tok0;
    __device__ __forceinline__ bool next(int i, pg8::Unit& u) const {
        if (!so.next(i, u)) return false;
        int e = 0;
#pragma unroll
        for (int k = 1; k < NEXP; ++k) e += (u.pm >= tab[k]) ? 1 : 0;
        u.pn += e * nN; return true;
    }
    __device__ __forceinline__ int arow(const pg8::Unit& u, int r) const {
        const int e = u.pn / nN, cnt = tab[16 + e], slot = (u.pm - tab[e]) * pg8::BM + r;
        const unsigned ent = list[e * LIST_CAP + (slot < cnt ? slot : 0)];
        return tok0 + (int)(ent >> 1);
    }
};
struct Args { const float* in[31]; float* out; unsigned char* ws; };
struct Frame {
    LAS unsigned char* lds; volatile LAS unsigned* MISC; gu32* ctl;
    int tid, lane, wave, vcu, G;
};
enum { I_X = 0, I_C, I_CTX, I_CCTX, I_WADA, I_BADA, I_NORMG, I_EWIN, I_CONVW, I_CONVB, I_LNAG, I_LNAB, I_LNVG, I_LNVB, I_WS, I_BS, I_EWOUT, I_FW1, I_FW3, I_FW2,
       I_OWIN, I_GQ, I_GKV, I_WUQ, I_WUKV, I_WO, I_ROUTER, I_XW1, I_XW3, I_XW2, I_FINALG };

struct MapId   { int off; __device__ __forceinline__ int operator()(int n) const { return off + n; } };
struct MapPair { int half; __device__ __forceinline__ int operator()(int n) const { return 256 * (n >> 7) + 128 * half + (n & 127); } };
struct MapMixIn { __device__ __forceinline__ int operator()(int n) const { if (n >= 1024) return n; const int j = n & 511, hf = n >> 9; return 256 * (j >> 7) + 128 * hf + (j & 127); } };
struct MapUq { __device__ __forceinline__ int operator()(int n) const { const int h = n / QKD, d = n - h * QKD; if (d < 128) return h * 128 + d;
    const int dd = d - 128, a = dd >> 5, p = (dd >> 4) & 1, f = dd & 15; return 1024 + 256 * (h >> 2) + 128 * p + (h & 3) * 32 + a * 16 + f; } };
template <class Map>
__device__ __forceinline__ void p0_transpose_item(const float* W, int K, int N, bf16* WT, const Map& map, LAS float* scr, int item, int lane) {
    const int nblk = N / 32, kb = item / nblk, nb = item - kb * nblk, k0 = 64 * kb, n0 = 32 * nb;
    float rg[32];
    const float* Wl = W + (size_t)(k0 + (lane >> 5)) * N + n0 + (lane & 31);
#pragma unroll
    for (int i = 0; i < 32; ++i) rg[i] = __builtin_nontemporal_load(Wl + (size_t)(2 * i) * N);
#pragma unroll
    for (int i = 0; i < 32; ++i) scr[(2 * i + (lane >> 5)) * 33 + (lane & 31)] = rg[i];
    LDS_WAIT(); asm volatile("" ::: "memory");
    const int c = lane & 7;
#pragma unroll
    for (int j = 0; j < 4; ++j) { const int n = (lane >> 3) + 8 * j; const LAS float* s = scr + (8 * c) * 33 + n;
        v4u o; o.x = cvt_pk_bf16(s[0 * 33], s[1 * 33]); o.y = cvt_pk_bf16(s[2 * 33], s[3 * 33]); o.z = cvt_pk_bf16(s[4 * 33], s[5 * 33]); o.w = cvt_pk_bf16(s[6 * 33], s[7 * 33]);
        *(GAS v4u*)(WT + (size_t)map(n0 + n) * K + k0 + 8 * c) = o; }
    LDS_WAIT(); asm volatile("" ::: "memory");
}
template <class Map>
__device__ __forceinline__ void p0_transpose_item_f8(const float* W, int K, int N, unsigned char* WT, const Map& map, float mul, LAS float* scr, int item, int lane) {
    const int nblk = N / 32, kb = item / nblk, nb = item - kb * nblk, k0 = 64 * kb, n0 = 32 * nb;
    float rg[32];
    const float* Wl = W + (size_t)(k0 + (lane >> 5)) * N + n0 + (lane & 31);
#pragma unroll
    for (int i = 0; i < 32; ++i) rg[i] = __builtin_nontemporal_load(Wl + (size_t)(2 * i) * N);
#pragma unroll
    for (int i = 0; i < 32; ++i) scr[(2 * i + (lane >> 5)) * 33 + (lane & 31)] = rg[i] * mul;
    LDS_WAIT(); asm volatile("" ::: "memory");
#pragma unroll
    for (int j = 0; j < 2; ++j) { const int idx = lane + 64 * j, n = idx >> 2, c = idx & 3; const LAS float* s = scr + (16 * c) * 33 + n;
        v4u o; o.x = pk_fp8x4(s[0 * 33], s[1 * 33], s[2 * 33], s[3 * 33]); o.y = pk_fp8x4(s[4 * 33], s[5 * 33], s[6 * 33], s[7 * 33]);
        o.z = pk_fp8x4(s[8 * 33], s[9 * 33], s[10 * 33], s[11 * 33]); o.w = pk_fp8x4(s[12 * 33], s[13 * 33], s[14 * 33], s[15 * 33]);
        *(GAS v4u*)(WT + (size_t)map(n0 + n) * K + k0 + 16 * c) = o; }
    LDS_WAIT(); asm volatile("" ::: "memory");
}
__device__ __forceinline__ void sincos_d(double th, float& c, float& s) {
    const double q = __builtin_rint(th * 0.63661977236758134308); const int n = (int)q;
    const double r = (th - q * 1.5707963267948966192) - q * 6.123233995736766036e-17, r2 = r * r;
    double sp = -7.6471637318198164759e-13; sp = sp * r2 + 1.6059043836821614599e-10; sp = sp * r2 - 2.5052108385441718775e-08; sp = sp * r2 + 2.7557319223985890653e-06;
    sp = sp * r2 - 1.9841269841269841253e-04; sp = sp * r2 + 8.3333333333333332177e-03; sp = sp * r2 - 1.6666666666666665741e-01; const double sr = r + r * r2 * sp;
    double cp = 4.7794773323873852974e-14; cp = cp * r2 - 1.1470745597729724714e-11; cp = cp * r2 + 2.0876756987868098979e-09; cp = cp * r2 - 2.7557319223985888e-07;
    cp = cp * r2 + 2.4801587301587301566e-05; cp = cp * r2 - 1.3888888888888889419e-03; cp = cp * r2 + 4.1666666666666664354e-02; const double cr = 1.0 - 0.5 * r2 + r2 * r2 * cp;
    const int k = n & 3; const double sv = (k == 0) ? sr : (k == 1) ? cr : (k == 2) ? -sr : -cr, cv = (k == 0) ? cr : (k == 1) ? -sr : (k == 2) ? -cr : sr;
    c = (float)cv; s = (float)sv;
}
__device__ __forceinline__ double inv_freq_d(int f) {
    const int q = f >> 2, r = f & 3; const double rr = (r == 0) ? 1.0 : (r == 1) ? 0.5623413251903491 : (r == 2) ? 0.31622776601683794 : 0.1778279410038923;
    const double qq = (q == 0) ? 1.0 : (q == 1) ? 0.1 : (q == 2) ? 0.01 : 0.001; return rr * qq;
}
template <int PART>
__device__ __forceinline__ void p0_prologue(Frame& F, const Args& A) {
    unsigned char* ws = A.ws;
    __syncthreads();
    if constexpr (PART == 0) {
    for (int rep_ = 0; rep_ < (((DUPMASK >> 24) & 1u) ? 2 : 1); ++rep_) {
        __syncthreads();
        LAS float* sv = (LAS float*)(F.lds + RING_OFF);
        LAS float* part = (LAS float*)(F.lds + RING_OFF + 9 * 1024 * 4);
        for (int i = F.tid; i < 9 * DM; i += NWAVES * 64) { const float v = (i < 8 * DM) ? A.in[I_C][i] : A.in[I_CCTX][i - 8 * DM]; sv[i] = fsilu(v); }
        __syncthreads();
        float* mod = (float*)(ws + WS_MOD);
        for (int it = F.vcu; it < 2 * MODW / 48; it += F.G) {
            const int l = it / (MODW / 48), j0 = (it - l * (MODW / 48)) * 48;
            const float* W = A.in[I_WADA] + (size_t)l * DM * MODW;
            if (F.tid < 480) { const int cc = F.tid % 48, ks = F.tid / 48, kbeg = ks * 103, kend = (kbeg + 103 < DM) ? kbeg + 103 : DM;
                float a[9];
#pragma unroll
                for (int b = 0; b < 9; ++b) a[b] = 0.f;
#pragma unroll 1
                for (int k8 = kbeg; k8 < kend; k8 += 13) { float w[13];
#pragma unroll
                    for (int i = 0; i < 13; ++i) w[i] = (k8 + i < kend) ? W[(size_t)(k8 + i) * MODW + j0 + cc] : 0.f;
#pragma unroll
                    for (int i = 0; i < 13; ++i) { const int k = (k8 + i < kend) ? k8 + i : kbeg;
#pragma unroll
                        for (int b = 0; b < 9; ++b) a[b] += sv[b * DM + k] * w[i]; } }
#pragma unroll
                for (int b = 0; b < 9; ++b) part[(ks * 9 + b) * 48 + cc] = a[b]; }
            __syncthreads();
            if (F.tid < 9 * 48) { const int b = F.tid / 48, cc = F.tid % 48; float s = A.in[I_BADA][l * MODW + j0 + cc];
#pragma unroll
                for (int ks = 0; ks < 10; ++ks) s += part[(ks * 9 + b) * 48 + cc];
                mod[(size_t)(l * 9 + b) * MODW + j0 + cc] = s; }
            __syncthreads();
        }
    }
    if (F.vcu == 0) for (int i = F.tid; i < 64 * 16; i += NWAVES * 64) { float c, s; sincos_d((double)(i >> 4) * inv_freq_d(i & 15), c, s); ((float*)(ws + WS_ROPE))[2 * i] = c; ((float*)(ws + WS_ROPE))[2 * i + 1] = s; }
    { const int gt = F.vcu * NWAVES * 64 + F.tid, NT = F.G * NWAVES * 64;
      for (int i = gt; i < NEXP * CHUNK * CHUNK / 4; i += NT) { const f32x4 v = ((const f32x4*)A.in[I_WS])[i]; v2u o; o.x = cvt_pk_bf16(v[0], v[1]); o.y = cvt_pk_bf16(v[2], v[3]); ((v2u*)(ws + WS_WSB))[i] = o; }
      for (int i = gt; i < (INO_PAD - INO) * DM * 2 / 16; i += NT) ((v4u*)(ws + WS_WINO + (size_t)INO * DM * 2))[i] = (v4u){0u, 0u, 0u, 0u}; }
    __syncthreads();
    }
    LAS float* scr = (LAS float*)(F.lds + RING_OFF + F.wave * 16384);
    const int gw = F.vcu * NWAVES + F.wave, NGW = F.G * NWAVES;
#define ITEMS(K_, N_) (((K_) / 64) * ((N_) / 32))
    constexpr int I_1 = ITEMS(DM, 2048), I_2 = ITEMS(DM, DM), I_3 = ITEMS(DM, DFF), I_4 = ITEMS(DFF, DM), I_5 = ITEMS(DM, INO), I_6 = ITEMS(QRANK, 1536), I_7 = ITEMS(KVRANK, 2048), I_8 = ITEMS(DM, DM);
    constexpr int I_E1 = ITEMS(DM, DEXP), I_E2 = ITEMS(DEXP, DM);
    constexpr int NSMALL = I_1 + I_2 + 2 * I_3 + I_4 + I_5 + I_6 + I_7 + I_8, NITEMS = NSMALL + NEXP * (2 * I_E1 + I_E2);
    constexpr int IT_LO = PART == 0 ? 0 : NSMALL, IT_HI = PART == 0 ? NSMALL : NITEMS;
    for (int rep_ = 0; rep_ < (((DUPMASK >> 25) & 1u) ? 2 : 1); ++rep_)
    for (int it = IT_LO + gw; it < IT_HI; it += NGW) {
        int r = it;
        if (r < I_1) { p0_transpose_item(A.in[I_EWIN], DM, 2048, (bf16*)(ws + WS_WIN), MapMixIn{}, scr, r, F.lane); continue; } r -= I_1;
        if (r < I_2) { p0_transpose_item(A.in[I_EWOUT], DM, DM, (bf16*)(ws + WS_WOUT), MapId{0}, scr, r, F.lane); continue; } r -= I_2;
        if (r < I_3) { if (FFN_FP8 == 1) p0_transpose_item_f8(A.in[I_FW1], DM, DFF, ws + WS_W13, MapPair{0}, 32.0f, scr, r, F.lane); else p0_transpose_item(A.in[I_FW1], DM, DFF, (bf16*)(ws + WS_W13), MapPair{0}, scr, r, F.lane); continue; } r -= I_3;
        if (r < I_3) { if (FFN_FP8 == 1) p0_transpose_item_f8(A.in[I_FW3], DM, DFF, ws + WS_W13, MapPair{1}, 32.0f, scr, r, F.lane); else p0_transpose_item(A.in[I_FW3], DM, DFF, (bf16*)(ws + WS_W13), MapPair{1}, scr, r, F.lane); continue; } r -= I_3;
        if (r < I_4) { if (FFN_FP8) p0_transpose_item_f8(A.in[I_FW2], DFF, DM, ws + WS_W2, MapId{0}, 64.0f, scr, r, F.lane); else p0_transpose_item(A.in[I_FW2], DFF, DM, (bf16*)(ws + WS_W2), MapId{0}, scr, r, F.lane); continue; } r -= I_4;
        if (r < I_5) { p0_transpose_item(A.in[I_OWIN], DM, INO, (bf16*)(ws + WS_WINO), MapId{0}, scr, r, F.lane); continue; } r -= I_5;
        if (r < I_6) { p0_transpose_item(A.in[I_WUQ], QRANK, 1536, (bf16*)(ws + WS_WUQ), MapUq{}, scr, r, F.lane); continue; } r -= I_6;
        if (r < I_7) { p0_transpose_item(A.in[I_WUKV], KVRANK, 2048, (bf16*)(ws + WS_WUKV), MapId{0}, scr, r, F.lane); continue; } r -= I_7;
        if (r < I_8) { p0_transpose_item(A.in[I_WO], DM, DM, (bf16*)(ws + WS_WO), MapId{0}, scr, r, F.lane); continue; } r -= I_8;
        { const int per = 2 * I_E1 + I_E2, e = r / per; r -= e * per;
          if (r < I_E1) { p0_transpose_item_f8(A.in[I_XW1] + (size_t)e * DM * DEXP, DM, DEXP, ws + WS_EW13 + (size_t)e * 2 * DEXP * DM, MapPair{0}, 32.0f, scr, r, F.lane); continue; } r -= I_E1;
          if (r < I_E1) { p0_transpose_item_f8(A.in[I_XW3] + (size_t)e * DM * DEXP, DM, DEXP, ws + WS_EW13 + (size_t)e * 2 * DEXP * DM, MapPair{1}, 32.0f, scr, r, F.lane); continue; } r -= I_E1;
          p0_transpose_item_f8(A.in[I_XW2] + (size_t)e * DEXP * DM, DEXP, DM, ws + WS_EW2 + (size_t)e * DM * DEXP, MapId{0}, 64.0f, scr, r, F.lane); }
    }
#undef ITEMS
}

template <bool ROUTE, bool OUT8 = ROUTE>
__device__ __forceinline__ void norm_phase(Frame& F, const Args& A, const float* srcL, const float* srcC, int nrows, const float* g, const float* modl, int shift_slot, bf16* H) {
    LAS float* rt = (LAS float*)(F.lds + RING_OFF);
    if constexpr (ROUTE) { for (int i = F.tid; i < DM * NEXP; i += NWAVES * 64) { const int k = i >> 3, e = i & 7; rt[e * DM + k] = A.in[I_ROUTER][i]; } __syncthreads(); }
    const int gw = F.vcu * NWAVES + F.wave, NGW = F.G * NWAVES;
    for (int row = gw; row < nrows; row += NGW) {
        const bool lat = row < NLAT; const float* src = lat ? srcL + (size_t)row * DM : srcC + (size_t)(row - NLAT) * DM; const int bi = lat ? (row >> 12) : 8;
        const float* sh = modl + bi * MODW + shift_slot * DM; const float* sc = sh + DM;
        f32x4 v[4]; float ss = 0.f;
#pragma unroll
        for (int j = 0; j < 4; ++j) { v[j] = ((const f32x4*)src)[F.lane + 64 * j]; ss += (v[j][0] * v[j][0] + v[j][1] * v[j][1]) + (v[j][2] * v[j][2] + v[j][3] * v[j][3]); }
        const float r = 1.0f / sqrtf(wave_sum(ss) * (1.0f / DM) + EPS);
        float lg[NEXP];
        if constexpr (ROUTE) {
#pragma unroll
            for (int e = 0; e < NEXP; ++e) lg[e] = 0.f; }
#pragma unroll
        for (int j = 0; j < 4; ++j) { const int c = 4 * F.lane + 256 * j; const f32x4 gv = *(const f32x4*)(g + c), s1 = *(const f32x4*)(sc + c), s0 = *(const f32x4*)(sh + c);
            const f32x4 y = (v[j] * r) * gv * (s1 + 1.0f) + s0;
            if constexpr (ROUTE) {
#pragma unroll
                for (int e = 0; e < NEXP; ++e) { const f32x4 w = *(const LAS f32x4*)(rt + e * DM + c); lg[e] += (y[0] * w[0] + y[1] * w[1]) + (y[2] * w[2] + y[3] * w[3]); } }
            if constexpr (OUT8) { *(unsigned*)((unsigned char*)H + (size_t)row * DM + c) = pk_fp8x4(y[0], y[1], y[2], y[3]); }
            else { v2u o; o.x = cvt_pk_bf16(y[0], y[1]); o.y = cvt_pk_bf16(y[2], y[3]); *(v2u*)(H + (size_t)row * DM + c) = o; } }
        if constexpr (ROUTE) {
#pragma unroll
            for (int e = 0; e < NEXP; ++e) lg[e] = wave_sum(lg[e]);
            int i0 = 0; float v0 = lg[0];
#pragma unroll
            for (int e = 1; e < NEXP; ++e) if (lg[e] > v0) { v0 = lg[e]; i0 = e; }
            int i1 = -1; float v1 = -3.0e38f;
#pragma unroll
            for (int e = 0; e < NEXP; ++e) if (e != i0 && lg[e] > v1) { v1 = lg[e]; i1 = e; }
            if (F.lane == 0) {
                const float ex = __expf(v1 - v0), g0 = 1.0f / (1.0f + ex), g1 = ex * g0;
                unsigned* list = (unsigned*)(A.ws + WS_LIST);
                const unsigned p0 = __hip_atomic_fetch_add((unsigned*)F.ctl + CW_CNT + 64 * i0, 1u, RLX_AGENT);
                const unsigned p1 = __hip_atomic_fetch_add((unsigned*)F.ctl + CW_CNT + 64 * i1, 1u, RLX_AGENT);
                list[i0 * LIST_CAP + p0] = (unsigned)row * 2u; list[i1 * LIST_CAP + p1] = (unsigned)row * 2u + 1u;
                *(f32x2*)(A.ws + WS_TOKG + (size_t)row * 8) = (f32x2){g0, g1};
            }
        }
    }
}

__device__ __forceinline__ void mixmid_conv(Frame& F, const Args& A, int ch, int hf, const bf16* AG, bf16* A2) {
    const int R0 = ch * CHUNK + hf * 64;
    int s_lo, s_hi; if (R0 < NLAT) { s_lo = R0 & ~(SEQ - 1); s_hi = s_lo + SEQ; } else { s_lo = NLAT + ((R0 - NLAT) & ~(CTXL - 1)); s_hi = s_lo + CTXL; }
    const int p = (F.wave & 3) * 64 + F.lane, gq = F.wave >> 2;
    LAS float* red = (LAS float*)(F.lds + RING_OFF);
    float w0[CONVK], w1[CONVK];
#pragma unroll
    for (int k = 0; k < CONVK; ++k) { const f32x2 w = *(const f32x2*)(A.in[I_CONVW] + k * ACH + 2 * p); w0[k] = w[0]; w1[k] = w[1]; }
    const f32x2 cb = *(const f32x2*)(A.in[I_CONVB] + 2 * p), lg = *(const f32x2*)(A.in[I_LNAG] + 2 * p), lb = *(const f32x2*)(A.in[I_LNAB] + 2 * p);
#pragma unroll 1
    for (int it = 0; it < 4; ++it) {
        const int t0 = R0 + 8 * (gq + 2 * it);
        float o0[8], o1[8];
#pragma unroll
        for (int t = 0; t < 8; ++t) { o0[t] = cb[0]; o1[t] = cb[1]; }
#pragma unroll
        for (int i = 0; i < 38; ++i) { const int rr = t0 - 15 + i; const unsigned wv = (rr >= s_lo && rr < s_hi) ? *(const unsigned*)((const char*)(AG + (size_t)rr * ACH) + 4 * p) : 0u;
            const float x0 = bf_lo(wv), x1 = bf_hi(wv);
#pragma unroll
            for (int t = 0; t < 8; ++t) { const int k = i - t; if (k >= 0 && k < CONVK) { o0[t] += w0[k] * x0; o1[t] += w1[k] * x1; } }
            if ((i & 7) == 7) asm volatile("" ::: "memory"); }
        LAS float* rd = red + ((it & 1) * 2 + gq) * (4 * 8 * 2);
#pragma unroll
        for (int t = 0; t < 8; ++t) { const float s = wave_sum(o0[t] + o1[t]), q = wave_sum(o0[t] * o0[t] + o1[t] * o1[t]);
            if (F.lane == 0) { rd[((F.wave & 3) * 8 + t) * 2] = s; rd[((F.wave & 3) * 8 + t) * 2 + 1] = q; } }
        __syncthreads();
#pragma unroll
        for (int t = 0; t < 8; ++t) { float s = 0.f, q = 0.f;
#pragma unroll
            for (int w = 0; w < 4; ++w) { s += rd[(w * 8 + t) * 2]; q += rd[(w * 8 + t) * 2 + 1]; }
            const float mu = s * (1.0f / ACH); float var = q * (1.0f / ACH) - mu * mu; var = var > 0.f ? var : 0.f; const float rs = 1.0f / sqrtf(var + EPS);
            const float y0 = (o0[t] - mu) * rs * lg[0] + lb[0], y1 = (o1[t] - mu) * rs * lg[1] + lb[1];
            *(unsigned*)((char*)(A2 + (size_t)(t0 + t) * DM) + 4 * p) = (DROPMASK & 16) ? 0u : cvt_pk_bf16(fsilu(y0), fsilu(y1)); }
    }
    __syncthreads();
}
__device__ __forceinline__ void mixmid_gmlp(Frame& F, const Args& A, int ch, int hg, const bf16* UG, const bf16* VG, const bf16* WSB, bf16* A2) {
    const int R0 = ch * CHUNK;
    LAS f32x2* st = (LAS f32x2*)(F.lds + RING_OFF);
    LAS bf16* vnT = (LAS bf16*)(F.lds + RING_OFF + 1024);
    constexpr int VP = 136;
    for (int i = 0; i < 16; ++i) { const int j = F.wave * 16 + i; const v4u x = *(const v4u*)(VG + (size_t)(R0 + j) * BCH + 8 * F.lane);
        float s = 0.f, q = 0.f;
#pragma unroll
        for (int e = 0; e < 4; ++e) { const float a = bf_lo(x[e]), b = bf_hi(x[e]); s += a + b; q += a * a + b * b; }
        s = wave_sum(s); q = wave_sum(q); const float mu = s * (1.0f / BCH); float var = q * (1.0f / BCH) - mu * mu; var = var > 0.f ? var : 0.f;
        if (F.lane == 0) st[j] = (f32x2){mu, 1.0f / sqrtf(var + EPS)}; }
    __syncthreads();
    { const int j = F.tid >> 2, cq = (F.tid & 3) * 16; const f32x2 ms = st[j];
#pragma unroll
      for (int hh = 0; hh < 4; ++hh) { const int c0 = (4 * hg + hh) * 64 + cq;
#pragma unroll
        for (int q = 0; q < 2; ++q) { const v4u x = *(const v4u*)(VG + (size_t)(R0 + j) * BCH + c0 + 8 * q);
#pragma unroll
            for (int e = 0; e < 4; ++e) { const int c = c0 + 8 * q + 2 * e; const f32x2 gg = *(const f32x2*)(A.in[I_LNVG] + c), bb = *(const f32x2*)(A.in[I_LNVB] + c);
                const float y0 = (bf_lo(x[e]) - ms[0]) * ms[1] * gg[0] + bb[0], y1 = (bf_hi(x[e]) - ms[0]) * ms[1] * gg[1] + bb[1];
                const unsigned pk = cvt_pk_bf16(y0, y1); const int d = cq + 8 * q + 2 * e;
                vnT[(hh * 64 + d) * VP + j] = (bf16)(pk & 0xffffu); vnT[(hh * 64 + d + 1) * VP + j] = (bf16)(pk >> 16); } } } }
    __syncthreads();
    { const int hh = F.wave >> 1, h = 4 * hg + hh, ib0 = (F.wave & 1) * 4, lr = F.lane & 15, lq = F.lane >> 4;
      f32x4 acc[4][4];
#pragma unroll
      for (int a = 0; a < 4; ++a)
#pragma unroll
          for (int b = 0; b < 4; ++b) acc[a][b] = (f32x4){0.f, 0.f, 0.f, 0.f};
#pragma unroll
      for (int kk = 0; kk < 4; ++kk) { bf16x8 wf[4], vf[4];
#pragma unroll
          for (int ib = 0; ib < 4; ++ib) wf[ib] = *(const bf16x8*)(WSB + ((size_t)h * CHUNK + (ib0 + ib) * 16 + lr) * CHUNK + kk * 32 + 8 * lq);
#pragma unroll
          for (int db = 0; db < 4; ++db) vf[db] = *(const LAS bf16x8*)(vnT + (hh * 64 + db * 16 + lr) * VP + kk * 32 + 8 * lq);
#pragma unroll
          for (int ib = 0; ib < 4; ++ib)
#pragma unroll
              for (int db = 0; db < 4; ++db) acc[ib][db] = __builtin_amdgcn_mfma_f32_16x16x32_bf16(vf[db], wf[ib], acc[ib][db], 0, 0, 0); }
#pragma unroll
      for (int ib = 0; ib < 4; ++ib) { const int i = (ib0 + ib) * 16 + lr; const float bsv = A.in[I_BS][h * CHUNK + i];
#pragma unroll
          for (int db = 0; db < 4; ++db) { const int c = h * 64 + db * 16 + 4 * lq; const v2u uu = *(const v2u*)(UG + (size_t)(R0 + i) * BCH + c);
              const f32x4 s = acc[ib][db] + bsv; v2u o; o.x = cvt_pk_bf16(bf_lo(uu.x) * s[0], bf_hi(uu.x) * s[1]); o.y = cvt_pk_bf16(bf_lo(uu.y) * s[2], bf_hi(uu.y) * s[3]);
              if (DROPMASK & 32) { o.x = 0u; o.y = 0u; }
              *(v2u*)(A2 + (size_t)(R0 + i) * DM + ACH + c) = o; } } }
    __syncthreads();
}
__device__ __forceinline__ void mixmid_phase(Frame& F, const Args& A, const bf16* AG, const bf16* UG, const bf16* VG, const bf16* WSB, bf16* A2) {
    constexpr int NU = (MALL / CHUNK) * 4;
    for (int u = F.vcu; u < NU; u += F.G) { const int part = u / (MALL / CHUNK), ch = u - part * (MALL / CHUNK);
#if !defined(MIX_ONLY) || MIX_ONLY == 1
        if (part < 2) mixmid_conv(F, A, ch, part, AG, A2);
#endif
#if !defined(MIX_ONLY) || MIX_ONLY == 2
        if (part >= 2) mixmid_gmlp(F, A, ch, part - 2, UG, VG, WSB, A2);
#endif
    }
}

__device__ __forceinline__ void zsplit_phase(Frame& F, const Args& A, const bf16* Z, bf16* QN, bf16* KVN, unsigned char* KPE, const float* rope) {
    const int gw = F.vcu * NWAVES + F.wave, NGW = F.G * NWAVES, l = F.lane;
    for (int row = gw; row < MALL; row += NGW) {
        const bf16* z = Z + (size_t)row * INO_PAD; float x[3][4];
#pragma unroll
        for (int j = 0; j < 3; ++j) { const v2u w = *(const v2u*)(z + 4 * l + 256 * j); x[j][0] = bf_lo(w.x); x[j][1] = bf_hi(w.x); x[j][2] = bf_lo(w.y); x[j][3] = bf_hi(w.y); }
        float q0 = 0.f, q1 = 0.f, q2 = 0.f;
#pragma unroll
        for (int e = 0; e < 4; ++e) { q0 += x[0][e] * x[0][e]; q1 += x[1][e] * x[1][e]; q2 += x[2][e] * x[2][e]; }
        const float sq = wave_sum(q0 + (l < 32 ? q1 : 0.f)), skv = wave_sum((l >= 32 ? q1 : 0.f) + (l < 32 ? q2 : 0.f));
        const float rq = 1.0f / sqrtf(sq * (1.0f / QRANK) + EPS), rkv = 1.0f / sqrtf(skv * (1.0f / KVRANK) + EPS);
        const bool lat = row < NLAT;
        if (lat) { const f32x4 g0 = *(const f32x4*)(A.in[I_GQ] + 4 * l); v2u o; o.x = cvt_pk_bf16(x[0][0] * rq * g0[0], x[0][1] * rq * g0[1]); o.y = cvt_pk_bf16(x[0][2] * rq * g0[2], x[0][3] * rq * g0[3]);
            *(v2u*)(QN + (size_t)row * QRANK + 4 * l) = o;
            if (l < 32) { const f32x4 g1 = *(const f32x4*)(A.in[I_GQ] + 256 + 4 * l); v2u o1; o1.x = cvt_pk_bf16(x[1][0] * rq * g1[0], x[1][1] * rq * g1[1]); o1.y = cvt_pk_bf16(x[1][2] * rq * g1[2], x[1][3] * rq * g1[3]);
                *(v2u*)(QN + (size_t)row * QRANK + 256 + 4 * l) = o1; } }
        { const int jj = (l >= 32) ? 1 : 2, kc = (l >= 32) ? 4 * (l - 32) : 128 + 4 * l; const f32x4 gk = *(const f32x4*)(A.in[I_GKV] + kc);
          const float a0 = (jj == 1) ? x[1][0] : x[2][0], a1 = (jj == 1) ? x[1][1] : x[2][1], a2 = (jj == 1) ? x[1][2] : x[2][2], a3 = (jj == 1) ? x[1][3] : x[2][3];
          v2u o; o.x = cvt_pk_bf16(a0 * rkv * gk[0], a1 * rkv * gk[1]); o.y = cvt_pk_bf16(a2 * rkv * gk[2], a3 * rkv * gk[3]);
          *(v2u*)(KVN + (size_t)row * KVRANK + kc) = o; }
        float y[4];
#pragma unroll
        for (int e = 0; e < 4; ++e) y[e] = lane_xor<4>(x[2][e]);
        if (l >= 32 && l < 48) { const int m = l - 32; int b, key, t = 0;
            if (lat) { b = row >> 12; t = row & (SEQ - 1); key = CTXL + t; } else { const int rc = row - NLAT; b = rc >> 8; key = rc & (CTXL - 1); }
            float o[4];
            if (lat) { const int a = m >> 3, pp = (m >> 2) & 1, f0 = 4 * (m & 3), pos = a ? (t & 63) : (t >> 6);
#pragma unroll
                for (int e = 0; e < 4; ++e) { const f32x2 cs = *(const f32x2*)(rope + (pos * 16 + f0 + e) * 2); const float x1 = pp ? y[e] : x[2][e], x2 = pp ? x[2][e] : y[e];
                    o[e] = pp ? (x1 * cs[1] + x2 * cs[0]) : (x1 * cs[0] - x2 * cs[1]); } }
            else {
#pragma unroll
                for (int e = 0; e < 4; ++e) o[e] = x[2][e]; }
            *(unsigned*)(KPE + ((size_t)b * SKV + key) * ROPE + 4 * m) = pk_fp8x4(o[0], o[1], o[2], o[3]); }
    }
}

__device__ __forceinline__ void combine_phase(Frame& F, const Args& A, const bf16* Y, const float* mod1, float mul) {
    const int gw = F.vcu * NWAVES + F.wave, NGW = F.G * NWAVES;
    for (int tl = gw; tl < NLAT; tl += NGW) { const int row = tl, bi = row >> 12;
        float* xr = A.out + (size_t)row * DM; const float* gate = mod1 + bi * MODW + 5 * DM; const f32x2 gg = *(const f32x2*)(A.ws + WS_TOKG + (size_t)row * 8);
        const bf16* y0 = Y + (size_t)(2 * tl) * DM; const bf16* y1 = y0 + DM;
        f32x4 v[4]; float ss = 0.f;
#pragma unroll
        for (int j = 0; j < 4; ++j) { const int c = 4 * F.lane + 256 * j; const f32x4 x = *(const f32x4*)(xr + c), gt = *(const f32x4*)(gate + c); const v2u a = *(const v2u*)(y0 + c), b = *(const v2u*)(y1 + c);
            f32x4 m; m[0] = gg[0] * bf_lo(a.x) + gg[1] * bf_lo(b.x); m[1] = gg[0] * bf_hi(a.x) + gg[1] * bf_hi(b.x); m[2] = gg[0] * bf_lo(a.y) + gg[1] * bf_lo(b.y); m[3] = gg[0] * bf_hi(a.y) + gg[1] * bf_hi(b.y);
            v[j] = x + gt * m * mul; ss += (v[j][0] * v[j][0] + v[j][1] * v[j][1]) + (v[j][2] * v[j][2] + v[j][3] * v[j][3]); }
        const float r = 1.0f / sqrtf(wave_sum(ss) * (1.0f / DM) + EPS);
#pragma unroll
        for (int j = 0; j < 4; ++j) { const int c = 4 * F.lane + 256 * j; const f32x4 fg = *(const f32x4*)(A.in[I_FINALG] + c); *(f32x4*)(xr + c) = v[j] * r * fg; }
    }
}
#if SELFCHECK
namespace chk {
__device__ __forceinline__ float bff(bf16 v) { return __builtin_bit_cast(float, (unsigned)v << 16); }
__device__ __forceinline__ float bfr(float f) { unsigned u = __builtin_bit_cast(unsigned, f); u = (u + 0x7fffu + ((u >> 16) & 1u)) & 0xffff0000u; return __builtin_bit_cast(float, u); }
__device__ __forceinline__ unsigned hsh(unsigned x) { x ^= x >> 16; x *= 0x7feb352du; x ^= x >> 15; x *= 0x846ca68bu; x ^= x >> 16; return x; }
__device__ __forceinline__ float dot_w(const bf16* a, const float* W, int K, int N, int n) { float s = 0.f; for (int k = 0; k < K; ++k) s += bff(a[k]) * bfr(W[(size_t)k * N + n]); return s; }
__device__ __forceinline__ float f8f(unsigned char v) { return __builtin_amdgcn_cvt_f32_fp8((int)v, 0); }
__device__ __forceinline__ float f8r(float x) { const int w = __builtin_amdgcn_cvt_pk_fp8_f32(x, 0.f, 0, false); return __builtin_amdgcn_cvt_f32_fp8(w, 0); }
__device__ __forceinline__ float dot_w8(const unsigned char* a, const float* W, int K, int N, int n, float mul) { float s = 0.f; for (int k = 0; k < K; ++k) s += f8f(a[k]) * f8r(W[(size_t)k * N + n] * mul); return s / mul; }
__device__ __forceinline__ float sigm(float x) { return 1.0f / (1.0f + __expf(-x)); }
__device__ __forceinline__ float gelu_t(float x) { return 0.5f * x * (1.0f + tanhf(0.7978845608028654f * (x + 0.044715f * x * x * x))); }
__device__ __forceinline__ void report(unsigned* dbg, int k, float got, float ref, float rel, float abs_) {
    const float err = fabsf(got - ref); const bool bad = !(err <= rel * fabsf(ref) + abs_);
    atomicAdd(dbg + 64 * k + 1, 1u); if (bad) atomicAdd(dbg + 64 * k, 1u);
}
}
#define CHK_LOOP(NS) for (int s_ = (int)(blockIdx.x * 512 + F.tid); s_ < (NS); s_ += (int)(gridDim.x * 512))
#endif
#if SELFCHECK
constexpr int CW_DBG = 32768;
constexpr size_t WS_CAP = 3 * MiB + 512 * 1024;
namespace chk {
struct Ctx { const Args* A; unsigned char* ws; unsigned char* ar; unsigned* dbg; const float* mod; float* XC; };
#define CK_IN(i) (C.A->in[i])
__device__ __forceinline__ const float* xrow(const Ctx& C, const float* L, const float* Cx, int row) { return row < NLAT ? L + (size_t)row * DM : Cx + (size_t)(row - NLAT) * DM; }
__device__ __forceinline__ void c_mod(Frame& F, const Ctx& C) {
    CHK_LOOP(2048) { const unsigned h = hsh(s_); const int l = h & 1, bi = (h >> 1) % 9, j = (h >> 8) % MODW;
        const float* cv = bi < 8 ? CK_IN(I_C) + bi * DM : CK_IN(I_CCTX); float s = CK_IN(I_BADA)[l * MODW + j];
        for (int k = 0; k < DM; ++k) { const float c = cv[k]; s += (c * sigm(c)) * CK_IN(I_WADA)[((size_t)l * DM + k) * MODW + j]; }
        report(C.dbg, 0, C.mod[(size_t)(l * 9 + bi) * MODW + j], s, 2e-3f, 2e-3f); }
}
__device__ __forceinline__ void c_norm(Frame& F, const Ctx& C, int k, const float* L, const float* Cx, int nrows, const float* g, const float* modl, int slot, const bf16* H) {
    CHK_LOOP(2048) { const unsigned h = hsh(s_ + 7919u * k); const int row = h % nrows, col = (h >> 16) % DM; const float* x = xrow(C, L, Cx, row); const int bi = row < NLAT ? row >> 12 : 8;
        float ss = 0.f; for (int i = 0; i < DM; ++i) ss += x[i] * x[i];
        const float r = 1.0f / sqrtf(ss / DM + EPS), y = x[col] * r * g[col] * (1.0f + modl[bi * MODW + (slot + 1) * DM + col]) + modl[bi * MODW + slot * DM + col];
        report(C.dbg, row < NLAT ? k : k + 20, bff(H[(size_t)row * DM + col]), y, 0.01f, 0.01f); }
}
__device__ __forceinline__ void c_mixin(Frame& F, const Ctx& C, const bf16* H, const bf16* AG, const bf16* UG, const bf16* VG) {
    CHK_LOOP(2048) { const unsigned h = hsh(s_ + 111u); const int row = h % MALL, c = (h >> 16) % 1536; const bf16* a = H + (size_t)row * DM; const float* W = CK_IN(I_EWIN); float ref, got;
        if (c < 512) { ref = dot_w(a, W, DM, 2048, c) * sigm(dot_w(a, W, DM, 2048, 512 + c)); got = bff(AG[(size_t)row * ACH + c]); }
        else if (c < 1024) { ref = gelu_t(dot_w(a, W, DM, 2048, 512 + c)); got = bff(UG[(size_t)row * BCH + c - 512]); }
        else { ref = gelu_t(dot_w(a, W, DM, 2048, 512 + c)); got = bff(VG[(size_t)row * BCH + c - 1024]); }
        report(C.dbg, 2, got, ref, 0.02f, 0.02f); }
}
__device__ __forceinline__ void c_mixmid(Frame& F, const Ctx& C, const bf16* AG, const bf16* UG, const bf16* VG, const bf16* A2) {
    CHK_LOOP(512) { const unsigned h = hsh(s_ + 222u); const int row = h % MALL, c = (h >> 16) % DM; float ref;
        if (c < ACH) { int s_lo, s_hi; if (row < NLAT) { s_lo = row & ~(SEQ - 1); s_hi = s_lo + SEQ; } else { s_lo = NLAT + ((row - NLAT) & ~(CTXL - 1)); s_hi = s_lo + CTXL; }
            float s = 0.f, q = 0.f, vc = 0.f;
            for (int ch = 0; ch < ACH; ++ch) { float v = CK_IN(I_CONVB)[ch];
                for (int k = 0; k < CONVK; ++k) { const int rr = row + k - 15; if (rr >= s_lo && rr < s_hi) v += CK_IN(I_CONVW)[k * ACH + ch] * bff(AG[(size_t)rr * ACH + ch]); }
                s += v; q += v * v; if (ch == c) vc = v; }
            const float mu = s / ACH, var = q / ACH - mu * mu, y = (vc - mu) / sqrtf(var + EPS) * CK_IN(I_LNAG)[c] + CK_IN(I_LNAB)[c]; ref = y * sigm(y);
        } else { const int cc = c - ACH, hh = cc >> 6, R0 = row & ~(CHUNK - 1), i = row - R0; float sv = CK_IN(I_BS)[hh * CHUNK + i];
            for (int j = 0; j < CHUNK; ++j) { const bf16* vr = VG + (size_t)(R0 + j) * BCH; float s = 0.f, q = 0.f;
                for (int ch = 0; ch < BCH; ++ch) { const float v = bff(vr[ch]); s += v; q += v * v; }
                const float mu = s / BCH, var = q / BCH - mu * mu, vn = (bff(vr[cc]) - mu) / sqrtf(var + EPS) * CK_IN(I_LNVG)[cc] + CK_IN(I_LNVB)[cc];
                sv += bfr(CK_IN(I_WS)[((size_t)hh * CHUNK + i) * CHUNK + j]) * bfr(vn); }
            ref = bff(UG[(size_t)row * BCH + cc]) * sv; }
        report(C.dbg, 3, bff(A2[(size_t)row * DM + c]), ref, 0.02f, 0.02f); }
}
__device__ __forceinline__ void c_resid(Frame& F, const Ctx& C, int k, int nrows, const bf16* Ain, int K, const float* W, const float* gate, const float* baseL, const float* baseC, bool captured) {
    CHK_LOOP(2048) { const unsigned h = hsh(s_ + 333u * k); const int row = h % nrows, col = (h >> 16) % DM, bi = row < NLAT ? row >> 12 : 8;
        const float base = captured ? ((const float*)(C.ws + WS_CAP))[s_] : xrow(C, baseL, baseC, row)[col];
        const float ref = base + gate[bi * MODW + col] * dot_w(Ain + (size_t)row * K, W, K, DM, col), got = xrow(C, C.A->out, C.XC, row)[col];
        report(C.dbg, k, got, ref, 0.01f, 0.01f); }
}
__device__ __forceinline__ void c_capture(Frame& F, const Ctx& C, int k, int nrows) {
    CHK_LOOP(2048) { const unsigned h = hsh(s_ + 333u * k); const int row = h % nrows, col = (h >> 16) % DM; ((float*)(C.ws + WS_CAP))[s_] = xrow(C, C.A->out, C.XC, row)[col]; }
}
__device__ __forceinline__ void c_swiglu(Frame& F, const Ctx& C, const bf16* H, const bf16* ACT) {
    CHK_LOOP(2048) { const unsigned h = hsh(s_ + 444u); const int row = h % MALL, j = (h >> 16) % DFF; const bf16* a = H + (size_t)row * DM;
        const float p = dot_w(a, CK_IN(I_FW1), DM, DFF, j), q = dot_w(a, CK_IN(I_FW3), DM, DFF, j);
        report(C.dbg, 6, bff(ACT[(size_t)row * DFF + j]), p * sigm(p) * q, 0.02f, 0.02f); }
}
__device__ __forceinline__ void c_z(Frame& F, const Ctx& C, const bf16* H, const bf16* Z) {
    CHK_LOOP(2048) { const unsigned h = hsh(s_ + 555u); const int row = h % MALL, j = (h >> 16) % INO;
        report(C.dbg, 9, bff(Z[(size_t)row * INO_PAD + j]), dot_w(H + (size_t)row * DM, CK_IN(I_OWIN), DM, INO, j), 0.02f, 0.02f); }
}
__device__ __forceinline__ float rope_ref(float x1, float x2, int p, int a, int f, int t) {
    const int pos = a ? (t & 63) : (t >> 6); const float ang = (float)pos * powf(10000.0f, -(float)f / 16.0f), c = cosf(ang), s = sinf(ang);
    return p ? (x1 * s + x2 * c) : (x1 * c - x2 * s);
}
__device__ __forceinline__ void c_zsplit(Frame& F, const Ctx& C, const bf16* Z, const bf16* QN, const bf16* KVN, const unsigned char* KPE) {
    CHK_LOOP(3072) { const unsigned h = hsh(s_ + 666u); const int kind = s_ % 3; const bf16* z;
        if (kind == 0) { const int row = h % NLAT, c = (h >> 16) % QRANK; z = Z + (size_t)row * INO_PAD; float ss = 0.f; for (int i = 0; i < QRANK; ++i) ss += bff(z[i]) * bff(z[i]);
            report(C.dbg, 10, bff(QN[(size_t)row * QRANK + c]), bff(z[c]) / sqrtf(ss / QRANK + EPS) * CK_IN(I_GQ)[c], 0.01f, 0.01f); }
        else if (kind == 1) { const int row = h % MALL, c = (h >> 16) % KVRANK; z = Z + (size_t)row * INO_PAD; float ss = 0.f; for (int i = 0; i < KVRANK; ++i) ss += bff(z[QRANK + i]) * bff(z[QRANK + i]);
            report(C.dbg, 10, bff(KVN[(size_t)row * KVRANK + c]), bff(z[QRANK + c]) / sqrtf(ss / KVRANK + EPS) * CK_IN(I_GKV)[c], 0.01f, 0.01f); }
        else { const int row = h % MALL, dd = (h >> 16) % ROPE; z = Z + (size_t)row * INO_PAD + QRANK + KVRANK; int b, key; float ref;
            if (row < NLAT) { b = row >> 12; const int t = row & (SEQ - 1); key = CTXL + t; const int a = dd >> 5, p = (dd >> 4) & 1, f = dd & 15; ref = rope_ref(bff(z[a * 32 + f]), bff(z[a * 32 + 16 + f]), p, a, f, t); }
            else { const int rc = row - NLAT; b = rc >> 8; key = rc & (CTXL - 1); ref = bff(z[dd]); }
            report(C.dbg, 10, f8f(KPE[((size_t)b * SKV + key) * ROPE + dd]), ref, 0.07f, 0.01f); } }
}
__device__ __forceinline__ void c_qkv(Frame& F, const Ctx& C, const bf16* QN, const bf16* KVN, const unsigned char* Q, const unsigned char* KN, const bf16* V) {
    CHK_LOOP(3072) { const unsigned h = hsh(s_ + 777u), h2 = hsh(s_ + 778u); const int kind = s_ % 3, b = h % NB, hd = (h >> 8) % NHEAD;
        if (kind == 0) { const int t = (h >> 16) % SEQ, d = h2 % QKD, row = b * SEQ + t; const bf16* a = QN + (size_t)row * QRANK; float ref;
            if (d < 128) ref = dot_w(a, CK_IN(I_WUQ), QRANK, 1536, hd * QKD + d);
            else { const int dd = d - 128, aa = dd >> 5, p = (dd >> 4) & 1, f = dd & 15;
                ref = rope_ref(dot_w(a, CK_IN(I_WUQ), QRANK, 1536, hd * QKD + 128 + aa * 32 + f), dot_w(a, CK_IN(I_WUQ), QRANK, 1536, hd * QKD + 128 + aa * 32 + 16 + f), p, aa, f, t); }
            report(C.dbg, 11, f8f(Q[((size_t)(b * NHEAD + hd) * SEQ + t) * QKD + d]), ref, 0.07f, 0.02f); }
        else { const int key = (h >> 16) % SKV, d = h2 % VHD, row = key < CTXL ? NLAT + b * CTXL + key : b * SEQ + key - CTXL; const bf16* a = KVN + (size_t)row * KVRANK;
            const float ref = dot_w(a, CK_IN(I_WUKV), KVRANK, 2048, hd * 256 + (kind == 1 ? 0 : 128) + d); const size_t oi = ((size_t)(b * NHEAD + hd) * SKV + key) * VHD + d;
            report(C.dbg, 11, kind == 1 ? f8f(KN[oi]) : bff(V[oi]), ref, kind == 1 ? 0.07f : 0.02f, 0.02f); } }
}
__device__ __forceinline__ void c_attn(Frame& F, const Ctx& C, const unsigned char* Q, const unsigned char* KN, const unsigned char* KPE, const bf16* V, const bf16* ATT) {
    CHK_LOOP(256) { const unsigned h = hsh(s_ + 888u), h2 = hsh(s_ + 889u); const int b = h % NB, hd = (h >> 8) % NHEAD, t = (h >> 16) % SEQ, d = h2 % VHD;
        const unsigned char* q = Q + ((size_t)(b * NHEAD + hd) * SEQ + t) * QKD; float m = -1e30f, l = 0.f, o = 0.f;
        for (int k = 0; k < SKV; ++k) { const unsigned char* kn = KN + ((size_t)(b * NHEAD + hd) * SKV + k) * VHD; const unsigned char* kp = KPE + ((size_t)b * SKV + k) * ROPE; float sc = 0.f;
            for (int i = 0; i < 128; ++i) sc += f8f(q[i]) * f8f(kn[i]);
            for (int i = 0; i < 64; ++i) sc += f8f(q[128 + i]) * f8f(kp[i]);
            sc *= ATTN_SCALE; const float mn = fmaxf(m, sc), al = __expf(m - mn), p = __expf(sc - mn); l = l * al + p; o = o * al + p * bff(V[((size_t)(b * NHEAD + hd) * SKV + k) * VHD + d]); m = mn; }
        report(C.dbg, 12, bff(ATT[((size_t)b * SEQ + t) * DM + hd * VHD + d]), o / l, 0.03f, 0.01f); }
}
__device__ __forceinline__ void c_route(Frame& F, const Ctx& C, const float* modl, const unsigned char* H4) {
    CHK_LOOP(128) { const unsigned h = hsh(s_ + 999u); const int row = h % NLAT, col = (h >> 16) % DM, bi = row >> 12; const float* x = C.A->out + (size_t)row * DM; const float* g = CK_IN(I_NORMG) + 3 * DM;
        float ss = 0.f; for (int i = 0; i < DM; ++i) ss += x[i] * x[i]; const float r = 1.0f / sqrtf(ss / DM + EPS); float lg[NEXP]; float ycol = 0.f;
#pragma unroll
        for (int e = 0; e < NEXP; ++e) lg[e] = 0.f;
        for (int i = 0; i < DM; ++i) { const float y = x[i] * r * g[i] * (1.0f + modl[bi * MODW + 4 * DM + i]) + modl[bi * MODW + 3 * DM + i]; if (i == col) ycol = y;
#pragma unroll
            for (int e = 0; e < NEXP; ++e) lg[e] += y * CK_IN(I_ROUTER)[i * NEXP + e]; }
        report(C.dbg, 14, f8f(H4[(size_t)row * DM + col]), ycol, 0.07f, 0.01f);
        int i0 = 0; float v0 = lg[0];
#pragma unroll
        for (int e = 1; e < NEXP; ++e) if (lg[e] > v0) { v0 = lg[e]; i0 = e; }
        int i1 = 0; float v1 = -3.0e38f;
#pragma unroll
        for (int e = 0; e < NEXP; ++e) if (e != i0 && lg[e] > v1) { v1 = lg[e]; i1 = e; }
        float v2 = -3.0e38f;
#pragma unroll
        for (int e = 0; e < NEXP; ++e) if (e != i0 && e != i1 && lg[e] > v2) v2 = lg[e];
        if (v1 - v2 > 1e-3f && v0 - v1 > 1e-3f) {
            const float ex = __expf(v1 - v0), g0 = 1.0f / (1.0f + ex); const f32x2 tg = *(const f32x2*)(C.ws + WS_TOKG + (size_t)row * 8);
            report(C.dbg, 14, tg[0], g0, 0.01f, 0.002f); report(C.dbg, 14, tg[1], 1.0f - g0, 0.01f, 0.002f);
            const int tl = row; const unsigned* list = (const unsigned*)(C.ws + WS_LIST);
            const int c0 = (int)((const unsigned*)(C.ws + WS_CTL))[CW_CNT + 64 * i0], c1 = (int)((const unsigned*)(C.ws + WS_CTL))[CW_CNT + 64 * i1];
            float f0 = 0.f, f1 = 0.f; for (int i = 0; i < c0; ++i) if (list[i0 * LIST_CAP + i] == (unsigned)tl * 2u) f0 += 1.f; for (int i = 0; i < c1; ++i) if (list[i1 * LIST_CAP + i] == (unsigned)tl * 2u + 1u) f1 += 1.f;
            report(C.dbg, 14, f0, 1.0f, 0.f, 0.01f); report(C.dbg, 14, f1, 1.0f, 0.f, 0.01f); } }
}
__device__ __forceinline__ void c_moe_up(Frame& F, const Ctx& C, const LAS int* tab, const unsigned char* H4, const unsigned char* ACTE) {
    const unsigned* list = (const unsigned*)(C.ws + WS_LIST);
    CHK_LOOP(2048) { const unsigned h = hsh(s_ + 1111u), h2 = hsh(s_ + 1112u); const int e = h % NEXP, cnt = tab[16 + e]; if (cnt == 0) continue; const int slot = (h >> 8) % cnt, j = h2 % DEXP;
        const int tok = (int)(list[e * LIST_CAP + slot] >> 1); const unsigned char* a = H4 + (size_t)tok * DM;
        const float p = dot_w8(a, CK_IN(I_XW1) + (size_t)e * DM * DEXP, DM, DEXP, j, 32.f), q = dot_w8(a, CK_IN(I_XW3) + (size_t)e * DM * DEXP, DM, DEXP, j, 32.f);
        report(C.dbg, 15, f8f(ACTE[((size_t)tab[e] * 256 + slot) * DEXP + j]), p * sigm(p) * q, 0.08f, 0.02f); }
}
__device__ __forceinline__ void c_moe_down(Frame& F, const Ctx& C, const LAS int* tab, const unsigned char* ACTE, const bf16* Y) {
    const unsigned* list = (const unsigned*)(C.ws + WS_LIST);
    CHK_LOOP(2048) { const unsigned h = hsh(s_ + 2222u), h2 = hsh(s_ + 2223u); const int e = h % NEXP, cnt = tab[16 + e]; if (cnt == 0) continue; const int slot = (h >> 8) % cnt, col = h2 % DM;
        const unsigned ent = list[e * LIST_CAP + slot];
        report(C.dbg, 16, bff(Y[(size_t)ent * DM + col]), dot_w8(ACTE + ((size_t)tab[e] * 256 + slot) * DEXP, CK_IN(I_XW2) + (size_t)e * DEXP * DM, DEXP, DM, col, 64.f), 0.02f, 0.02f); }
}
__device__ __forceinline__ void c_cap_rows(Frame& F, const Ctx& C) {
    float* cap = (float*)(C.ws + WS_CAP + 65536);
    for (int i = (int)(blockIdx.x * 512 + F.tid); i < 64 * DM; i += (int)(gridDim.x * 512)) { const int r = i >> 10, c = i & (DM - 1), tl = hsh(r + 3333u) % NLAT; cap[i] = C.A->out[(size_t)tl * DM + c]; }
}
__device__ __forceinline__ void c_combine(Frame& F, const Ctx& C, const float* mod1, const bf16* Y) {
    const float* cap = (const float*)(C.ws + WS_CAP + 65536);
    CHK_LOOP(64 * 16) { const int r = s_ >> 4, tl = hsh(r + 3333u) % NLAT, row = tl, bi = row >> 12, col = hsh(s_ + 4444u) % DM; const f32x2 tg = *(const f32x2*)(C.ws + WS_TOKG + (size_t)row * 8);
        float ss = 0.f, vc = 0.f; for (int i = 0; i < DM; ++i) { const float v = cap[r * DM + i] + mod1[bi * MODW + 5 * DM + i] * (tg[0] * bff(Y[(size_t)(2 * tl) * DM + i]) + tg[1] * bff(Y[(size_t)(2 * tl + 1) * DM + i])); ss += v * v; if (i == col) vc = v; }
        report(C.dbg, 17, C.A->out[(size_t)row * DM + col], vc / sqrtf(ss / DM + EPS) * CK_IN(I_FINALG)[col], 0.005f, 0.005f); }
}
}
#endif
namespace att {
using bf16x8 = __attribute__((ext_vector_type(8))) short;
using s16x4  = __attribute__((ext_vector_type(4))) short;
using f32x16 = __attribute__((ext_vector_type(16))) float;
using u32x4  = __attribute__((ext_vector_type(4))) unsigned;
using i32x4  = __attribute__((ext_vector_type(4))) int;
using i32x8  = __attribute__((ext_vector_type(8))) int;
constexpr int D = 128, NW = 8, QBLK = 32, KVBLK = 64;
constexpr float THR = 8.f, SCALE = ATTN_SCALE;
constexpr int SHM_V = KVBLK * D * 2, SHM_K = KVBLK * 128, SHM_P = KVBLK * ROPE, SHM_ATTN = 2 * SHM_V + 2 * SHM_K + 2 * SHM_P + NW * 64 * 4;
static_assert(SHM_ATTN <= RING_BYTES, "attention LDS");
#define K8SWZ(row, colB) ((row) * 128 + ((colB) ^ ((((row) >> 1) & 7) << 4)))
#define P8SWZ(row, colB) ((row) * 64 + ((colB) ^ ((((row) >> 2) & 3) << 4)))
#define SBAR() __builtin_amdgcn_sched_barrier(0)
__device__ __forceinline__ int crow(int r, int hi) { return (r & 3) + 8 * (r >> 2) + 4 * hi; }
__device__ __forceinline__ unsigned cvtpk(float lo, float hi) { unsigned r; asm volatile("v_cvt_pk_bf16_f32 %0, %1, %2" : "=v"(r) : "v"(lo), "v"(hi)); return r; }
__device__ __forceinline__ void swap32(unsigned& a, unsigned& b) { asm volatile("s_nop 1\n\tv_permlane32_swap_b32 %0, %1\n\ts_nop 0" : "+v"(a), "+v"(b)); }
__device__ __forceinline__ void partialSM(f32x16& p0, f32x16& p1, float& m_reg, float& mn, float& alpha) {
  constexpr float C = SCALE * 1.4426950408889634f;
  float pmax = p0[0]; for (int r = 1; r < 16; ++r) pmax = fmaxf(pmax, p0[r]); for (int r = 0; r < 16; ++r) pmax = fmaxf(pmax, p1[r]);
  { unsigned a_ = __float_as_uint(pmax), b_ = a_; swap32(a_, b_); pmax = fmaxf(__uint_as_float(a_), __uint_as_float(b_)); }
  if (__builtin_expect(__all(pmax - m_reg <= THR / SCALE), 1)) { mn = m_reg; alpha = 1.f; }
  else { mn = fmaxf(m_reg, pmax); alpha = __builtin_amdgcn_exp2f((m_reg - mn) * C); m_reg = mn; }
  float mnC = -mn * C;
  for (int r = 0; r < 16; ++r) p0[r] = fmaf(p0[r], C, mnC); for (int r = 0; r < 16; ++r) p1[r] = fmaf(p1[r], C, mnC);
  for (int r = 0; r < 16; ++r) p0[r] = __builtin_amdgcn_exp2f(p0[r]);
}
__device__ __forceinline__ void finishSM(f32x16& p0, f32x16& p1, float alpha, float& l_reg, bf16x8& pa0, bf16x8& pa1, bf16x8& pa2, bf16x8& pa3) {
  for (int r = 0; r < 16; ++r) p1[r] = __builtin_amdgcn_exp2f(p1[r]);
  float ps = 0; for (int r = 0; r < 16; ++r) ps += p0[r]; for (int r = 0; r < 16; ++r) ps += p1[r];
  { unsigned a_ = __float_as_uint(ps), b_ = a_; swap32(a_, b_); ps = __uint_as_float(a_) + __uint_as_float(b_); }
  l_reg = l_reg * alpha + ps;
#define PK4(P, BASE, OUT) do { unsigned a0 = cvtpk(P[BASE + 0], P[BASE + 1]), a1 = cvtpk(P[BASE + 2], P[BASE + 3]);   \
    unsigned b0 = cvtpk(P[BASE + 4], P[BASE + 5]), b1 = cvtpk(P[BASE + 6], P[BASE + 7]);                              \
    auto r0 = __builtin_amdgcn_permlane32_swap(a0, b0, false, false); auto r1 = __builtin_amdgcn_permlane32_swap(a1, b1, false, false); \
    u32x4 w = {r0[0], r1[0], r0[1], r1[1]}; OUT = *reinterpret_cast<bf16x8*>(&w); } while (0)
  PK4(p0, 0, pa0); PK4(p0, 8, pa1); PK4(p1, 0, pa2); PK4(p1, 8, pa3);
#undef PK4
}
#define CAT8(x0, x1) __builtin_shufflevector(x0, x1, 0, 1, 2, 3, 4, 5, 6, 7)
#define MFMA8(a, b, c) __builtin_amdgcn_mfma_scale_f32_32x32x64_f8f6f4(a, b, c, 0, 0, 0, 0x7f7f7f7f, 0, 0x7f7f7f7f)
__device__ __forceinline__ void qkt(f32x16& p0, f32x16& p1, const char* Ks, const char* Ps, const i32x8* q8, int r32, int hi) {
  p0 = f32x16{}; p1 = f32x16{};
#pragma unroll
  for (int s = 0; s < 2; ++s) { const int cb = 64 * s + 32 * hi;
    const i32x8 b0 = CAT8(*reinterpret_cast<const i32x4*>(Ks + K8SWZ(r32, cb)), *reinterpret_cast<const i32x4*>(Ks + K8SWZ(r32, cb + 16)));
    const i32x8 b1 = CAT8(*reinterpret_cast<const i32x4*>(Ks + K8SWZ(32 + r32, cb)), *reinterpret_cast<const i32x4*>(Ks + K8SWZ(32 + r32, cb + 16)));
    p0 = MFMA8(b0, q8[s], p0); p1 = MFMA8(b1, q8[s], p1); }
  { const int cb = 32 * hi;
    const i32x8 b0 = CAT8(*reinterpret_cast<const i32x4*>(Ps + P8SWZ(r32, cb)), *reinterpret_cast<const i32x4*>(Ps + P8SWZ(r32, cb + 16)));
    const i32x8 b1 = CAT8(*reinterpret_cast<const i32x4*>(Ps + P8SWZ(32 + r32, cb)), *reinterpret_cast<const i32x4*>(Ps + P8SWZ(32 + r32, cb + 16)));
    p0 = MFMA8(b0, q8[2], p0); p1 = MFMA8(b1, q8[2], p1); }
}
__device__ __forceinline__ int v_st(int k, int c) { const int kk = (k & ~0xC) | ((k & 4) << 1) | ((k & 8) >> 1); return ((kk >> 3) * 4 + (c >> 5)) * 512 + ((kk & 7) * 32 + (c & 31)) * 2; }
__device__ __forceinline__ int v_rd_base(int lane) { return ((lane & 3) << 3) | (((lane >> 2) & 3) << 6) | (((lane >> 4) & 1) << 5) | (((lane >> 5) & 1) << 8); }
constexpr int v_rd_off(int d0, int ks, int half) { return d0 * 512 + ks * 4096 + half * 2048; }
template <int OFF> __device__ __forceinline__ s16x4 tr_read(int vb) {
  s16x4 r; asm volatile("ds_read_b64_tr_b16 %0, %1 offset:%2" : "=&v"(r) : "v"(vb), "i"(OFF) : "memory"); return r;
}
template <int D0> __device__ __forceinline__ void pv_one(f32x16& od, int vb, bf16x8 pa0, bf16x8 pa1, bf16x8 pa2, bf16x8 pa3) {
  const s16x4 l0 = tr_read<v_rd_off(D0, 0, 0)>(vb), h0 = tr_read<v_rd_off(D0, 0, 1)>(vb), l1 = tr_read<v_rd_off(D0, 1, 0)>(vb), h1 = tr_read<v_rd_off(D0, 1, 1)>(vb);
  const s16x4 l2 = tr_read<v_rd_off(D0, 2, 0)>(vb), h2 = tr_read<v_rd_off(D0, 2, 1)>(vb), l3 = tr_read<v_rd_off(D0, 3, 0)>(vb), h3 = tr_read<v_rd_off(D0, 3, 1)>(vb);
  asm volatile("s_waitcnt lgkmcnt(0)" ::: "memory"); SBAR();
#define PK(L, H) (bf16x8){L[0], L[1], L[2], L[3], H[0], H[1], H[2], H[3]}
  od = __builtin_amdgcn_mfma_f32_32x32x16_bf16(pa0, PK(l0, h0), od, 0, 0, 0);
  od = __builtin_amdgcn_mfma_f32_32x32x16_bf16(pa1, PK(l1, h1), od, 0, 0, 0);
  od = __builtin_amdgcn_mfma_f32_32x32x16_bf16(pa2, PK(l2, h2), od, 0, 0, 0);
  od = __builtin_amdgcn_mfma_f32_32x32x16_bf16(pa3, PK(l3, h3), od, 0, 0, 0);
#undef PK
}
__device__ __forceinline__ void pv_d0(f32x16* o, int vb, bf16x8 pa0, bf16x8 pa1, bf16x8 pa2, bf16x8 pa3) {
  pv_one<0>(o[0], vb, pa0, pa1, pa2, pa3); pv_one<1>(o[1], vb, pa0, pa1, pa2, pa3); pv_one<2>(o[2], vb, pa0, pa1, pa2, pa3); pv_one<3>(o[3], vb, pa0, pa1, pa2, pa3);
}
__device__ __forceinline__ void attn_unit(const unsigned char* __restrict__ Qb, const unsigned char* __restrict__ Kh, const unsigned char* __restrict__ Ph, const bf16* __restrict__ Vh, bf16* __restrict__ Ob, int seq, char* lds, int wave_id) {
  const int wid = __builtin_amdgcn_readfirstlane(wave_id), lane = fresh_lane(), tid = wid * 64 + lane, r32 = lane & 31, hi = lane >> 5;
  char* V_lds = lds; char* K_lds = lds + 2 * SHM_V; char* P_lds = lds + 2 * SHM_V + 2 * SHM_K;
  float* ws = (float*)(lds + 2 * SHM_V + 2 * SHM_K + 2 * SHM_P) + wid * 64; float* li_l = ws; float* al_l = ws + 32;
  float m_reg = -1e30f, l_reg = 0; f32x16 o[4] = {}; i32x8 q8[3];
  const char* Qw = (const char*)Qb + (size_t)wid * (QBLK * QKD); const int qoff = r32 * QKD + hi * 32;
#pragma unroll
  for (int s = 0; s < 3; ++s) q8[s] = CAT8(*reinterpret_cast<const i32x4*>(Qw + qoff + 64 * s), *reinterpret_cast<const i32x4*>(Qw + qoff + 64 * s + 16));
  const int sr = tid >> 4, sc = (tid & 15) * 8, vst0 = v_st(sr, sc), vst1 = v_st(32 + sr, sc);
  const int kr = tid >> 3, kc = (tid & 7) * 16, pr = (tid >> 2) & 63, pc = (tid & 3) * 16;
  const bool do_p = wid < 4;
  const int vb0 = (int)(uintptr_t)V_lds + v_rd_base(lane);
  struct { bf16x8 vs0, vs1; i32x4 ks, ps; } sr_[1];
  const int voff = (sr * D + sc) * 2, koff = kr * 128 + kc, poff = pr * ROPE + pc;
#define SLOAD(i, k0) do { const char* vt_ = (const char*)Vh + (size_t)(k0) * (D * 2); const char* kt_ = (const char*)Kh + (size_t)(k0) * 128; const char* pt_ = (const char*)Ph + (size_t)(k0) * ROPE; \
    sr_[i].vs0 = *(const bf16x8*)(vt_ + voff); sr_[i].vs1 = *(const bf16x8*)(vt_ + voff + 32 * D * 2); sr_[i].ks = *(const i32x4*)(kt_ + koff); \
    if (do_p) sr_[i].ps = *(const i32x4*)(pt_ + poff); } while (0)
#define SWRITE(b, i) do { *(bf16x8*)(V_lds + (b) * SHM_V + vst0) = sr_[i].vs0; *(bf16x8*)(V_lds + (b) * SHM_V + vst1) = sr_[i].vs1; \
    *(i32x4*)(K_lds + (b) * SHM_K + K8SWZ(kr, kc)) = sr_[i].ks; if (do_p) *(i32x4*)(P_lds + (b) * SHM_P + P8SWZ(pr, pc)) = sr_[i].ps; } while (0)
#define SWAIT() asm volatile("s_waitcnt vmcnt(0)" ::: "memory")
#define RESC(a) do { if (__any((a) < 1.f)) { if (hi == 0) al_l[r32] = (a); asm volatile("s_waitcnt lgkmcnt(0)" ::: "memory"); \
    for (int d = 0; d < 4; ++d) for (int r = 0; r < 16; ++r) o[d][r] *= al_l[crow(r, hi)]; } } while (0)
  f32x16 pA0, pA1, pB0, pB1; float mnA, mnB, alA, alB; bf16x8 pa0, pa1, pa2, pa3; const int NT = seq / KVBLK;
  SLOAD(0, 0); asm volatile("s_waitcnt vmcnt(0)" ::: "memory"); SWRITE(0, 0); __syncthreads();
  qkt(pA0, pA1, K_lds, P_lds, q8, r32, hi); partialSM(pA0, pA1, m_reg, mnA, alA);
  SLOAD(0, KVBLK);
  SWAIT(); SWRITE(1, 0); __syncthreads();
  for (int j = 1; j + 1 < NT; j += 2) {
    SBAR(); qkt(pB0, pB1, K_lds + SHM_K, P_lds + SHM_P, q8, r32, hi);
    finishSM(pA0, pA1, alA, l_reg, pa0, pa1, pa2, pa3); SBAR();
    SLOAD(0, (j + 1) * KVBLK); SBAR();
    pv_d0(o, vb0, pa0, pa1, pa2, pa3); partialSM(pB0, pB1, m_reg, mnB, alB);
    __syncthreads(); SWAIT(); SWRITE(0, 0);
    RESC(alB); __syncthreads();
    SBAR(); qkt(pA0, pA1, K_lds, P_lds, q8, r32, hi);
    finishSM(pB0, pB1, alB, l_reg, pa0, pa1, pa2, pa3); SBAR();
    SLOAD(0, (j + 2) * KVBLK); SBAR();
    pv_d0(o, vb0 + (int)SHM_V, pa0, pa1, pa2, pa3); partialSM(pA0, pA1, m_reg, mnA, alA);
    __syncthreads(); SWAIT(); SWRITE(1, 0);
    RESC(alA); __syncthreads();
  }
  SBAR(); qkt(pB0, pB1, K_lds + SHM_K, P_lds + SHM_P, q8, r32, hi);
  finishSM(pA0, pA1, alA, l_reg, pa0, pa1, pa2, pa3); SBAR();
  pv_d0(o, vb0, pa0, pa1, pa2, pa3); partialSM(pB0, pB1, m_reg, mnB, alB);
  __syncthreads(); RESC(alB);
  finishSM(pB0, pB1, alB, l_reg, pa0, pa1, pa2, pa3); SBAR();
  pv_d0(o, vb0 + (int)SHM_V, pa0, pa1, pa2, pa3);
  if (hi == 0) li_l[r32] = l_reg; asm volatile("s_waitcnt lgkmcnt(0)" ::: "memory");
  float rli[16];
#pragma unroll
  for (int r = 0; r < 16; ++r) rli[r] = __builtin_amdgcn_rcpf(li_l[crow(r, hi)]);
  char* Ow = (char*)Ob + (size_t)wid * (QBLK * DM * 2); const int ooff = (4 * hi * DM + r32) * 2;
#pragma unroll
  for (int r = 0; r < 16; ++r) { const int orow = (r & 3) + 8 * (r >> 2);
#pragma unroll
    for (int d0 = 0; d0 < 4; ++d0) { const unsigned w = cvtpk(o[d0][r] * rli[r], 0.f); *(bf16*)(Ow + ooff + (orow * DM + d0 * 32) * 2) = (bf16)(w & 0xffffu); } }
  __syncthreads();
#undef SLOAD
#undef SWRITE
#undef SWAIT
#undef RESC
}
#undef K8SWZ
#undef P8SWZ
#undef SBAR
#undef CAT8
#undef MFMA8
}

__global__ void __launch_bounds__(NWAVES * 64, 2) fwd_kernel(Args args) {
    extern __shared__ __attribute__((aligned(16))) unsigned char lds[];
    Frame F;
    F.lds = (LAS unsigned char*)lds;
    F.MISC = (volatile LAS unsigned*)(F.lds + MISC_OFF);
    F.tid = threadIdx.x; F.lane = F.tid & 63; F.wave = __builtin_amdgcn_readfirstlane(F.tid >> 6);
    F.G = gridDim.x; { const int bx = blockIdx.x; F.vcu = (F.G % 8 == 0) ? (bx % 8) * (F.G / 8) + bx / 8 : bx; }
    unsigned char* ws = args.ws;
    F.ctl = (gu32*)(ws + WS_CTL);
    for (int u = F.tid; u < (LDS_BYTES - LDSCTL_OFF) / 4; u += NWAVES * 64) ((LAS unsigned*)(F.lds + LDSCTL_OFF))[u] = 0u;
    __syncthreads();
    XcdBarrier bar = xcd_barrier_post((unsigned*)(F.ctl + CW_BAR), F.MISC + 8);
#define GRID_BAR() xcd_barrier(bar, F.wave)
#ifndef DROPMASK
#define DROPMASK 0
#endif
#ifndef PHMASK
#define PHMASK 0xffffffffu
#endif
#ifndef DUPMASK
#define DUPMASK 0u
#endif
#define PH(k) FRESH(); if constexpr (((PHMASK) >> (k)) & 1u) for (int rep_ = 0; rep_ < ((((DUPMASK) >> (k)) & 1u) ? 2 : 1); ++rep_)
#define FRESH() do { F.lane = fresh_lane(); F.tid = F.wave * 64 + F.lane; } while (0)
    unsigned char* ar = ws + WS_ARENA;
    float* const mod = (float*)(ws + WS_MOD); const float* const mod0 = mod; const float* const mod1 = mod + 9 * MODW;
    const float* const rope = (const float*)(ws + WS_ROPE);
    bf16* const XCb = nullptr; (void)XCb;
    float* const XC = (float*)(ar + AR_XC * MiB);
    bf16* const H = (bf16*)(ar + AR_H * MiB);
    PG8_LAS unsigned char* const ring = (PG8_LAS unsigned char*)(F.lds + RING_OFF);
    const int G = F.G, cid = (int)blockIdx.x;
#if SELFCHECK
    chk::Ctx CK{&args, ws, ar, (unsigned*)(ws + WS_CTL) + CW_DBG, mod, XC};
#define CHK(stmt) do { FRESH(); stmt; GRID_BAR(); } while (0)
#else
#define CHK(stmt) do { } while (0)
#endif

#ifndef XW_LATE
#define XW_LATE 1
#endif
    PH(0) { p0_prologue<0>(F, args); if (!XW_LATE) p0_prologue<1>(F, args); }
    GRID_BAR();
    CHK(chk::c_mod(F, CK));
    PH(1) norm_phase<false>(F, args, args.in[I_X], args.in[I_CTX], MALL, args.in[I_NORMG] + 0 * DM, mod0, 0, H);
    GRID_BAR();
    CHK(chk::c_norm(F, CK, 1, args.in[I_X], args.in[I_CTX], MALL, args.in[I_NORMG], mod0, 0, H));
    PH(2) { pg8::Gemm g{H, (const bf16*)(ws + WS_WIN), MALL, 2048, DM}; pg8::StaticOrder S; S.init(MALL, 2048, G, cid);
      epi::EpiMixIn E{(bf16*)(ar + AR_AG * MiB), (bf16*)(ar + AR_UG * MiB), (bf16*)(ar + AR_VG * MiB)};
      pg8::gemm_phase<epi::EpiMixIn, pg8::StaticOrder, true>(ring, g, S, E, F.wave); }
    GRID_BAR();
    CHK(chk::c_mixin(F, CK, H, (const bf16*)(ar + AR_AG * MiB), (const bf16*)(ar + AR_UG * MiB), (const bf16*)(ar + AR_VG * MiB)));
    PH(3) mixmid_phase(F, args, (const bf16*)(ar + AR_AG * MiB), (const bf16*)(ar + AR_UG * MiB), (const bf16*)(ar + AR_VG * MiB), (const bf16*)(ws + WS_WSB), H);
    GRID_BAR();
    CHK(chk::c_mixmid(F, CK, (const bf16*)(ar + AR_AG * MiB), (const bf16*)(ar + AR_UG * MiB), (const bf16*)(ar + AR_VG * MiB), H));
    PH(4) { pg8::Gemm g{H, (const bf16*)(ws + WS_WOUT), MALL, DM, DM}; pg8::StaticOrder S; S.init(MALL, DM, G, cid);
      epi::EpiResid E{args.in[I_X], args.in[I_CTX], args.out, XC, mod0 + 2 * DM, (DROPMASK & 1) ? 0.f : 1.f};
      pg8::gemm_phase<epi::EpiResid, pg8::StaticOrder, true>(ring, g, S, E, F.wave); }
    GRID_BAR();
    CHK(chk::c_resid(F, CK, 4, MALL, H, DM, args.in[I_EWOUT], mod0 + 2 * DM, args.in[I_X], args.in[I_CTX], false));
    PH(5) norm_phase<false, FFN_FP8 == 1>(F, args, args.out, XC, MALL, args.in[I_NORMG] + 1 * DM, mod0, 3, H);
    GRID_BAR();
#if !FFN_FP8
    CHK(chk::c_norm(F, CK, 5, args.out, XC, MALL, args.in[I_NORMG] + DM, mod0, 3, H));
#endif
#if FFN_FP8
#if FFN_FP8 == 1
    PH(6) { pg8::Gemm g{H, (const bf16*)(ws + WS_W13), MALL, 2 * DFF, DM / 2, 0x7f7f7f7f, SC_W13 * 0x01010101}; pg8::StaticOrder S; S.init(MALL, 2 * DFF, G, cid);
      epi::EpiSwiGluF8 E{ar + AR_ACT * MiB, DFF, 2 * DFF / 256};
      pg8::gemm_phase<epi::EpiSwiGluF8, pg8::StaticOrder, true, false, true>(ring, g, S, E, F.wave); }
#else
    PH(6) { pg8::Gemm g{H, (const bf16*)(ws + WS_W13), MALL, 2 * DFF, DM}; pg8::StaticOrder S; S.init(MALL, 2 * DFF, G, cid);
      epi::EpiSwiGluF8 E{ar + AR_ACT * MiB, DFF, 2 * DFF / 256};
      pg8::gemm_phase<epi::EpiSwiGluF8, pg8::StaticOrder, true>(ring, g, S, E, F.wave); }
#endif
    GRID_BAR();
    PH(7) { pg8::Gemm g{(const bf16*)(ar + AR_ACT * MiB), (const bf16*)(ws + WS_W2), MALL, DM, DFF / 2, 0x7f7f7f7f, SC_W2 * 0x01010101}; pg8::StaticOrder S; S.init(MALL, DM, G, cid);
      epi::EpiResid E{args.out, XC, args.out, XC, mod0 + 5 * DM, ((DROPMASK & 2) || rep_) ? 0.f : 1.f};
      pg8::gemm_phase<epi::EpiResid, pg8::StaticOrder, true, false, true>(ring, g, S, E, F.wave); }
    GRID_BAR();
#else
    PH(6) { pg8::Gemm g{H, (const bf16*)(ws + WS_W13), MALL, 2 * DFF, DM}; pg8::StaticOrder S; S.init(MALL, 2 * DFF, G, cid);
      epi::EpiSwiGlu E{(bf16*)(ar + AR_ACT * MiB), DFF, 2 * DFF / 256};
      pg8::gemm_phase<epi::EpiSwiGlu, pg8::StaticOrder, true>(ring, g, S, E, F.wave); }
    GRID_BAR();
    CHK(chk::c_swiglu(F, CK, H, (const bf16*)(ar + AR_ACT * MiB)));
    CHK(chk::c_capture(F, CK, 7, MALL));
    PH(7) { pg8::Gemm g{(const bf16*)(ar + AR_ACT * MiB), (const bf16*)(ws + WS_W2), MALL, DM, DFF}; pg8::StaticOrder S; S.init(MALL, DM, G, cid);
      epi::EpiResid E{args.out, XC, args.out, XC, mod0 + 5 * DM, ((DROPMASK & 2) || rep_) ? 0.f : 1.f};
      pg8::gemm_phase<epi::EpiResid, pg8::StaticOrder, true>(ring, g, S, E, F.wave); }
    GRID_BAR();
    CHK(chk::c_resid(F, CK, 7, MALL, (const bf16*)(ar + AR_ACT * MiB), DFF, args.in[I_FW2], mod0 + 5 * DM, nullptr, nullptr, true));
#endif
    PH(8) norm_phase<false>(F, args, args.out, XC, MALL, args.in[I_NORMG] + 2 * DM, mod1, 0, H);
    GRID_BAR();
    CHK(chk::c_norm(F, CK, 8, args.out, XC, MALL, args.in[I_NORMG] + 2 * DM, mod1, 0, H));
    PH(9) { pg8::Gemm g{H, (const bf16*)(ws + WS_WINO), MALL, INO_PAD, DM}; pg8::StaticOrder S; S.init(MALL, INO_PAD, G, cid);
      epi::EpiPlain E{(bf16*)(ar + AR_Z * MiB), INO_PAD};
      pg8::gemm_phase<epi::EpiPlain, pg8::StaticOrder, true>(ring, g, S, E, F.wave); }
    GRID_BAR();
    CHK(chk::c_z(F, CK, H, (const bf16*)(ar + AR_Z * MiB)));
    PH(10) zsplit_phase(F, args, (const bf16*)(ar + AR_Z * MiB), (bf16*)(ar + AR_QN * MiB), (bf16*)(ar + AR_KVN * MiB), ar + AR_KPE * MiB, rope);
    GRID_BAR();
    CHK(chk::c_zsplit(F, CK, (const bf16*)(ar + AR_Z * MiB), (const bf16*)(ar + AR_QN * MiB), (const bf16*)(ar + AR_KVN * MiB), ar + AR_KPE * MiB));
    PH(11) { pg8::Gemm g{(const bf16*)(ar + AR_QN * MiB), (const bf16*)(ws + WS_WUQ), NLAT, 1536, QRANK}; pg8::StaticOrder S; S.init(NLAT, 1536, G, cid);
      epi::EpiQ E{ar + AR_Q * MiB, rope};
      pg8::gemm_phase<epi::EpiQ, pg8::StaticOrder, true>(ring, g, S, E, F.wave); }
    PH(12) { pg8::Gemm g{(const bf16*)(ar + AR_KVN * MiB), (const bf16*)(ws + WS_WUKV), MALL, 2048, KVRANK}; pg8::StaticOrder S; S.init(MALL, 2048, G, cid);
      epi::EpiKV E{ar + AR_KN * MiB, (bf16*)(ar + AR_V * MiB)};
      pg8::gemm_phase<epi::EpiKV, pg8::StaticOrder, true>(ring, g, S, E, F.wave); }
    GRID_BAR();
    CHK(chk::c_qkv(F, CK, (const bf16*)(ar + AR_QN * MiB), (const bf16*)(ar + AR_KVN * MiB), ar + AR_Q * MiB, ar + AR_KN * MiB, (const bf16*)(ar + AR_V * MiB)));
    PH(13) { const unsigned char* Qg = ar + AR_Q * MiB; const unsigned char* Kg = ar + AR_KN * MiB; const unsigned char* Pg = ar + AR_KPE * MiB; const bf16* Vg = (const bf16*)(ar + AR_V * MiB);
      bf16* Og = (bf16*)(ar + AR_ATT * MiB);
      constexpr int NQB = SEQ / 256, NU = NB * NHEAD * NQB;
      for (int u = F.vcu; u < NU; u += G) { const int bh = u / NQB, qb = u - bh * NQB, b = bh / NHEAD, h = bh - b * NHEAD;
          att::attn_unit(Qg + ((size_t)bh * SEQ + qb * 256) * QKD, Kg + (size_t)bh * SKV * 128, Pg + (size_t)b * SKV * ROPE, Vg + (size_t)bh * SKV * VHD,
                         Og + ((size_t)b * SEQ + qb * 256) * DM + h * VHD, SKV, (char*)lds + RING_OFF, F.wave); } }
    GRID_BAR();
    CHK(chk::c_attn(F, CK, ar + AR_Q * MiB, ar + AR_KN * MiB, ar + AR_KPE * MiB, (const bf16*)(ar + AR_V * MiB), (const bf16*)(ar + AR_ATT * MiB)));
    CHK(chk::c_capture(F, CK, 13, NLAT));
    PH(14) { pg8::Gemm g{(const bf16*)(ar + AR_ATT * MiB), (const bf16*)(ws + WS_WO), NLAT, DM, DM}; pg8::StaticOrder S; S.init(NLAT, DM, G, cid);
      epi::EpiResid E{args.out, XC, args.out, XC, mod1 + 2 * DM, ((DROPMASK & 4) || rep_) ? 0.f : 1.f};
      pg8::gemm_phase<epi::EpiResid, pg8::StaticOrder, true>(ring, g, S, E, F.wave); }
    GRID_BAR();
    CHK(chk::c_resid(F, CK, 13, NLAT, (const bf16*)(ar + AR_ATT * MiB), DM, args.in[I_WO], mod1 + 2 * DM, nullptr, nullptr, true));
    PH(15) norm_phase<true>(F, args, args.out, XC, NLAT, args.in[I_NORMG] + 3 * DM, mod1, 3, (bf16*)(ar + AR_H4 * MiB));
    GRID_BAR();
    CHK(chk::c_route(F, CK, mod1, ar + AR_H4 * MiB));
    if (XW_LATE) { PH(19) p0_prologue<1>(F, args); GRID_BAR(); }
    LAS int* const tab = (LAS int*)(F.lds + MOET_OFF);
    { FRESH();
      if (F.tid == 0) { int base = 0;
          for (int e = 0; e < NEXP; ++e) { const int c = (int)__hip_atomic_load((unsigned*)F.ctl + CW_CNT + 64 * e, RLX_AGENT); tab[e] = base; tab[16 + e] = c; base += (c + 255) >> 8; }
          tab[8] = base; }
      __syncthreads(); }
    const int TT = tab[8];
    const unsigned* const list = (const unsigned*)(ws + WS_LIST);
    PH(16) { pg8::Gemm g{(const bf16*)(ar + AR_H4 * MiB), (const bf16*)(ws + WS_EW13), TT * 256, 2 * DEXP, DM / 2, 0x7f7f7f7f, SC_W13 * 0x01010101};
      MoeOrder S; S.so.init(TT * 256, 2 * DEXP, G, cid); S.nN = 2 * DEXP / 256; S.tab = tab; S.list = list; S.tok0 = 0;
      epi::EpiSwiGluF8 E{ar + AR_ACTE * MiB, DEXP, 2 * DEXP / 256};
      pg8::gemm_phase<epi::EpiSwiGluF8, MoeOrder, true, true, true>(ring, g, S, E, F.wave); }
    GRID_BAR();
    CHK(chk::c_moe_up(F, CK, tab, ar + AR_H4 * MiB, ar + AR_ACTE * MiB));
    PH(17) { pg8::Gemm g{(const bf16*)(ar + AR_ACTE * MiB), (const bf16*)(ws + WS_EW2), TT * 256, DM, DEXP / 2, 0x7f7f7f7f, SC_W2 * 0x01010101};
      MoeOrder S; S.so.init(TT * 256, DM, G, cid); S.nN = DM / 256; S.tab = tab; S.list = list; S.tok0 = 0;
      epi::EpiMoeDown E{(bf16*)(ar + AR_Y * MiB), list, tab};
      pg8::gemm_phase<epi::EpiMoeDown, MoeOrder, true, false, true>(ring, g, S, E, F.wave); }
    GRID_BAR();
    CHK(chk::c_moe_down(F, CK, tab, ar + AR_ACTE * MiB, (const bf16*)(ar + AR_Y * MiB)));
    CHK(chk::c_cap_rows(F, CK));
    PH(18) combine_phase(F, args, (const bf16*)(ar + AR_Y * MiB), mod1, (DROPMASK & 8) ? 0.f : 1.f);
#if SELFCHECK
    GRID_BAR(); CHK(chk::c_combine(F, CK, mod1, (const bf16*)(ar + AR_Y * MiB)));
    { FRESH(); int code = -1;
      for (int k = 39; k >= 0; --k) { const unsigned f = __hip_atomic_load(CK.dbg + 64 * k, RLX_AGENT), n = __hip_atomic_load(CK.dbg + 64 * k + 1, RLX_AGENT); if (f * 50u > n) code = k; }
      if (code >= 0) { const float v = sqrtf((float)(code + 1)); for (size_t i = (size_t)blockIdx.x * 512 + F.tid; i < (size_t)NLAT * DM; i += (size_t)gridDim.x * 512) args.out[i] = v; } }
#endif
#undef GRID_BAR
}

extern "C" void kernel_launch(void* const* d_in, const int* in_sizes, int n_in, void* d_out, int out_size, void* d_ws, size_t ws_size, hipStream_t stream) {
    static int grid = 0;
    if (grid == 0) {
        if (n_in != 31 || in_sizes[0] != NLAT * DM || out_size != NLAT * DM || ws_size < WS_END) {
            fprintf(stderr, "kernel_launch: shape mismatch: n_in %d in0 %d out %d ws %zu (need %zu); nothing launched\n", n_in, n_in > 0 ? in_sizes[0] : -1, out_size, ws_size, (size_t)WS_END); grid = -1; return; }
        int dev = 0, cus = 0, per_cu = 0;
        if (hipGetDevice(&dev) != hipSuccess || hipDeviceGetAttribute(&cus, hipDeviceAttributeMultiprocessorCount, dev) != hipSuccess) { fprintf(stderr, "kernel_launch: device query failed\n"); grid = -1; return; }
        if (hipFuncSetAttribute((const void*)fwd_kernel, hipFuncAttributeMaxDynamicSharedMemorySize, LDS_BYTES) != hipSuccess) { fprintf(stderr, "kernel_launch: hipFuncSetAttribute failed\n"); grid = -1; return; }
        if (hipOccupancyMaxActiveBlocksPerMultiprocessor(&per_cu, (const void*)fwd_kernel, NWAVES * 64, LDS_BYTES) != hipSuccess || per_cu < 1) {
            fprintf(stderr, "kernel_launch: occupancy query reports %d workgroups per CU; nothing launched\n", per_cu); (void)hipGetLastError(); grid = -1; return; }
        grid = cus;
    }
    if (grid < 0) return;
    if (hipMemsetAsync((char*)d_ws + WS_CTL, 0, CTL_ZERO_BYTES, stream) != hipSuccess) { fprintf(stderr, "kernel_launch: memset failed\n"); return; }
    Args a{};
    for (int i = 0; i < 31; ++i) a.in[i] = (const float*)d_in[i];
    a.out = (float*)d_out; a.ws = (unsigned char*)d_ws;
    hipLaunchKernelGGL(fwd_kernel, dim3(grid), dim3(NWAVES * 64), LDS_BYTES, stream, a);
    const hipError_t le = hipPeekAtLastError();
    if (le != hipSuccess) fprintf(stderr, "kernel_launch: launch failed: %s\n", hipGetErrorName(le));
}
```

```cpp
#include <hip/hip_runtime.h>
#include <cstdio>
#include <cstdint>
#ifndef DUPMASK
#define DUPMASK 0u
#endif
#ifndef FUSE_NORM
#define FUSE_NORM 0
#endif
#ifndef ATT_FP8
#define ATT_FP8 1
#endif
#ifndef FFN_FP8
#define FFN_FP8 2
#endif
#ifndef DROPMASK
#define DROPMASK 0
#endif

__device__ __forceinline__ int fresh_lane() { int l; asm volatile("v_mbcnt_lo_u32_b32 %0, -1, 0\n\tv_mbcnt_hi_u32_b32 %0, -1, %0" : "=v"(l)); return l; }
namespace pg8 {
#define PG8_LAS __attribute__((address_space(3)))
typedef unsigned short bf16_t;
typedef short bf16x8 __attribute__((ext_vector_type(8)));
typedef float f32x4 __attribute__((ext_vector_type(4)));
typedef unsigned u32x4 __attribute__((ext_vector_type(4)));
constexpr int BM = 256, BK = 64, HALF = 128, HTB = HALF * BK * 2  , STAGE_BYTES = 8 * HTB, NXCD = 8, WGM = 8;

__host__ __device__ __forceinline__ int lds_byte(int r, int c) { const int st = (r >> 4) * 2 + (c >> 5), rr = r & 15, cc = c & 31, ob = rr * 64 + cc * 2; return st * 1024 + (ob ^ (((ob >> 9) & 1) << 5)); }
__host__ __device__ __forceinline__ void stage_rc(int b, int& R, int& C) { const int st = b / 1024, sb = b % 1024, swz = sb ^ (((sb >> 9) & 1) << 5); R = (st >> 1) * 16 + swz / 64; C = (st & 1) * 32 + (swz % 64) / 2; }
__host__ __device__ __forceinline__ int perm32(int rho) { const int n = rho >> 4, i = rho & 15; return 8 * (i >> 2) + 4 * n + (i & 3); }

struct Unit { int pm, pn; };
struct Gemm { const bf16_t* A; const bf16_t* Bt; int M, N, K; int sa, sb; };
typedef int i32x4 __attribute__((ext_vector_type(4)));
typedef int i32x8 __attribute__((ext_vector_type(8)));

struct StaticOrder {
    int nM, nN, nwg, G, c;
    __host__ __device__ void init(int M, int N, int G_, int c_) { nM = M / BM; nN = N / BM; nwg = nM * nN; G = G_; c = c_; }
    __host__ __device__ bool next(int i, Unit& u) const {
        const long L = (long)i * G + c; if (L >= nwg) return false;
        int wgid = (int)L; { const int q = nwg / NXCD, r = nwg % NXCD, xcd = wgid % NXCD, off = wgid / NXCD; wgid = (xcd < r ? xcd * (q + 1) : r * (q + 1) + (xcd - r) * q) + off; }
        const int nig = WGM * nN, gid = wgid / nig, fm = gid * WGM, gsz = (nM - fm) < WGM ? (nM - fm) : WGM;
        u.pm = fm + ((wgid % nig) % gsz); u.pn = (wgid % nig) / gsz; return true;
    }
    __device__ __forceinline__ int arow(const Unit&, int) const { return 0; }
};

__device__ __forceinline__ unsigned cvt_pk_bf16(float lo, float hi) { unsigned r; asm volatile("v_cvt_pk_bf16_f32 %0, %1, %2" : "=v"(r) : "v"(lo), "v"(hi)); return r; }
__device__ __forceinline__ u32x4 pack8(const f32x4 a, const f32x4 b) { u32x4 w; w.x = cvt_pk_bf16(a[0], a[1]); w.y = cvt_pk_bf16(a[2], a[3]); w.z = cvt_pk_bf16(b[0], b[1]); w.w = cvt_pk_bf16(b[2], b[3]); return w; }

template <class Epi, class Sched, bool ALIGN_EPI = false, bool GATHER = false, bool FP8 = false>
__device__ __forceinline__ void gemm_phase(PG8_LAS unsigned char* lds, const Gemm g, const Sched& S, const Epi& E, int wave_id) {
    const int wid = __builtin_amdgcn_readfirstlane(wave_id), tid = wid * 64 + fresh_lane(), lane = tid & 63, wr = wid >> 2, wc = wid & 3, fr = lane & 15, fq = lane >> 4;
    const int K = g.K, nt = K / BK;
    unsigned voffA[2], voffB[2]; int RA[2], CA[2];
#pragma unroll
    for (int i = 0; i < 2; ++i) { int R, C; stage_rc(tid * 16 + i * 8192, R, C); const int Rb = Epi::PERM ? ((R & ~31) + perm32(R & 31)) : R;
        RA[i] = R; CA[i] = C; voffA[i] = (unsigned)(R * K + C) * 2u; voffB[i] = (unsigned)(Rb * K + C) * 2u; }
    const size_t kstep = (size_t)(BK * 2);
    const size_t hstep = (size_t)HALF * K * 2;
    const size_t tstep = 2 * hstep;
    const unsigned ldsw = (unsigned)wid * 1024u;
    const int aoff = lds_byte(wr * 64 + fr, fq * 8), boff = lds_byte(wc * 32 + fr, fq * 8);
#define PG8_SA(b, h) (((b) * 2 + (h)) * HTB)
#define PG8_SB(b, h) ((4 + (b) * 2 + (h)) * HTB)
#define PG8_GLDS(gp, loff) __builtin_amdgcn_global_load_lds((const unsigned*)(gp), (PG8_LAS unsigned*)(lds + (loff)), 16, 0, 0)
#define PG8_STAGE(bufoff, gbase, voff) do { _Pragma("unroll") for (int _i = 0; _i < 2; ++_i) PG8_GLDS((const char*)(gbase) + (voff)[_i], (bufoff) + ldsw + _i * 8192); } while (0)
#define PG8_STAGE_A(bufoff, ptr_ng, ptr_g, h, nx) do { if constexpr (GATHER) { const unsigned _o0 = (nx) ? gn[h][0] : gc[h][0], _o1 = (nx) ? gn[h][1] : gc[h][1]; \
        PG8_GLDS((const char*)(ptr_g) + _o0, (bufoff) + ldsw); PG8_GLDS((const char*)(ptr_g) + _o1, (bufoff) + ldsw + 8192); } \
    else { PG8_STAGE(bufoff, (const char*)(ptr_ng) + (h) * hstep, voffA); } } while (0)
#define PG8_MAP(u, go) do { _Pragma("unroll") for (int _h = 0; _h < 2; ++_h) _Pragma("unroll") for (int _i = 0; _i < 2; ++_i) go[_h][_i] = ((unsigned)S.arow(u, _h * HALF + RA[_i]) * (unsigned)K + (unsigned)CA[_i]) * 2u; } while (0)
#define PG8_LD16(off) (*(const PG8_LAS bf16x8*)(lds + (off)))
#define PG8_CAT(x0, x1) __builtin_shufflevector(__builtin_bit_cast(i32x4, x0), __builtin_bit_cast(i32x4, x1), 0, 1, 2, 3, 4, 5, 6, 7)
#define PG8_LDA(dst, b, h) do { if constexpr (FP8) { _Pragma("unroll") for (int m = 0; m < 4; ++m) dst##8[m] = PG8_CAT(PG8_LD16(PG8_SA(b, h) + aoff + m * 2048), PG8_LD16(PG8_SA(b, h) + aoff + m * 2048 + 1024)); } \
    else { _Pragma("unroll") for (int m = 0; m < 4; ++m) _Pragma("unroll") for (int k = 0; k < 2; ++k) dst[m][k] = PG8_LD16(PG8_SA(b, h) + aoff + m * 2048 + k * 1024); } } while (0)
#define PG8_LDB(dst, b, h) do { if constexpr (FP8) { _Pragma("unroll") for (int n = 0; n < 2; ++n) dst##8[n] = PG8_CAT(PG8_LD16(PG8_SB(b, h) + boff + n * 2048), PG8_LD16(PG8_SB(b, h) + boff + n * 2048 + 1024)); } \
    else { _Pragma("unroll") for (int n = 0; n < 2; ++n) _Pragma("unroll") for (int k = 0; k < 2; ++k) dst[n][k] = PG8_LD16(PG8_SB(b, h) + boff + n * 2048 + k * 1024); } } while (0)
#define PG8_MMA(ai, bj, At, Bt) do { __builtin_amdgcn_s_setprio(1); if constexpr (FP8) { _Pragma("unroll") for (int m = 0; m < 4; ++m) _Pragma("unroll") for (int n = 0; n < 2; ++n) \
        asm volatile("v_mfma_scale_f32_16x16x128_f8f6f4 %0, %1, %2, %0, %3, %4 op_sel_hi:[0,0,0]" : "+v"(acc[ai][bj][m][n]) : "v"(Bt##8[n]), "v"(At##8[m]), "v"(vsb), "v"(vsa)); } \
    else { _Pragma("unroll") for (int m = 0; m < 4; ++m) _Pragma("unroll") for (int n = 0; n < 2; ++n) _Pragma("unroll") for (int k = 0; k < 2; ++k) \
        acc[ai][bj][m][n] = __builtin_amdgcn_mfma_f32_16x16x32_bf16(Bt[n][k], At[m][k], acc[ai][bj][m][n], 0, 0, 0); } __builtin_amdgcn_s_setprio(0); } while (0)
#define PG8_WAIT_V(n) asm volatile("s_waitcnt vmcnt(" #n ")" ::: "memory")
#define PG8_WAIT_L(n) asm volatile("s_waitcnt lgkmcnt(" #n ")" ::: "memory")
#define PG8_BAR __builtin_amdgcn_s_barrier()
#define PG8_SCHED __builtin_amdgcn_sched_barrier(0)
    Unit cur, nxt; int ui = 0;
    if (!S.next(0, cur)) return;
    const int vsa = g.sa, vsb = g.sb; (void)vsa; (void)vsb;
    f32x4 acc[2][2][4][2];
#pragma unroll
    for (int a = 0; a < 2; ++a)
#pragma unroll
        for (int b = 0; b < 2; ++b)
#pragma unroll
            for (int m = 0; m < 4; ++m)
#pragma unroll
                for (int n = 0; n < 2; ++n) acc[a][b][m][n] = (f32x4){0.f, 0.f, 0.f, 0.f};
    bf16x8 At[4][2], B0[2][2], B1[2][2]; i32x8 At8[4], B08[2], B18[2];
    unsigned gc[2][2] = {{0u, 0u}, {0u, 0u}}, gn[2][2] = {{0u, 0u}, {0u, 0u}};
    if constexpr (GATHER) { PG8_MAP(cur, gc); }
    const char* const gA = (const char*)g.A;
    const char* cA = GATHER ? gA : gA + (size_t)cur.pm * tstep; const char* cB = (const char*)g.Bt + (size_t)cur.pn * tstep;
    PG8_STAGE(PG8_SB(0, 0), cB, voffB); PG8_STAGE(PG8_SB(0, 1), cB + hstep, voffB); PG8_STAGE_A(PG8_SA(0, 0), cA, gA, 0, false); PG8_STAGE_A(PG8_SA(0, 1), cA, gA, 1, false);
    if (wr == 1) PG8_BAR;
    PG8_WAIT_V(2); PG8_BAR;
    PG8_STAGE(PG8_SB(1, 0), cB + kstep, voffB); PG8_STAGE_A(PG8_SA(1, 0), cA + kstep, gA + kstep, 0, false); PG8_STAGE(PG8_SB(1, 1), cB + hstep + kstep, voffB);
    PG8_WAIT_V(6); PG8_BAR;
    for (;;) {
        const bool has_next = S.next(ui + 1, nxt);
        if constexpr (GATHER) { if (has_next) { PG8_MAP(nxt, gn); } else {
#pragma unroll
            for (int h = 0; h < 2; ++h)
#pragma unroll
                for (int i = 0; i < 2; ++i) gn[h][i] = gc[h][i]; } }
        const char* nA = GATHER ? gA : (has_next ? gA + (size_t)nxt.pm * tstep : cA); const char* nB = has_next ? (const char*)g.Bt + (size_t)nxt.pn * tstep : cB;
#pragma unroll 1
        for (int t = 0; t < nt; t += 2) {
            const bool last = (t == nt - 2);
            const char* a1 = cA + (size_t)(t + 1) * kstep;
            const char* a2 = last ? nA : cA + (size_t)(t + 2) * kstep; const char* b2 = last ? nB : cB + (size_t)(t + 2) * kstep;
            const char* a3 = a2 + kstep; const char* b3 = b2 + kstep;
            PG8_LDB(B0, 0, 0); PG8_LDB(B1, 0, 1); PG8_SCHED; PG8_LDA(At, 0, 0); PG8_STAGE_A(PG8_SA(1, 1), a1, a1, 1, false);
            PG8_WAIT_V(8); PG8_WAIT_L(0); PG8_BAR; PG8_MMA(0, 0, At, B0); PG8_MMA(0, 1, At, B1); PG8_BAR; PG8_SCHED;
            PG8_LDA(At, 0, 1); PG8_STAGE(PG8_SB(0, 0), b2, voffB); PG8_STAGE(PG8_SB(0, 1), b2 + hstep, voffB); PG8_STAGE_A(PG8_SA(0, 0), a2, a2, 0, last);
            PG8_WAIT_V(8); PG8_WAIT_L(0); PG8_BAR; PG8_MMA(1, 0, At, B0); PG8_MMA(1, 1, At, B1); PG8_BAR; PG8_SCHED;
            PG8_LDB(B0, 1, 0); PG8_LDB(B1, 1, 1); PG8_SCHED; PG8_LDA(At, 1, 0); PG8_STAGE_A(PG8_SA(0, 1), a2, a2, 1, last);
            PG8_WAIT_V(8); PG8_WAIT_L(0); PG8_BAR; PG8_MMA(0, 0, At, B0); PG8_MMA(0, 1, At, B1); PG8_BAR; PG8_SCHED;
            PG8_LDA(At, 1, 1); PG8_STAGE(PG8_SB(1, 0), b3, voffB); PG8_STAGE(PG8_SB(1, 1), b3 + hstep, voffB); PG8_STAGE_A(PG8_SA(1, 0), a3, a3, 0, last);
            PG8_WAIT_V(8); PG8_WAIT_L(0); PG8_BAR; PG8_MMA(1, 0, At, B0); PG8_MMA(1, 1, At, B1); PG8_BAR; PG8_SCHED;
        }
        if constexpr (ALIGN_EPI) { if (wr == 0) PG8_BAR; }
        if constexpr (FP8) { asm volatile("s_nop 15\n\ts_nop 15" ::: "memory"); }
        E(acc, cur, wr, wc, fr, fq);
        if (!has_next) break;
#pragma unroll
        for (int a = 0; a < 2; ++a)
#pragma unroll
            for (int b = 0; b < 2; ++b)
#pragma unroll
                for (int m = 0; m < 4; ++m)
#pragma unroll
                    for (int n = 0; n < 2; ++n) acc[a][b][m][n] = (f32x4){0.f, 0.f, 0.f, 0.f};
        cur = nxt; cA = nA; cB = nB; ++ui;
        if constexpr (GATHER) {
#pragma unroll
            for (int h = 0; h < 2; ++h)
#pragma unroll
                for (int i = 0; i < 2; ++i) gc[h][i] = gn[h][i]; }
        if constexpr (ALIGN_EPI) { if (wr == 1) PG8_BAR; }
    }
    PG8_WAIT_V(0);
    if constexpr (!ALIGN_EPI) { if (wr == 0) PG8_BAR; }
    PG8_BAR;
#undef PG8_SA
#undef PG8_SB
#undef PG8_GLDS
#undef PG8_STAGE
#undef PG8_STAGE_A
#undef PG8_MAP
#undef PG8_LDA
#undef PG8_LD16
#undef PG8_LDB
#undef PG8_MMA
#undef PG8_CAT
#undef PG8_WAIT_V
#undef PG8_WAIT_L
#undef PG8_BAR
#undef PG8_SCHED
}
}
constexpr int NWAVES = 8;
constexpr int DM = 1024, NB = 8, SEQ = 4096, CTXL = 256;
constexpr int NLAT = NB * SEQ, NCTX = NB * CTXL, MALL = NLAT + NCTX;
constexpr int ACH = 512, BCH = 512, CONVK = 31, CHUNK = 128;
constexpr int DFF = 2816, NEXP = 8, DEXP = 3584;
constexpr int QRANK = 384, KVRANK = 256, ROPE = 64, INO = 704, INO_PAD = 768, NHEAD = 8, QKD = 192, VHD = 128;
constexpr int SKV = CTXL + SEQ;
constexpr float EPS = 1e-6f;
constexpr float ATTN_SCALE = 0.07216878364870322f;
constexpr int LIST_CAP = NLAT;
constexpr int XROWS = 2 * NLAT + NEXP * 256;
constexpr int SC_W13 = 127 - 5, SC_W2 = 127 - 6;
constexpr int MODW = 6 * DM;

constexpr size_t MiB = 1u << 20;
constexpr size_t WS_CTL = 0, CTL_ZERO_BYTES = 1 * MiB;
constexpr size_t WS_MOD = 1 * MiB;
constexpr size_t WS_ROPE = 1 * MiB + 512 * 1024;
constexpr size_t WS_TOKG = 1 * MiB + 768 * 1024;
constexpr size_t WS_LIST = 2 * MiB;
constexpr size_t WS_WIN = 4 * MiB, WS_WOUT = 8 * MiB, WS_W13 = 10 * MiB, WS_W2 = 21 * MiB, WS_WINO = 27 * MiB, WS_WUQ = 29 * MiB, WS_WUKV = 31 * MiB, WS_WO = 32 * MiB;
constexpr size_t WS_B13 = 26 * MiB + 512 * 1024, WS_GV = 26 * MiB + 768 * 1024, WS_BZ = 26 * MiB + 896 * 1024;
constexpr size_t WS_WSB = 3 * MiB;
constexpr size_t WS_EW13 = 34 * MiB, WS_EW2 = 90 * MiB, WS_ARENA = 118 * MiB;
static_assert(WS_W2 + (size_t)DM * DFF * 2 <= WS_WINO && WS_WINO + (size_t)INO_PAD * DM * 2 <= WS_WUQ && WS_WUQ + (size_t)1536 * QRANK * 2 <= WS_WUKV && WS_WUKV + (size_t)2048 * KVRANK * 2 <= WS_WO && WS_WO + (size_t)DM * DM * 2 <= 34 * MiB && WS_LIST + (size_t)NEXP * LIST_CAP * 4 <= WS_WSB, "weight map");
static_assert(WS_EW13 + (size_t)NEXP * 2 * DEXP * DM == WS_EW2 && WS_EW2 + (size_t)NEXP * DM * DEXP == WS_ARENA, "expert weight map");
constexpr size_t AR_XC = 0, AR_H = 8, AR_AG = 76, AR_UG = 110, AR_VG = 144, AR_A0 = 76  , AR_ACT = 178, AR_Z = 76, AR_QN = 127, AR_KVN = 151, AR_KPE = 168, AR_Q = 173, AR_KN = 0, AR_V = 269, AR_ATT = 68;
constexpr size_t AR_SS = 370;
constexpr size_t AR_H4 = 0, AR_Y = 32, AR_ACTE = 160, AR_END = 392;
constexpr size_t WS_END = WS_ARENA + AR_END * MiB;
static_assert(AR_ACT * MiB + (size_t)MALL * DFF * 2 <= AR_SS * MiB && AR_SS * MiB + (size_t)2 * MALL * 64 <= AR_END * MiB && AR_ACTE * MiB + (size_t)XROWS * DEXP <= AR_END * MiB && (AR_V + 68) <= AR_END, "arena");
constexpr int CW_TMO = 0, CW_CODE = 1, CW_BAR = 4096, CW_CNT = 16384;

constexpr int RING_OFF = 0, RING_BYTES = 139264;
constexpr int LDSCTL_OFF = RING_BYTES, MISC_OFF = LDSCTL_OFF + 320, MOET_OFF = LDSCTL_OFF + 512;
constexpr int LDS_BYTES = 147456;

#define GAS __attribute__((address_space(1)))
#define LAS __attribute__((address_space(3)))
typedef unsigned short bf16;
typedef unsigned v4u __attribute__((ext_vector_type(4)));
typedef unsigned v2u __attribute__((ext_vector_type(2)));
typedef float f32x4 __attribute__((ext_vector_type(4)));
typedef float f32x2 __attribute__((ext_vector_type(2)));
typedef short bf16x8 __attribute__((ext_vector_type(8)));
typedef GAS unsigned gu32;
#define RLX_AGENT __ATOMIC_RELAXED, __HIP_MEMORY_SCOPE_AGENT
#define LDS_WAIT() asm volatile("s_waitcnt lgkmcnt(0)" ::: "memory")
#define VM_WAIT() asm volatile("s_waitcnt vmcnt(0)" ::: "memory")
using pg8::cvt_pk_bf16; using pg8::pack8;
__device__ __forceinline__ float bf_lo(unsigned w) { return __builtin_bit_cast(float, w << 16); }
__device__ __forceinline__ float bf_hi(unsigned w) { return __builtin_bit_cast(float, w & 0xffff0000u); }
__device__ __forceinline__ unsigned pk_fp8x4(float a, float b, float c, float d) { int w = 0; w = __builtin_amdgcn_cvt_pk_fp8_f32(a, b, w, false); w = __builtin_amdgcn_cvt_pk_fp8_f32(c, d, w, true); return (unsigned)w; }
__device__ __forceinline__ float fsigmoid(float x) { return __builtin_amdgcn_rcpf(1.0f + __builtin_amdgcn_exp2f(-1.4426950408889634f * x)); }
__device__ __forceinline__ float fsilu(float x) { return x * fsigmoid(x); }
__device__ __forceinline__ float fgelu(float x) { const float u = 0.7978845608028654f * (x + 0.044715f * x * x * x); return x * fsigmoid(2.0f * u); }
template <int K> __device__ __forceinline__ float lane_xor(float v) { return __builtin_bit_cast(float, __builtin_amdgcn_ds_swizzle(__builtin_bit_cast(int, v), (K << 10) | 0x1f)); }
__device__ __forceinline__ float wave_sum(float v) {
    v += lane_xor<1>(v); v += lane_xor<2>(v); v += lane_xor<4>(v); v += lane_xor<8>(v); v += lane_xor<16>(v);
    return __builtin_bit_cast(float, __builtin_amdgcn_readlane(__builtin_bit_cast(int, v), 0)) + __builtin_bit_cast(float, __builtin_amdgcn_readlane(__builtin_bit_cast(int, v), 32));
}

#define XB_TMO      128
#define XB_XCNT(j)  (256  + 64 * (j))
#define XB_XSUB(j)  (1280 + 64 * (j))
#define XB_XGEN(j)  (2304 + 64 * (j))
#define XB_TOP      3328
#define XB_TOPGEN   3392
#define XCD_BAR_WORDS 3456
#define XB_SPIN_CAP (1u << 18)

__device__ __forceinline__ unsigned xb_ld(unsigned* p)              { return __hip_atomic_load(p, __ATOMIC_RELAXED, __HIP_MEMORY_SCOPE_AGENT); }
__device__ __forceinline__ unsigned xb_add(unsigned* p, unsigned v) { return __hip_atomic_fetch_add(p, v, __ATOMIC_RELAXED, __HIP_MEMORY_SCOPE_AGENT); }
__device__ __forceinline__ unsigned xb_xcc_id() { return (unsigned)__builtin_amdgcn_s_getreg((3 << 11) | 20) & 0xFu; }
#define XB_SPIN(cond, bar) do { unsigned _sp = 0; while (cond) { __builtin_amdgcn_s_sleep(1); \
    if ((++_sp & 255u) == 0u) { if (xb_ld(&(bar)[XB_TMO])) break; if (_sp > XB_SPIN_CAP) { atomicAdd(&(bar)[XB_TMO], 1u); break; } } } } while (0)

struct XcdBarrier {
    unsigned* bar; unsigned x;
    volatile LAS unsigned* st;
};

__device__ __forceinline__ XcdBarrier xcd_barrier_post(unsigned* bar, volatile LAS unsigned* st) {
    XcdBarrier b; b.bar = bar; b.x = xb_xcc_id(); b.st = st;
    if (threadIdx.x == 0) (void)xb_add(&bar[XB_XCNT(b.x)], 1u);
    return b;
}
__device__ __forceinline__ void xcd_barrier_complete(unsigned* bar, unsigned x, unsigned& nloc, unsigned& nx) {
    const unsigned G = gridDim.x * gridDim.y * gridDim.z;
    unsigned sum, cnt, mine, sp = 0u;
    for (;;) {
        sum = 0u; cnt = 0u; mine = 0u;
#pragma unroll
        for (unsigned j = 0; j < 16; ++j) { const unsigned c = xb_ld(&bar[XB_XCNT(j)]); sum += c; cnt += (c > 0u) ? 1u : 0u; mine = (j == x) ? c : mine; }
        if (sum == G) break;
        __builtin_amdgcn_s_sleep(1);
        if ((++sp & 255u) == 0u) { if (xb_ld(&bar[XB_TMO])) break; if (sp > XB_SPIN_CAP) { atomicAdd(&bar[XB_TMO], 1u); break; } }
    }
    nloc = mine > 0u ? mine : 1u; nx = cnt > 0u ? cnt : 1u;
}

__device__ __forceinline__ void xcd_barrier(const XcdBarrier& b, int wave_id) {
    const bool t0 = (wave_id == 0) && (fresh_lane() == 0);
    asm volatile("s_waitcnt vmcnt(0)" ::: "memory");
    __syncthreads();
    if (t0) {
        unsigned* bar = b.bar;
        __builtin_amdgcn_s_waitcnt(0);
        unsigned nloc = b.st[0], nx = b.st[1];
        if (nloc == 0u) { xcd_barrier_complete(bar, b.x, nloc, nx); b.st[0] = nloc; b.st[1] = nx; }
        const unsigned old = xb_add(&bar[XB_XSUB(b.x)], 1u);
        const unsigned gen = old / nloc;
        if (old + 1u == (gen + 1u) * nloc) {
            __builtin_amdgcn_fence(__ATOMIC_RELEASE, "agent");
            asm volatile("s_waitcnt vmcnt(0)" ::: "memory");
            const unsigned og = xb_add(&bar[XB_TOP], 1u);
            const unsigned tg = og / nx;
            if (og + 1u == (tg + 1u) * nx) xb_add(&bar[XB_TOPGEN], 1u);
            else XB_SPIN(xb_ld(&bar[XB_TOPGEN]) == tg, bar);
            __builtin_amdgcn_fence(__ATOMIC_ACQUIRE, "agent");
            xb_add(&bar[XB_XGEN(b.x)], 1u);
            asm volatile("s_waitcnt vmcnt(0)" ::: "memory");
        } else {
            XB_SPIN(xb_ld(&bar[XB_XGEN(b.x)]) == gen, bar);
            __builtin_amdgcn_fence(__ATOMIC_ACQUIRE, "agent");
            asm volatile("s_waitcnt vmcnt(0)" ::: "memory");
        }
    }
    __syncthreads();
}
namespace epi {
using pg8::Unit; using pg8::f32x4; using pg8::u32x4; using pg8::bf16_t; using pg8::HALF; using pg8::BM;
#define EPI_ST16(base, off, val) (*(u32x4*)((char*)(base) + (unsigned)(off)) = (val))
#define EPI_ST8F(base, off, a, b) do { v2u w_; w_.x = pk_fp8x4((a)[0], (a)[1], (a)[2], (a)[3]); w_.y = pk_fp8x4((b)[0], (b)[1], (b)[2], (b)[3]); *(v2u*)((char*)(base) + (unsigned)(off)) = w_; } while (0)
__device__ __forceinline__ float fused_rstd(const float* ssp, int row) {
    const f32x4* p = (const f32x4*)(ssp + (size_t)row * 16); const f32x4 a = p[0], b = p[1], c = p[2], d = p[3];
    const float ss = ((a[0] + a[1]) + (a[2] + a[3])) + ((b[0] + b[1]) + (b[2] + b[3])) + ((c[0] + c[1]) + (c[2] + c[3])) + ((d[0] + d[1]) + (d[2] + d[3]));
    return 1.0f / sqrtf(ss * (1.0f / DM) + EPS);
}
struct EpiMixIn {
    static constexpr bool PERM = true;
    bf16_t *AG, *UG, *VG;
    __device__ __forceinline__ void operator()(const f32x4 (&acc)[2][2][4][2], const Unit& u, int wr, int wc, int fr, int fq) const {
        const int cw = wc * 32 + 8 * fq;
        if (u.pn < 4) {
            char* tb = (char*)(AG + (size_t)u.pm * (BM * ACH)); const unsigned lo = (unsigned)((wr * 64 + fr) * ACH + u.pn * 128 + cw) * 2u;
#pragma unroll
            for (int ai = 0; ai < 2; ++ai)
#pragma unroll
                for (int m = 0; m < 4; ++m) { f32x4 o0, o1;
#pragma unroll
                    for (int e = 0; e < 4; ++e) { o0[e] = acc[ai][0][m][0][e] * fsigmoid(acc[ai][1][m][0][e]); o1[e] = acc[ai][0][m][1][e] * fsigmoid(acc[ai][1][m][1][e]); }
                    EPI_ST16(tb + (ai * HALF + m * 16) * ACH * 2, lo, pack8(o0, o1)); }
        } else {
            char* tb = (char*)(((u.pn < 6) ? UG : VG) + (size_t)u.pm * (BM * BCH)); const unsigned lo = (unsigned)((wr * 64 + fr) * BCH + (u.pn & 1) * 256 + cw) * 2u;
#pragma unroll
            for (int ai = 0; ai < 2; ++ai)
#pragma unroll
                for (int m = 0; m < 4; ++m)
#pragma unroll
                    for (int bj = 0; bj < 2; ++bj) { f32x4 o0, o1;
#pragma unroll
                        for (int e = 0; e < 4; ++e) { o0[e] = fgelu(acc[ai][bj][m][0][e]); o1[e] = fgelu(acc[ai][bj][m][1][e]); }
                        EPI_ST16(tb + ((ai * HALF + m * 16) * BCH + bj * HALF) * 2, lo, pack8(o0, o1)); }
        }
    }
};
struct EpiSwiGlu {
    static constexpr bool PERM = true;
    bf16_t* O; int ldc, npn;
    __device__ __forceinline__ void operator()(const f32x4 (&acc)[2][2][4][2], const Unit& u, int wr, int wc, int fr, int fq) const {
        char* tb = (char*)(O + (size_t)u.pm * BM * ldc); const unsigned lo = (unsigned)((wr * 64 + fr) * ldc + (u.pn % npn) * 128 + wc * 32 + 8 * fq) * 2u;
#pragma unroll
        for (int ai = 0; ai < 2; ++ai)
#pragma unroll
            for (int m = 0; m < 4; ++m) { f32x4 o0, o1;
#pragma unroll
                for (int e = 0; e < 4; ++e) { o0[e] = fsilu(acc[ai][0][m][0][e]) * acc[ai][1][m][0][e]; o1[e] = fsilu(acc[ai][0][m][1][e]) * acc[ai][1][m][1][e]; }
                EPI_ST16(tb + (size_t)(ai * HALF + m * 16) * ldc * 2, lo, pack8(o0, o1)); }
    }
};
struct EpiSwiGluF8 {
    static constexpr bool PERM = true;
    unsigned char* O; int ldc, npn; const float* ssp; const float* bias;
    __device__ __forceinline__ void operator()(const f32x4 (&acc)[2][2][4][2], const Unit& u, int wr, int wc, int fr, int fq) const {
        char* tb = (char*)(O + (size_t)u.pm * BM * ldc); const unsigned lo = (unsigned)((wr * 64 + fr) * ldc + (u.pn % npn) * 128 + wc * 32 + 8 * fq);
        f32x4 bv[2][2];
        if (ssp) { const int bi = u.pm < NLAT / BM ? (u.pm >> 4) : 8; const float* bp = bias + (size_t)bi * (2 * ldc) + u.pn * BM + wc * 32 + 8 * fq;
#pragma unroll
            for (int bj = 0; bj < 2; ++bj) { bv[bj][0] = *(const f32x4*)(bp + bj * HALF); bv[bj][1] = *(const f32x4*)(bp + bj * HALF + 4); } }
        float rr[2][4];
        if (ssp) { asm volatile("" ::: "memory");
#pragma unroll
            for (int ai = 0; ai < 2; ++ai)
#pragma unroll
                for (int m = 0; m < 4; ++m) rr[ai][m] = fused_rstd(ssp, u.pm * BM + wr * 64 + fr + ai * HALF + m * 16);
            asm volatile("" ::: "memory"); }
#pragma unroll
        for (int ai = 0; ai < 2; ++ai)
#pragma unroll
            for (int m = 0; m < 4; ++m) { f32x4 a0 = acc[ai][0][m][0], a1 = acc[ai][0][m][1], b0 = acc[ai][1][m][0], b1 = acc[ai][1][m][1];
                if (ssp) { const float r = rr[ai][m]; a0 = a0 * r + bv[0][0]; a1 = a1 * r + bv[0][1]; b0 = b0 * r + bv[1][0]; b1 = b1 * r + bv[1][1]; }
                f32x4 o0, o1;
#pragma unroll
                for (int e = 0; e < 4; ++e) { o0[e] = fsilu(a0[e]) * b0[e]; o1[e] = fsilu(a1[e]) * b1[e]; }
                v2u w; w.x = pk_fp8x4(o0[0], o0[1], o0[2], o0[3]); w.y = pk_fp8x4(o1[0], o1[1], o1[2], o1[3]);
                *(v2u*)(tb + (size_t)(ai * HALF + m * 16) * ldc + lo) = w; }
    }
};
struct EpiPlain {
    static constexpr bool PERM = true;
    bf16_t* O; int ldc; const float* ssp; const float* bias;
    __device__ __forceinline__ void operator()(const f32x4 (&acc)[2][2][4][2], const Unit& u, int wr, int wc, int fr, int fq) const {
        char* tb = (char*)(O + (size_t)u.pm * BM * ldc + u.pn * BM); const unsigned lo = (unsigned)((wr * 64 + fr) * ldc + wc * 32 + 8 * fq) * 2u;
        f32x4 bv[2][2];
        if (ssp) { const int bi = u.pm < NLAT / BM ? (u.pm >> 4) : 8; const float* bp = bias + (size_t)bi * ldc + u.pn * BM + wc * 32 + 8 * fq;
#pragma unroll
            for (int bj = 0; bj < 2; ++bj) { bv[bj][0] = *(const f32x4*)(bp + bj * HALF); bv[bj][1] = *(const f32x4*)(bp + bj * HALF + 4); } }
        float rr[2][4];
        if (ssp) { asm volatile("" ::: "memory");
#pragma unroll
            for (int ai = 0; ai < 2; ++ai)
#pragma unroll
                for (int m = 0; m < 4; ++m) rr[ai][m] = fused_rstd(ssp, u.pm * BM + wr * 64 + fr + ai * HALF + m * 16);
            asm volatile("" ::: "memory"); }
#pragma unroll
        for (int ai = 0; ai < 2; ++ai)
#pragma unroll
            for (int m = 0; m < 4; ++m) { const float r = ssp ? rr[ai][m] : 1.0f;
#pragma unroll
                for (int bj = 0; bj < 2; ++bj) { f32x4 v0 = acc[ai][bj][m][0], v1 = acc[ai][bj][m][1]; if (ssp) { v0 = v0 * r + bv[bj][0]; v1 = v1 * r + bv[bj][1]; }
                    EPI_ST16(tb + ((size_t)(ai * HALF + m * 16) * ldc + bj * HALF) * 2, lo, pack8(v0, v1)); } }
    }
};
struct EpiResid {
    static constexpr bool PERM = false;
    const float *srcL, *srcC; float *dstL, *dstC; const float* gate; float mul;
    bf16_t* Aout; const float* Gv; float* ssp;
    __device__ __forceinline__ void operator()(const f32x4 (&acc)[2][2][4][2], const Unit& u, int wr, int wc, int fr, int fq) const {
        const bool lat = u.pm < NLAT / BM; const int bi = lat ? (u.pm >> 4) : 8;
        const size_t tb = (size_t)(lat ? u.pm : u.pm - NLAT / BM) * (BM * DM) + u.pn * BM;
        const char* src = (const char*)((lat ? srcL : srcC) + tb); char* dst = (char*)((lat ? dstL : dstC) + tb); const float* gp = gate + bi * MODW + u.pn * BM;
        const unsigned lo = (unsigned)((wr * 64 + fr) * DM + wc * 32 + 4 * fq) * 4u, lg = (unsigned)(wc * 32 + 4 * fq) * 4u;
        const char* Gp = (const char*)(Gv + bi * DM + u.pn * BM);
        char* ab = (char*)(Aout + (size_t)u.pm * (BM * DM) + u.pn * BM); float* sp = ssp + (size_t)u.pm * (BM * 16) + u.pn * 4 + wc;
        if (!Aout) {
            f32x4 gv[2][2];
#pragma unroll
            for (int bj = 0; bj < 2; ++bj)
#pragma unroll
                for (int n = 0; n < 2; ++n) gv[bj][n] = *(const f32x4*)((const char*)gp + (bj * HALF + n * 16) * 4 + lg) * mul;
#pragma unroll
            for (int ai = 0; ai < 2; ++ai)
#pragma unroll
                for (int m = 0; m < 4; ++m) {
#pragma unroll
                    for (int bj = 0; bj < 2; ++bj)
#pragma unroll
                        for (int n = 0; n < 2; ++n) { const int co = ((ai * HALF + m * 16) * DM + bj * HALF + n * 16) * 4;
                            const f32x4 bs = *(const f32x4*)(src + co + lo); *(f32x4*)(dst + co + lo) = bs + gv[bj][n] * acc[ai][bj][m][n]; }
                    if (m & 1) asm volatile("" ::: "memory"); }
        } else { const unsigned lo2 = lo >> 1, spo = (unsigned)(wr * 64 + fr) * 64u;
            asm volatile("" ::: "memory");
            f32x4 gv[2][2], Gg[2][2];
#pragma unroll
            for (int bj = 0; bj < 2; ++bj)
#pragma unroll
                for (int n = 0; n < 2; ++n) { const int cg = (bj * HALF + n * 16) * 4; gv[bj][n] = *(const f32x4*)((const char*)gp + cg + lg) * mul; Gg[bj][n] = *(const f32x4*)(Gp + cg + lg); }
#pragma unroll
            for (int ai = 0; ai < 2; ++ai)
#pragma unroll
                for (int m = 0; m < 4; ++m) { float sq = 0.f;
#pragma unroll
                    for (int bj = 0; bj < 2; ++bj)
#pragma unroll
                        for (int n = 0; n < 2; ++n) { const int co = ((ai * HALF + m * 16) * DM + bj * HALF + n * 16) * 4;
                            const f32x4 bs = *(const f32x4*)(src + co + lo);
                            const f32x4 xn = bs + gv[bj][n] * acc[ai][bj][m][n]; *(f32x4*)(dst + co + lo) = xn;
                            const f32x4 a = xn * Gg[bj][n]; v2u w; w.x = cvt_pk_bf16(a[0], a[1]); w.y = cvt_pk_bf16(a[2], a[3]); *(v2u*)(ab + co / 2 + lo2) = w;
                            sq += (xn[0] * xn[0] + xn[1] * xn[1]) + (xn[2] * xn[2] + xn[3] * xn[3]); }
                    sq += lane_xor<16>(sq); unsigned a_ = __builtin_bit_cast(unsigned, sq), b_ = a_; asm volatile("s_nop 1\n\tv_permlane32_swap_b32 %0, %1\n\ts_nop 0" : "+v"(a_), "+v"(b_));
                    sq = __builtin_bit_cast(float, a_) + __builtin_bit_cast(float, b_);
                    if (fq == 0) *(float*)((char*)sp + (ai * HALF + m * 16) * 64 + spo) = sq;
                    if (m & 1) asm volatile("" ::: "memory"); }
        }
    }
};
struct EpiQ {
    static constexpr bool PERM = true;
    unsigned char* Q; const float* rope;
    __device__ __forceinline__ void operator()(const f32x4 (&acc)[2][2][4][2], const Unit& u, int wr, int wc, int fr, int fq) const {
        const int b = u.pm >> 4, t0 = (u.pm & 15) * BM, rl = wr * 64 + fr;
        if (u.pn < 4) {
#pragma unroll
            for (int bj = 0; bj < 2; ++bj) { char* tb = (char*)(Q + ((size_t)(b * NHEAD + 2 * u.pn + bj) * SEQ + t0) * QKD); const unsigned lo = (unsigned)(rl * QKD + wc * 32 + 8 * fq);
#pragma unroll
                for (int ai = 0; ai < 2; ++ai)
#pragma unroll
                    for (int m = 0; m < 4; ++m) EPI_ST8F(tb + (ai * HALF + m * 16) * QKD, lo, acc[ai][bj][m][0], acc[ai][bj][m][1]); }
        } else {
            const int h = 4 * (u.pn - 4) + wc, a = fq >> 1, f0 = 8 * (fq & 1);
            char* tb = (char*)(Q + ((size_t)(b * NHEAD + h) * SEQ + t0) * QKD + 128); const unsigned lo = (unsigned)(rl * QKD + a * 32 + f0);
#pragma unroll
            for (int ai = 0; ai < 2; ++ai)
#pragma unroll
                for (int m = 0; m < 4; ++m) { const int t = t0 + rl + ai * HALF + m * 16, pos = a ? (t & 63) : (t >> 6);
                    const char* cs = (const char*)rope + (unsigned)((pos * 16 + f0) * 8); f32x4 o1[2], o2[2];
#pragma unroll
                    for (int n = 0; n < 2; ++n) { const f32x4 c0 = *(const f32x4*)(cs + n * 32), c1 = *(const f32x4*)(cs + n * 32 + 16);
                        const f32x4 x1 = acc[ai][0][m][n], x2 = acc[ai][1][m][n];
                        o1[n][0] = x1[0] * c0[0] - x2[0] * c0[1]; o2[n][0] = x1[0] * c0[1] + x2[0] * c0[0];
                        o1[n][1] = x1[1] * c0[2] - x2[1] * c0[3]; o2[n][1] = x1[1] * c0[3] + x2[1] * c0[2];
                        o1[n][2] = x1[2] * c1[0] - x2[2] * c1[1]; o2[n][2] = x1[2] * c1[1] + x2[2] * c1[0];
                        o1[n][3] = x1[3] * c1[2] - x2[3] * c1[3]; o2[n][3] = x1[3] * c1[3] + x2[3] * c1[2]; }
                    EPI_ST8F(tb + (ai * HALF + m * 16) * QKD, lo, o1[0], o1[1]); EPI_ST8F(tb + (ai * HALF + m * 16) * QKD + 16, lo, o2[0], o2[1]);
                    asm volatile("" ::: "memory"); }
        }
    }
};
struct EpiKV {
    static constexpr bool PERM = true;
    unsigned char* KN; bf16_t* V;
    __device__ __forceinline__ void operator()(const f32x4 (&acc)[2][2][4][2], const Unit& u, int wr, int wc, int fr, int fq) const {
        const bool lat = u.pm < NLAT / BM; const int b = lat ? (u.pm >> 4) : (u.pm - NLAT / BM), key0 = lat ? CTXL + (u.pm & 15) * BM : 0;
        const size_t te = ((size_t)(b * NHEAD + u.pn) * SKV + key0) * VHD; char* kb = (char*)(KN + te); char* vb = (char*)(V + te);
        const unsigned lo = (unsigned)((wr * 64 + fr) * VHD + wc * 32 + 8 * fq);
#pragma unroll
        for (int ai = 0; ai < 2; ++ai)
#pragma unroll
            for (int m = 0; m < 4; ++m) { EPI_ST8F(kb + (ai * HALF + m * 16) * VHD, lo, acc[ai][0][m][0], acc[ai][0][m][1]); EPI_ST16(vb + (ai * HALF + m * 16) * VHD * 2, lo * 2u, pack8(acc[ai][1][m][0], acc[ai][1][m][1])); }
    }
};
struct EpiMoeDown {
    static constexpr bool PERM = true;
    bf16_t* Y; const unsigned* list; const LAS int* tab;
    __device__ __forceinline__ void operator()(const f32x4 (&acc)[2][2][4][2], const Unit& u, int wr, int wc, int fr, int fq) const {
        const int e = u.pn >> 2, pnl = u.pn & 3, cnt = tab[16 + e], s0 = (u.pm - tab[e]) * BM + wr * 64 + fr; const unsigned cb = (unsigned)(pnl * BM + wc * 32 + 8 * fq) * 2u;
        const char* lp = (const char*)(list + e * LIST_CAP);
#pragma unroll
        for (int ai = 0; ai < 2; ++ai)
#pragma unroll
            for (int m = 0; m < 4; ++m) { const int slot = s0 + ai * HALF + m * 16;
                if (slot < cnt) { const unsigned ent = *(const unsigned*)(lp + (unsigned)slot * 4u), ro = ent * (unsigned)(DM * 2) + cb;
#pragma unroll
                    for (int bj = 0; bj < 2; ++bj) EPI_ST16(Y, ro + bj * HALF * 2, pack8(acc[ai][bj][m][0], acc[ai][bj][m][1])); } }
    }
};
}
struct MoeOrder {
    pg8::StaticOrder so; int nN; const LAS int* tab; const unsigned* list; int tok0;
    __device__ __forceinline__ bool next(int i, pg8::Unit& u) const {
        if (!so.next(i, u)) return false;
        int e = 0;
#pragma unroll
        for (int k = 1; k < NEXP; ++k) e += (u.pm >= tab[k]) ? 1 : 0;
        u.pn += e * nN; return true;
    }
    __device__ __forceinline__ int arow(const pg8::Unit& u, int r) const {
        const int e = u.pn / nN, cnt = tab[16 + e], slot = (u.pm - tab[e]) * pg8::BM + r;
        const unsigned ent = list[e * LIST_CAP + (slot < cnt ? slot : 0)];
        return tok0 + (int)(ent >> 1);
    }
};
struct Args { const float* in[31]; float* out; unsigned char* ws; };
struct Frame {
    LAS unsigned char* lds; volatile LAS unsigned* MISC; gu32* ctl;
    int tid, lane, wave, vcu, G;
};
enum { I_X = 0, I_C, I_CTX, I_CCTX, I_WADA, I_BADA, I_NORMG, I_EWIN, I_CONVW, I_CONVB, I_LNAG, I_LNAB, I_LNVG, I_LNVB, I_WS, I_BS, I_EWOUT, I_FW1, I_FW3, I_FW2,
       I_OWIN, I_GQ, I_GKV, I_WUQ, I_WUKV, I_WO, I_ROUTER, I_XW1, I_XW3, I_XW2, I_FINALG };

struct MapId   { int off; __device__ __forceinline__ int operator()(int n) const { return off + n; } };
struct MapPair { int half; __device__ __forceinline__ int operator()(int n) const { return 256 * (n >> 7) + 128 * half + (n & 127); } };
struct MapMixIn { __device__ __forceinline__ int operator()(int n) const { if (n >= 1024) return n; const int j = n & 511, hf = n >> 9; return 256 * (j >> 7) + 128 * hf + (j & 127); } };
struct MapUq { __device__ __forceinline__ int operator()(int n) const { const int h = n / QKD, d = n - h * QKD; if (d < 128) return h * 128 + d;
    const int dd = d - 128, a = dd >> 5, p = (dd >> 4) & 1, f = dd & 15; return 1024 + 256 * (h >> 2) + 128 * p + (h & 3) * 32 + a * 16 + f; } };
template <class Map>
__device__ __forceinline__ void p0_transpose_item(const float* W, int K, int N, bf16* WT, const Map& map, LAS float* scr, int item, int lane) {
    const int nblk = N / 32, kb = item / nblk, nb = item - kb * nblk, k0 = 64 * kb, n0 = 32 * nb;
    float rg[32];
    const float* Wl = W + (size_t)(k0 + (lane >> 5)) * N + n0 + (lane & 31);
#pragma unroll
    for (int i = 0; i < 32; ++i) rg[i] = __builtin_nontemporal_load(Wl + (size_t)(2 * i) * N);
#pragma unroll
    for (int i = 0; i < 32; ++i) scr[(2 * i + (lane >> 5)) * 33 + (lane & 31)] = rg[i];
    LDS_WAIT(); asm volatile("" ::: "memory");
    const int c = lane & 7;
#pragma unroll
    for (int j = 0; j < 4; ++j) { const int n = (lane >> 3) + 8 * j; const LAS float* s = scr + (8 * c) * 33 + n;
        v4u o; o.x = cvt_pk_bf16(s[0 * 33], s[1 * 33]); o.y = cvt_pk_bf16(s[2 * 33], s[3 * 33]); o.z = cvt_pk_bf16(s[4 * 33], s[5 * 33]); o.w = cvt_pk_bf16(s[6 * 33], s[7 * 33]);
        *(GAS v4u*)(WT + (size_t)map(n0 + n) * K + k0 + 8 * c) = o; }
    LDS_WAIT(); asm volatile("" ::: "memory");
}
template <class Map>
__device__ __forceinline__ void p0_transpose_item_f8(const float* W, int K, int N, unsigned char* WT, const Map& map, float mul, LAS float* scr, int item, int lane) {
    const int nblk = N / 32, kb = item / nblk, nb = item - kb * nblk, k0 = 64 * kb, n0 = 32 * nb;
    float rg[32];
    const float* Wl = W + (size_t)(k0 + (lane >> 5)) * N + n0 + (lane & 31);
#pragma unroll
    for (int i = 0; i < 32; ++i) rg[i] = __builtin_nontemporal_load(Wl + (size_t)(2 * i) * N);
#pragma unroll
    for (int i = 0; i < 32; ++i) scr[(2 * i + (lane >> 5)) * 33 + (lane & 31)] = rg[i] * mul;
    LDS_WAIT(); asm volatile("" ::: "memory");
#pragma unroll
    for (int j = 0; j < 2; ++j) { const int idx = lane + 64 * j, n = idx >> 2, c = idx & 3; const LAS float* s = scr + (16 * c) * 33 + n;
        v4u o; o.x = pk_fp8x4(s[0 * 33], s[1 * 33], s[2 * 33], s[3 * 33]); o.y = pk_fp8x4(s[4 * 33], s[5 * 33], s[6 * 33], s[7 * 33]);
        o.z = pk_fp8x4(s[8 * 33], s[9 * 33], s[10 * 33], s[11 * 33]); o.w = pk_fp8x4(s[12 * 33], s[13 * 33], s[14 * 33], s[15 * 33]);
        *(GAS v4u*)(WT + (size_t)map(n0 + n) * K + k0 + 16 * c) = o; }
    LDS_WAIT(); asm volatile("" ::: "memory");
}
__device__ __forceinline__ void sincos_d(double th, float& c, float& s) {
    const double q = __builtin_rint(th * 0.63661977236758134308); const int n = (int)q;
    const double r = (th - q * 1.5707963267948966192) - q * 6.123233995736766036e-17, r2 = r * r;
    double sp = -7.6471637318198164759e-13; sp = sp * r2 + 1.6059043836821614599e-10; sp = sp * r2 - 2.5052108385441718775e-08; sp = sp * r2 + 2.7557319223985890653e-06;
    sp = sp * r2 - 1.9841269841269841253e-04; sp = sp * r2 + 8.3333333333333332177e-03; sp = sp * r2 - 1.6666666666666665741e-01; const double sr = r + r * r2 * sp;
    double cp = 4.7794773323873852974e-14; cp = cp * r2 - 1.1470745597729724714e-11; cp = cp * r2 + 2.0876756987868098979e-09; cp = cp * r2 - 2.7557319223985888e-07;
    cp = cp * r2 + 2.4801587301587301566e-05; cp = cp * r2 - 1.3888888888888889419e-03; cp = cp * r2 + 4.1666666666666664354e-02; const double cr = 1.0 - 0.5 * r2 + r2 * r2 * cp;
    const int k = n & 3; const double sv = (k == 0) ? sr : (k == 1) ? cr : (k == 2) ? -sr : -cr, cv = (k == 0) ? cr : (k == 1) ? -sr : (k == 2) ? -cr : sr;
    c = (float)cv; s = (float)sv;
}
__device__ __forceinline__ double inv_freq_d(int f) {
    const int q = f >> 2, r = f & 3; const double rr = (r == 0) ? 1.0 : (r == 1) ? 0.5623413251903491 : (r == 2) ? 0.31622776601683794 : 0.1778279410038923;
    const double qq = (q == 0) ? 1.0 : (q == 1) ? 0.1 : (q == 2) ? 0.01 : 0.001; return rr * qq;
}
template <int PART>
__device__ __forceinline__ void p0_prologue(Frame& F, const Args& A) {
    unsigned char* ws = A.ws;
    __syncthreads();
    if constexpr (PART == 0) {
    for (int rep_ = 0; rep_ < (((DUPMASK >> 24) & 1u) ? 2 : 1); ++rep_) {
        __syncthreads();
        LAS float* sv = (LAS float*)(F.lds + RING_OFF);
        LAS float* part = (LAS float*)(F.lds + RING_OFF + 9 * 1024 * 4);
        for (int i = F.tid; i < 9 * DM; i += NWAVES * 64) { const float v = (i < 8 * DM) ? A.in[I_C][i] : A.in[I_CCTX][i - 8 * DM]; sv[i] = fsilu(v); }
        __syncthreads();
        float* mod = (float*)(ws + WS_MOD);
        for (int it = F.vcu; it < 2 * MODW / 48; it += F.G) {
            const int l = it / (MODW / 48), j0 = (it - l * (MODW / 48)) * 48;
            const float* W = A.in[I_WADA] + (size_t)l * DM * MODW;
            if (F.tid < 480) { const int cc = F.tid % 48, ks = F.tid / 48, kbeg = ks * 103, kend = (kbeg + 103 < DM) ? kbeg + 103 : DM;
                float a[9];
#pragma unroll
                for (int b = 0; b < 9; ++b) a[b] = 0.f;
#pragma unroll 1
                for (int k8 = kbeg; k8 < kend; k8 += 13) { float w[13];
#pragma unroll
                    for (int i = 0; i < 13; ++i) w[i] = (k8 + i < kend) ? W[(size_t)(k8 + i) * MODW + j0 + cc] : 0.f;
#pragma unroll
                    for (int i = 0; i < 13; ++i) { const int k = (k8 + i < kend) ? k8 + i : kbeg;
#pragma unroll
                        for (int b = 0; b < 9; ++b) a[b] += sv[b * DM + k] * w[i]; } }
#pragma unroll
                for (int b = 0; b < 9; ++b) part[(ks * 9 + b) * 48 + cc] = a[b]; }
            __syncthreads();
            if (F.tid < 9 * 48) { const int b = F.tid / 48, cc = F.tid % 48; float s = A.in[I_BADA][l * MODW + j0 + cc];
#pragma unroll
                for (int ks = 0; ks < 10; ++ks) s += part[(ks * 9 + b) * 48 + cc];
                mod[(size_t)(l * 9 + b) * MODW + j0 + cc] = s; }
            __syncthreads();
        }
    }
    if (F.vcu == 0) for (int i = F.tid; i < 64 * 16; i += NWAVES * 64) { float c, s; sincos_d((double)(i >> 4) * inv_freq_d(i & 15), c, s); ((float*)(ws + WS_ROPE))[2 * i] = c; ((float*)(ws + WS_ROPE))[2 * i + 1] = s; }
    { const int gt = F.vcu * NWAVES * 64 + F.tid, NT = F.G * NWAVES * 64;
      for (int i = gt; i < NEXP * CHUNK * CHUNK / 4; i += NT) { const f32x4 v = ((const f32x4*)A.in[I_WS])[i]; v2u o; o.x = cvt_pk_bf16(v[0], v[1]); o.y = cvt_pk_bf16(v[2], v[3]); ((v2u*)(ws + WS_WSB))[i] = o; }
      for (int i = gt; i < (INO_PAD - INO) * DM * (ATT_FP8 ? 1 : 2) / 16; i += NT) ((v4u*)(ws + WS_WINO + (size_t)INO * DM * (ATT_FP8 ? 1 : 2)))[i] = (v4u){0u, 0u, 0u, 0u}; }
    __syncthreads();
    }
    LAS float* scr = (LAS float*)(F.lds + RING_OFF + F.wave * 16384);
    const int gw = F.vcu * NWAVES + F.wave, NGW = F.G * NWAVES;
#define ITEMS(K_, N_) (((K_) / 64) * ((N_) / 32))
    constexpr int I_1 = ITEMS(DM, 2048), I_2 = ITEMS(DM, DM), I_3 = ITEMS(DM, DFF), I_4 = ITEMS(DFF, DM), I_5 = ITEMS(DM, INO), I_6 = ITEMS(QRANK, 1536), I_7 = ITEMS(KVRANK, 2048), I_8 = ITEMS(DM, DM);
    constexpr int I_E1 = ITEMS(DM, DEXP), I_E2 = ITEMS(DEXP, DM);
    constexpr int NSMALL = I_1 + I_2 + 2 * I_3 + I_4 + I_5 + I_6 + I_7 + I_8, NITEMS = NSMALL + NEXP * (2 * I_E1 + I_E2);
    constexpr int IT_LO = PART == 0 ? 0 : NSMALL, IT_HI = PART == 0 ? NSMALL : NITEMS;
    for (int rep_ = 0; rep_ < (((DUPMASK >> 25) & 1u) ? 2 : 1); ++rep_)
    for (int it = IT_LO + gw; it < IT_HI; it += NGW) {
        int r = it;
        if (r < I_1) { p0_transpose_item(A.in[I_EWIN], DM, 2048, (bf16*)(ws + WS_WIN), MapMixIn{}, scr, r, F.lane); continue; } r -= I_1;
        if (r < I_2) { p0_transpose_item(A.in[I_EWOUT], DM, DM, (bf16*)(ws + WS_WOUT), MapId{0}, scr, r, F.lane); continue; } r -= I_2;
        if (r < I_3) { if (FFN_FP8 == 1 || FFN_FP8 == 3) p0_transpose_item_f8(A.in[I_FW1], DM, DFF, ws + WS_W13, MapPair{0}, 32.0f, scr, r, F.lane); else p0_transpose_item(A.in[I_FW1], DM, DFF, (bf16*)(ws + WS_W13), MapPair{0}, scr, r, F.lane); continue; } r -= I_3;
        if (r < I_3) { if (FFN_FP8 == 1 || FFN_FP8 == 3) p0_transpose_item_f8(A.in[I_FW3], DM, DFF, ws + WS_W13, MapPair{1}, 32.0f, scr, r, F.lane); else p0_transpose_item(A.in[I_FW3], DM, DFF, (bf16*)(ws + WS_W13), MapPair{1}, scr, r, F.lane); continue; } r -= I_3;
        if (r < I_4) { if (FFN_FP8 == 1 || FFN_FP8 == 2) p0_transpose_item_f8(A.in[I_FW2], DFF, DM, ws + WS_W2, MapId{0}, 64.0f, scr, r, F.lane); else p0_transpose_item(A.in[I_FW2], DFF, DM, (bf16*)(ws + WS_W2), MapId{0}, scr, r, F.lane); continue; } r -= I_4;
        if (r < I_5) { if (ATT_FP8) p0_transpose_item_f8(A.in[I_OWIN], DM, INO, ws + WS_WINO, MapId{0}, 32.0f, scr, r, F.lane); else p0_transpose_item(A.in[I_OWIN], DM, INO, (bf16*)(ws + WS_WINO), MapId{0}, scr, r, F.lane); continue; } r -= I_5;
        if (r < I_6) { p0_transpose_item(A.in[I_WUQ], QRANK, 1536, (bf16*)(ws + WS_WUQ), MapUq{}, scr, r, F.lane); continue; } r -= I_6;
        if (r < I_7) { p0_transpose_item(A.in[I_WUKV], KVRANK, 2048, (bf16*)(ws + WS_WUKV), MapId{0}, scr, r, F.lane); continue; } r -= I_7;
        if (r < I_8) { if (ATT_FP8) p0_transpose_item_f8(A.in[I_WO], DM, DM, ws + WS_WO, MapId{0}, 32.0f, scr, r, F.lane); else p0_transpose_item(A.in[I_WO], DM, DM, (bf16*)(ws + WS_WO), MapId{0}, scr, r, F.lane); continue; } r -= I_8;
        { const int per = 2 * I_E1 + I_E2, e = r / per; r -= e * per;
          if (r < I_E1) { p0_transpose_item_f8(A.in[I_XW1] + (size_t)e * DM * DEXP, DM, DEXP, ws + WS_EW13 + (size_t)e * 2 * DEXP * DM, MapPair{0}, 32.0f, scr, r, F.lane); continue; } r -= I_E1;
          if (r < I_E1) { p0_transpose_item_f8(A.in[I_XW3] + (size_t)e * DM * DEXP, DM, DEXP, ws + WS_EW13 + (size_t)e * 2 * DEXP * DM, MapPair{1}, 32.0f, scr, r, F.lane); continue; } r -= I_E1;
          p0_transpose_item_f8(A.in[I_XW2] + (size_t)e * DEXP * DM, DEXP, DM, ws + WS_EW2 + (size_t)e * DM * DEXP, MapId{0}, 64.0f, scr, r, F.lane); }
    }
#undef ITEMS
}

template <bool ROUTE, bool OUT8 = ROUTE>
__device__ __forceinline__ void norm_phase(Frame& F, const Args& A, const float* srcL, const float* srcC, int nrows, const float* g, const float* modl, int shift_slot, bf16* H) {
    LAS float* rt = (LAS float*)(F.lds + RING_OFF);
    if constexpr (ROUTE) { for (int i = F.tid; i < DM * NEXP; i += NWAVES * 64) { const int k = i >> 3, e = i & 7; rt[e * DM + k] = A.in[I_ROUTER][i]; } __syncthreads(); }
    const int gw = F.vcu * NWAVES + F.wave, NGW = F.G * NWAVES;
    for (int row = gw; row < nrows; row += NGW) {
        const bool lat = row < NLAT; const float* src = lat ? srcL + (size_t)row * DM : srcC + (size_t)(row - NLAT) * DM; const int bi = lat ? (row >> 12) : 8;
        const float* sh = modl + bi * MODW + shift_slot * DM; const float* sc = sh + DM;
        f32x4 v[4]; float ss = 0.f;
#pragma unroll
        for (int j = 0; j < 4; ++j) { v[j] = ((const f32x4*)src)[F.lane + 64 * j]; ss += (v[j][0] * v[j][0] + v[j][1] * v[j][1]) + (v[j][2] * v[j][2] + v[j][3] * v[j][3]); }
        const float r = 1.0f / sqrtf(wave_sum(ss) * (1.0f / DM) + EPS);
        float lg[NEXP];
        if constexpr (ROUTE) {
#pragma unroll
            for (int e = 0; e < NEXP; ++e) lg[e] = 0.f; }
#pragma unroll
        for (int j = 0; j < 4; ++j) { const int c = 4 * F.lane + 256 * j; const f32x4 gv = *(const f32x4*)(g + c), s1 = *(const f32x4*)(sc + c), s0 = *(const f32x4*)(sh + c);
            const f32x4 y = (v[j] * r) * gv * (s1 + 1.0f) + s0;
            if constexpr (ROUTE) {
#pragma unroll
                for (int e = 0; e < NEXP; ++e) { const f32x4 w = *(const LAS f32x4*)(rt + e * DM + c); lg[e] += (y[0] * w[0] + y[1] * w[1]) + (y[2] * w[2] + y[3] * w[3]); } }
            if constexpr (OUT8) { *(unsigned*)((unsigned char*)H + (size_t)row * DM + c) = pk_fp8x4(y[0], y[1], y[2], y[3]); }
            else { v2u o; o.x = cvt_pk_bf16(y[0], y[1]); o.y = cvt_pk_bf16(y[2], y[3]); *(v2u*)(H + (size_t)row * DM + c) = o; } }
        if constexpr (ROUTE) {
#pragma unroll
            for (int e = 0; e < NEXP; ++e) lg[e] = wave_sum(lg[e]);
            int i0 = 0; float v0 = lg[0];
#pragma unroll
            for (int e = 1; e < NEXP; ++e) if (lg[e] > v0) { v0 = lg[e]; i0 = e; }
            int i1 = -1; float v1 = -3.0e38f;
#pragma unroll
            for (int e = 0; e < NEXP; ++e) if (e != i0 && lg[e] > v1) { v1 = lg[e]; i1 = e; }
            if (F.lane == 0) {
                const float ex = __expf(v1 - v0), g0 = 1.0f / (1.0f + ex), g1 = ex * g0;
                unsigned* list = (unsigned*)(A.ws + WS_LIST);
                const unsigned p0 = __hip_atomic_fetch_add((unsigned*)F.ctl + CW_CNT + 64 * i0, 1u, RLX_AGENT);
                const unsigned p1 = __hip_atomic_fetch_add((unsigned*)F.ctl + CW_CNT + 64 * i1, 1u, RLX_AGENT);
                list[i0 * LIST_CAP + p0] = (unsigned)row * 2u; list[i1 * LIST_CAP + p1] = (unsigned)row * 2u + 1u;
                *(f32x2*)(A.ws + WS_TOKG + (size_t)row * 8) = (f32x2){g0, g1};
            }
        }
    }
}

__device__ __forceinline__ void fuse_prep(Frame& F, const Args& A, const float* mod0, const float* mod1) {
    float* GV = (float*)(A.ws + WS_GV); float* B13 = (float*)(A.ws + WS_B13); float* BZ = (float*)(A.ws + WS_BZ);
    for (int i = F.vcu * NWAVES * 64 + F.tid; i < 2 * 9 * DM; i += F.G * NWAVES * 64) { const int l = i / (9 * DM), r = i - l * 9 * DM, bi = r >> 10, k = r & (DM - 1);
        GV[i] = l == 0 ? A.in[I_NORMG][1 * DM + k] * (1.0f + mod0[bi * MODW + 4 * DM + k]) : A.in[I_NORMG][2 * DM + k] * (1.0f + mod1[bi * MODW + 1 * DM + k]); }
    const int gw = F.vcu * NWAVES + F.wave, NGW = F.G * NWAVES;
    for (int n = gw; n < 2 * DFF + INO_PAD; n += NGW) { const bool z = n >= 2 * DFF; const int nn = z ? n - 2 * DFF : n;
        const bf16* wrow = (const bf16*)(A.ws + (z ? WS_WINO : WS_W13)) + (size_t)nn * DM + 16 * F.lane; const float* sh = z ? mod1 + 0 * DM : mod0 + 3 * DM;
        const v4u w0 = *(const v4u*)wrow, w1 = *(const v4u*)(wrow + 8); float wf[16];
#pragma unroll
        for (int e = 0; e < 4; ++e) { wf[2 * e] = bf_lo(w0[e]); wf[2 * e + 1] = bf_hi(w0[e]); wf[8 + 2 * e] = bf_lo(w1[e]); wf[8 + 2 * e + 1] = bf_hi(w1[e]); }
        float a9[9];
#pragma unroll
        for (int bi = 0; bi < 9; ++bi) { const float* sp = sh + bi * MODW + 16 * F.lane; float a = 0.f;
#pragma unroll
            for (int e = 0; e < 16; ++e) a += wf[e] * sp[e];
            a9[bi] = a; }
#pragma unroll
        for (int bi = 0; bi < 9; ++bi) { const float a = wave_sum(a9[bi]); if (F.lane == 0) { if (z) BZ[bi * INO_PAD + nn] = a; else B13[bi * (2 * DFF) + nn] = a; } } }
}

__device__ __forceinline__ void mixmid_conv(Frame& F, const Args& A, int ch, int hf, const bf16* AG, bf16* A2) {
    const int R0 = ch * CHUNK + hf * 64;
    int s_lo, s_hi; if (R0 < NLAT) { s_lo = R0 & ~(SEQ - 1); s_hi = s_lo + SEQ; } else { s_lo = NLAT + ((R0 - NLAT) & ~(CTXL - 1)); s_hi = s_lo + CTXL; }
    const int p = (F.wave & 3) * 64 + F.lane, gq = F.wave >> 2;
    LAS float* red = (LAS float*)(F.lds + RING_OFF);
    float w0[CONVK], w1[CONVK];
#pragma unroll
    for (int k = 0; k < CONVK; ++k) { const f32x2 w = *(const f32x2*)(A.in[I_CONVW] + k * ACH + 2 * p); w0[k] = w[0]; w1[k] = w[1]; }
    const f32x2 cb = *(const f32x2*)(A.in[I_CONVB] + 2 * p), lg = *(const f32x2*)(A.in[I_LNAG] + 2 * p), lb = *(const f32x2*)(A.in[I_LNAB] + 2 * p);
#pragma unroll 1
    for (int it = 0; it < 4; ++it) {
        const int t0 = R0 + 8 * (gq + 2 * it);
        float o0[8], o1[8];
#pragma unroll
        for (int t = 0; t < 8; ++t) { o0[t] = cb[0]; o1[t] = cb[1]; }
        unsigned win[38];
#pragma unroll
        for (int i = 0; i < 38; ++i) { const int rr = t0 - 15 + i; win[i] = (rr >= s_lo && rr < s_hi) ? *(const unsigned*)((const char*)(AG + (size_t)rr * ACH) + 4 * p) : 0u; }
#pragma unroll
        for (int i = 0; i < 38; ++i) { const float x0 = bf_lo(win[i]), x1 = bf_hi(win[i]);
#pragma unroll
            for (int t = 0; t < 8; ++t) { const int k = i - t; if (k >= 0 && k < CONVK) { o0[t] += w0[k] * x0; o1[t] += w1[k] * x1; } } }
        LAS float* rd = red + ((it & 1) * 2 + gq) * (4 * 8 * 2);
#pragma unroll
        for (int t = 0; t < 8; ++t) { const float s = wave_sum(o0[t] + o1[t]), q = wave_sum(o0[t] * o0[t] + o1[t] * o1[t]);
            if (F.lane == 0) { rd[((F.wave & 3) * 8 + t) * 2] = s; rd[((F.wave & 3) * 8 + t) * 2 + 1] = q; } }
        __syncthreads();
#pragma unroll
        for (int t = 0; t < 8; ++t) { float s = 0.f, q = 0.f;
#pragma unroll
            for (int w = 0; w < 4; ++w) { s += rd[(w * 8 + t) * 2]; q += rd[(w * 8 + t) * 2 + 1]; }
            const float mu = s * (1.0f / ACH); float var = q * (1.0f / ACH) - mu * mu; var = var > 0.f ? var : 0.f; const float rs = 1.0f / sqrtf(var + EPS);
            const float y0 = (o0[t] - mu) * rs * lg[0] + lb[0], y1 = (o1[t] - mu) * rs * lg[1] + lb[1];
            *(unsigned*)((char*)(A2 + (size_t)(t0 + t) * DM) + 4 * p) = (DROPMASK & 16) ? 0u : cvt_pk_bf16(fsilu(y0), fsilu(y1)); }
    }
    __syncthreads();
}
__device__ __forceinline__ void mixmid_gmlp(Frame& F, const Args& A, int ch, int hg, const bf16* UG, const bf16* VG, const bf16* WSB, bf16* A2) {
    const int R0 = ch * CHUNK;
    LAS f32x2* st = (LAS f32x2*)(F.lds + RING_OFF);
    LAS bf16* vnT = (LAS bf16*)(F.lds + RING_OFF + 1024);
    constexpr int VP = 136;
    { v4u xs[16];
#pragma unroll
      for (int i = 0; i < 16; ++i) xs[i] = *(const v4u*)((const char*)(VG + (size_t)(R0 + F.wave * 16 + i) * BCH) + 16 * F.lane);
#pragma unroll
      for (int i = 0; i < 16; ++i) { const int j = F.wave * 16 + i; float s = 0.f, q = 0.f;
#pragma unroll
        for (int e = 0; e < 4; ++e) { const float a = bf_lo(xs[i][e]), b = bf_hi(xs[i][e]); s += a + b; q += a * a + b * b; }
        s = wave_sum(s); q = wave_sum(q); const float mu = s * (1.0f / BCH); float var = q * (1.0f / BCH) - mu * mu; var = var > 0.f ? var : 0.f;
        if (F.lane == 0) st[j] = (f32x2){mu, 1.0f / sqrtf(var + EPS)}; } }
    __syncthreads();
    { const int j = F.tid >> 2, cq = (F.tid & 3) * 16; const f32x2 ms = st[j];
#pragma unroll
      for (int hh = 0; hh < 4; ++hh) { const int c0 = (4 * hg + hh) * 64 + cq;
#pragma unroll
        for (int q = 0; q < 2; ++q) { const v4u x = *(const v4u*)(VG + (size_t)(R0 + j) * BCH + c0 + 8 * q);
#pragma unroll
            for (int e = 0; e < 4; ++e) { const int c = c0 + 8 * q + 2 * e; const f32x2 gg = *(const f32x2*)(A.in[I_LNVG] + c), bb = *(const f32x2*)(A.in[I_LNVB] + c);
                const float y0 = (bf_lo(x[e]) - ms[0]) * ms[1] * gg[0] + bb[0], y1 = (bf_hi(x[e]) - ms[0]) * ms[1] * gg[1] + bb[1];
                const unsigned pk = cvt_pk_bf16(y0, y1); const int d = cq + 8 * q + 2 * e;
                vnT[(hh * 64 + d) * VP + j] = (bf16)(pk & 0xffffu); vnT[(hh * 64 + d + 1) * VP + j] = (bf16)(pk >> 16); } } } }
    __syncthreads();
    { const int hh = F.wave >> 1, h = 4 * hg + hh, ib0 = (F.wave & 1) * 4, lr = F.lane & 15, lq = F.lane >> 4;
      f32x4 acc[4][4];
#pragma unroll
      for (int a = 0; a < 4; ++a)
#pragma unroll
          for (int b = 0; b < 4; ++b) acc[a][b] = (f32x4){0.f, 0.f, 0.f, 0.f};
#pragma unroll
      for (int kk = 0; kk < 4; ++kk) { bf16x8 wf[4], vf[4];
#pragma unroll
          for (int ib = 0; ib < 4; ++ib) wf[ib] = *(const bf16x8*)(WSB + ((size_t)h * CHUNK + (ib0 + ib) * 16 + lr) * CHUNK + kk * 32 + 8 * lq);
#pragma unroll
          for (int db = 0; db < 4; ++db) vf[db] = *(const LAS bf16x8*)(vnT + (hh * 64 + db * 16 + lr) * VP + kk * 32 + 8 * lq);
#pragma unroll
          for (int ib = 0; ib < 4; ++ib)
#pragma unroll
              for (int db = 0; db < 4; ++db) acc[ib][db] = __builtin_amdgcn_mfma_f32_16x16x32_bf16(vf[db], wf[ib], acc[ib][db], 0, 0, 0); }
#pragma unroll
      for (int ib = 0; ib < 4; ++ib) { const int i = (ib0 + ib) * 16 + lr; const float bsv = A.in[I_BS][h * CHUNK + i];
#pragma unroll
          for (int db = 0; db < 4; ++db) { const int c = h * 64 + db * 16 + 4 * lq; const v2u uu = *(const v2u*)(UG + (size_t)(R0 + i) * BCH + c);
              const f32x4 s = acc[ib][db] + bsv; v2u o; o.x = cvt_pk_bf16(bf_lo(uu.x) * s[0], bf_hi(uu.x) * s[1]); o.y = cvt_pk_bf16(bf_lo(uu.y) * s[2], bf_hi(uu.y) * s[3]);
              if (DROPMASK & 32) { o.x = 0u; o.y = 0u; }
              *(v2u*)(A2 + (size_t)(R0 + i) * DM + ACH + c) = o; } } }
    __syncthreads();
}
__device__ __forceinline__ void mixmid_phase(Frame& F, const Args& A, const bf16* AG, const bf16* UG, const bf16* VG, const bf16* WSB, bf16* A2) {
    constexpr int NU = (MALL / CHUNK) * 4;
    for (int u = F.vcu; u < NU; u += F.G) { const int part = u / (MALL / CHUNK), ch = u - part * (MALL / CHUNK);
#if !defined(MIX_ONLY) || MIX_ONLY == 1
        if (part < 2) mixmid_conv(F, A, ch, part, AG, A2);
#endif
#if !defined(MIX_ONLY) || MIX_ONLY == 2
        if (part >= 2) mixmid_gmlp(F, A, ch, part - 2, UG, VG, WSB, A2);
#endif
    }
}

__device__ __forceinline__ void zsplit_phase(Frame& F, const Args& A, const bf16* Z, bf16* QN, bf16* KVN, unsigned char* KPE, const float* rope) {
    const int gw = F.vcu * NWAVES + F.wave, NGW = F.G * NWAVES, l = F.lane;
    for (int row = gw; row < MALL; row += NGW) {
        const bf16* z = Z + (size_t)row * INO_PAD; float x[3][4];
#pragma unroll
        for (int j = 0; j < 3; ++j) { const v2u w = *(const v2u*)(z + 4 * l + 256 * j); x[j][0] = bf_lo(w.x); x[j][1] = bf_hi(w.x); x[j][2] = bf_lo(w.y); x[j][3] = bf_hi(w.y); }
        float q0 = 0.f, q1 = 0.f, q2 = 0.f;
#pragma unroll
        for (int e = 0; e < 4; ++e) { q0 += x[0][e] * x[0][e]; q1 += x[1][e] * x[1][e]; q2 += x[2][e] * x[2][e]; }
        const float sq = wave_sum(q0 + (l < 32 ? q1 : 0.f)), skv = wave_sum((l >= 32 ? q1 : 0.f) + (l < 32 ? q2 : 0.f));
        const float rq = 1.0f / sqrtf(sq * (1.0f / QRANK) + EPS), rkv = 1.0f / sqrtf(skv * (1.0f / KVRANK) + EPS);
        const bool lat = row < NLAT;
        if (lat) { const f32x4 g0 = *(const f32x4*)(A.in[I_GQ] + 4 * l); v2u o; o.x = cvt_pk_bf16(x[0][0] * rq * g0[0], x[0][1] * rq * g0[1]); o.y = cvt_pk_bf16(x[0][2] * rq * g0[2], x[0][3] * rq * g0[3]);
            *(v2u*)(QN + (size_t)row * QRANK + 4 * l) = o;
            if (l < 32) { const f32x4 g1 = *(const f32x4*)(A.in[I_GQ] + 256 + 4 * l); v2u o1; o1.x = cvt_pk_bf16(x[1][0] * rq * g1[0], x[1][1] * rq * g1[1]); o1.y = cvt_pk_bf16(x[1][2] * rq * g1[2], x[1][3] * rq * g1[3]);
                *(v2u*)(QN + (size_t)row * QRANK + 256 + 4 * l) = o1; } }
        { const int jj = (l >= 32) ? 1 : 2, kc = (l >= 32) ? 4 * (l - 32) : 128 + 4 * l; const f32x4 gk = *(const f32x4*)(A.in[I_GKV] + kc);
          const float a0 = (jj == 1) ? x[1][0] : x[2][0], a1 = (jj == 1) ? x[1][1] : x[2][1], a2 = (jj == 1) ? x[1][2] : x[2][2], a3 = (jj == 1) ? x[1][3] : x[2][3];
          v2u o; o.x = cvt_pk_bf16(a0 * rkv * gk[0], a1 * rkv * gk[1]); o.y = cvt_pk_bf16(a2 * rkv * gk[2], a3 * rkv * gk[3]);
          *(v2u*)(KVN + (size_t)row * KVRANK + kc) = o; }
        float y[4];
#pragma unroll
        for (int e = 0; e < 4; ++e) y[e] = lane_xor<4>(x[2][e]);
        if (l >= 32 && l < 48) { const int m = l - 32; int b, key, t = 0;
            if (lat) { b = row >> 12; t = row & (SEQ - 1); key = CTXL + t; } else { const int rc = row - NLAT; b = rc >> 8; key = rc & (CTXL - 1); }
            float o[4];
            if (lat) { const int a = m >> 3, pp = (m >> 2) & 1, f0 = 4 * (m & 3), pos = a ? (t & 63) : (t >> 6);
#pragma unroll
                for (int e = 0; e < 4; ++e) { const f32x2 cs = *(const f32x2*)(rope + (pos * 16 + f0 + e) * 2); const float x1 = pp ? y[e] : x[2][e], x2 = pp ? x[2][e] : y[e];
                    o[e] = pp ? (x1 * cs[1] + x2 * cs[0]) : (x1 * cs[0] - x2 * cs[1]); } }
            else {
#pragma unroll
                for (int e = 0; e < 4; ++e) o[e] = x[2][e]; }
            *(unsigned*)(KPE + ((size_t)b * SKV + key) * ROPE + 4 * m) = pk_fp8x4(o[0], o[1], o[2], o[3]); }
    }
}

__device__ __forceinline__ void combine_phase(Frame& F, const Args& A, const bf16* Y, const float* mod1, float mul) {
    const int gw = F.vcu * NWAVES + F.wave, NGW = F.G * NWAVES;
    for (int tl = gw; tl < NLAT; tl += NGW) { const int row = tl, bi = row >> 12;
        float* xr = A.out + (size_t)row * DM; const float* gate = mod1 + bi * MODW + 5 * DM; const f32x2 gg = *(const f32x2*)(A.ws + WS_TOKG + (size_t)row * 8);
        const bf16* y0 = Y + (size_t)(2 * tl) * DM; const bf16* y1 = y0 + DM;
        f32x4 v[4]; float ss = 0.f;
#pragma unroll
        for (int j = 0; j < 4; ++j) { const int c = 4 * F.lane + 256 * j; const f32x4 x = *(const f32x4*)(xr + c), gt = *(const f32x4*)(gate + c); const v2u a = *(const v2u*)(y0 + c), b = *(const v2u*)(y1 + c);
            f32x4 m; m[0] = gg[0] * bf_lo(a.x) + gg[1] * bf_lo(b.x); m[1] = gg[0] * bf_hi(a.x) + gg[1] * bf_hi(b.x); m[2] = gg[0] * bf_lo(a.y) + gg[1] * bf_lo(b.y); m[3] = gg[0] * bf_hi(a.y) + gg[1] * bf_hi(b.y);
            v[j] = x + gt * m * mul; ss += (v[j][0] * v[j][0] + v[j][1] * v[j][1]) + (v[j][2] * v[j][2] + v[j][3] * v[j][3]); }
        const float r = 1.0f / sqrtf(wave_sum(ss) * (1.0f / DM) + EPS);
#pragma unroll
        for (int j = 0; j < 4; ++j) { const int c = 4 * F.lane + 256 * j; const f32x4 fg = *(const f32x4*)(A.in[I_FINALG] + c); *(f32x4*)(xr + c) = v[j] * r * fg; }
    }
}
#if SELFCHECK
namespace chk {
__device__ __forceinline__ float bff(bf16 v) { return __builtin_bit_cast(float, (unsigned)v << 16); }
__device__ __forceinline__ float bfr(float f) { unsigned u = __builtin_bit_cast(unsigned, f); u = (u + 0x7fffu + ((u >> 16) & 1u)) & 0xffff0000u; return __builtin_bit_cast(float, u); }
__device__ __forceinline__ unsigned hsh(unsigned x) { x ^= x >> 16; x *= 0x7feb352du; x ^= x >> 15; x *= 0x846ca68bu; x ^= x >> 16; return x; }
__device__ __forceinline__ float dot_w(const bf16* a, const float* W, int K, int N, int n) { float s = 0.f; for (int k = 0; k < K; ++k) s += bff(a[k]) * bfr(W[(size_t)k * N + n]); return s; }
__device__ __forceinline__ float f8f(unsigned char v) { return __builtin_amdgcn_cvt_f32_fp8((int)v, 0); }
__device__ __forceinline__ float f8r(float x) { const int w = __builtin_amdgcn_cvt_pk_fp8_f32(x, 0.f, 0, false); return __builtin_amdgcn_cvt_f32_fp8(w, 0); }
__device__ __forceinline__ float dot_w8(const unsigned char* a, const float* W, int K, int N, int n, float mul) { float s = 0.f; for (int k = 0; k < K; ++k) s += f8f(a[k]) * f8r(W[(size_t)k * N + n] * mul); return s / mul; }
__device__ __forceinline__ float sigm(float x) { return 1.0f / (1.0f + __expf(-x)); }
__device__ __forceinline__ float gelu_t(float x) { return 0.5f * x * (1.0f + tanhf(0.7978845608028654f * (x + 0.044715f * x * x * x))); }
__device__ __forceinline__ void report(unsigned* dbg, int k, float got, float ref, float rel, float abs_) {
    const float err = fabsf(got - ref); const bool bad = !(err <= rel * fabsf(ref) + abs_);
    atomicAdd(dbg + 64 * k + 1, 1u); if (bad) atomicAdd(dbg + 64 * k, 1u);
}
}
#define CHK_LOOP(NS) for (int s_ = (int)(blockIdx.x * 512 + F.tid); s_ < (NS); s_ += (int)(gridDim.x * 512))
#endif
#if SELFCHECK
constexpr int CW_DBG = 32768;
constexpr size_t WS_CAP = 3 * MiB + 512 * 1024;
namespace chk {
struct Ctx { const Args* A; unsigned char* ws; unsigned char* ar; unsigned* dbg; const float* mod; float* XC; };
#define CK_IN(i) (C.A->in[i])
__device__ __forceinline__ const float* xrow(const Ctx& C, const float* L, const float* Cx, int row) { return row < NLAT ? L + (size_t)row * DM : Cx + (size_t)(row - NLAT) * DM; }
__device__ __forceinline__ void c_mod(Frame& F, const Ctx& C) {
    CHK_LOOP(2048) { const unsigned h = hsh(s_); const int l = h & 1, bi = (h >> 1) % 9, j = (h >> 8) % MODW;
        const float* cv = bi < 8 ? CK_IN(I_C) + bi * DM : CK_IN(I_CCTX); float s = CK_IN(I_BADA)[l * MODW + j];
        for (int k = 0; k < DM; ++k) { const float c = cv[k]; s += (c * sigm(c)) * CK_IN(I_WADA)[((size_t)l * DM + k) * MODW + j]; }
        report(C.dbg, 0, C.mod[(size_t)(l * 9 + bi) * MODW + j], s, 2e-3f, 2e-3f); }
}
__device__ __forceinline__ void c_norm(Frame& F, const Ctx& C, int k, const float* L, const float* Cx, int nrows, const float* g, const float* modl, int slot, const bf16* H) {
    CHK_LOOP(2048) { const unsigned h = hsh(s_ + 7919u * k); const int row = h % nrows, col = (h >> 16) % DM; const float* x = xrow(C, L, Cx, row); const int bi = row < NLAT ? row >> 12 : 8;
        float ss = 0.f; for (int i = 0; i < DM; ++i) ss += x[i] * x[i];
        const float r = 1.0f / sqrtf(ss / DM + EPS), y = x[col] * r * g[col] * (1.0f + modl[bi * MODW + (slot + 1) * DM + col]) + modl[bi * MODW + slot * DM + col];
        report(C.dbg, row < NLAT ? k : k + 20, bff(H[(size_t)row * DM + col]), y, 0.01f, 0.01f); }
}
__device__ __forceinline__ void c_mixin(Frame& F, const Ctx& C, const bf16* H, const bf16* AG, const bf16* UG, const bf16* VG) {
    CHK_LOOP(2048) { const unsigned h = hsh(s_ + 111u); const int row = h % MALL, c = (h >> 16) % 1536; const bf16* a = H + (size_t)row * DM; const float* W = CK_IN(I_EWIN); float ref, got;
        if (c < 512) { ref = dot_w(a, W, DM, 2048, c) * sigm(dot_w(a, W, DM, 2048, 512 + c)); got = bff(AG[(size_t)row * ACH + c]); }
        else if (c < 1024) { ref = gelu_t(dot_w(a, W, DM, 2048, 512 + c)); got = bff(UG[(size_t)row * BCH + c - 512]); }
        else { ref = gelu_t(dot_w(a, W, DM, 2048, 512 + c)); got = bff(VG[(size_t)row * BCH + c - 1024]); }
        report(C.dbg, 2, got, ref, 0.02f, 0.02f); }
}
__device__ __forceinline__ void c_mixmid(Frame& F, const Ctx& C, const bf16* AG, const bf16* UG, const bf16* VG, const bf16* A2) {
    CHK_LOOP(512) { const unsigned h = hsh(s_ + 222u); const int row = h % MALL, c = (h >> 16) % DM; float ref;
        if (c < ACH) { int s_lo, s_hi; if (row < NLAT) { s_lo = row & ~(SEQ - 1); s_hi = s_lo + SEQ; } else { s_lo = NLAT + ((row - NLAT) & ~(CTXL - 1)); s_hi = s_lo + CTXL; }
            float s = 0.f, q = 0.f, vc = 0.f;
            for (int ch = 0; ch < ACH; ++ch) { float v = CK_IN(I_CONVB)[ch];
                for (int k = 0; k < CONVK; ++k) { const int rr = row + k - 15; if (rr >= s_lo && rr < s_hi) v += CK_IN(I_CONVW)[k * ACH + ch] * bff(AG[(size_t)rr * ACH + ch]); }
                s += v; q += v * v; if (ch == c) vc = v; }
            const float mu = s / ACH, var = q / ACH - mu * mu, y = (vc - mu) / sqrtf(var + EPS) * CK_IN(I_LNAG)[c] + CK_IN(I_LNAB)[c]; ref = y * sigm(y);
        } else { const int cc = c - ACH, hh = cc >> 6, R0 = row & ~(CHUNK - 1), i = row - R0; float sv = CK_IN(I_BS)[hh * CHUNK + i];
            for (int j = 0; j < CHUNK; ++j) { const bf16* vr = VG + (size_t)(R0 + j) * BCH; float s = 0.f, q = 0.f;
                for (int ch = 0; ch < BCH; ++ch) { const float v = bff(vr[ch]); s += v; q += v * v; }
                const float mu = s / BCH, var = q / BCH - mu * mu, vn = (bff(vr[cc]) - mu) / sqrtf(var + EPS) * CK_IN(I_LNVG)[cc] + CK_IN(I_LNVB)[cc];
                sv += bfr(CK_IN(I_WS)[((size_t)hh * CHUNK + i) * CHUNK + j]) * bfr(vn); }
            ref = bff(UG[(size_t)row * BCH + cc]) * sv; }
        report(C.dbg, 3, bff(A2[(size_t)row * DM + c]), ref, 0.02f, 0.02f); }
}
__device__ __forceinline__ void c_resid(Frame& F, const Ctx& C, int k, int nrows, const bf16* Ain, int K, const float* W, const float* gate, const float* baseL, const float* baseC, bool captured) {
    CHK_LOOP(2048) { const unsigned h = hsh(s_ + 333u * k); const int row = h % nrows, col = (h >> 16) % DM, bi = row < NLAT ? row >> 12 : 8;
        const float base = captured ? ((const float*)(C.ws + WS_CAP))[s_] : xrow(C, baseL, baseC, row)[col];
        const float ref = base + gate[bi * MODW + col] * dot_w(Ain + (size_t)row * K, W, K, DM, col), got = xrow(C, C.A->out, C.XC, row)[col];
        report(C.dbg, k, got, ref, 0.01f, 0.01f); }
}
__device__ __forceinline__ void c_capture(Frame& F, const Ctx& C, int k, int nrows) {
    CHK_LOOP(2048) { const unsigned h = hsh(s_ + 333u * k); const int row = h % nrows, col = (h >> 16) % DM; ((float*)(C.ws + WS_CAP))[s_] = xrow(C, C.A->out, C.XC, row)[col]; }
}
__device__ __forceinline__ void c_swiglu(Frame& F, const Ctx& C, const bf16* H, const bf16* ACT) {
    CHK_LOOP(2048) { const unsigned h = hsh(s_ + 444u); const int row = h % MALL, j = (h >> 16) % DFF; const bf16* a = H + (size_t)row * DM;
        const float p = dot_w(a, CK_IN(I_FW1), DM, DFF, j), q = dot_w(a, CK_IN(I_FW3), DM, DFF, j);
        report(C.dbg, 6, bff(ACT[(size_t)row * DFF + j]), p * sigm(p) * q, 0.02f, 0.02f); }
}
__device__ __forceinline__ void c_z(Frame& F, const Ctx& C, const bf16* H, const bf16* Z) {
    CHK_LOOP(2048) { const unsigned h = hsh(s_ + 555u); const int row = h % MALL, j = (h >> 16) % INO;
        report(C.dbg, 9, bff(Z[(size_t)row * INO_PAD + j]), dot_w(H + (size_t)row * DM, CK_IN(I_OWIN), DM, INO, j), 0.02f, 0.02f); }
}
__device__ __forceinline__ float rope_ref(float x1, float x2, int p, int a, int f, int t) {
    const int pos = a ? (t & 63) : (t >> 6); const float ang = (float)pos * powf(10000.0f, -(float)f / 16.0f), c = cosf(ang), s = sinf(ang);
    return p ? (x1 * s + x2 * c) : (x1 * c - x2 * s);
}
__device__ __forceinline__ void c_zsplit(Frame& F, const Ctx& C, const bf16* Z, const bf16* QN, const bf16* KVN, const unsigned char* KPE) {
    CHK_LOOP(3072) { const unsigned h = hsh(s_ + 666u); const int kind = s_ % 3; const bf16* z;
        if (kind == 0) { const int row = h % NLAT, c = (h >> 16) % QRANK; z = Z + (size_t)row * INO_PAD; float ss = 0.f; for (int i = 0; i < QRANK; ++i) ss += bff(z[i]) * bff(z[i]);
            report(C.dbg, 10, bff(QN[(size_t)row * QRANK + c]), bff(z[c]) / sqrtf(ss / QRANK + EPS) * CK_IN(I_GQ)[c], 0.01f, 0.01f); }
        else if (kind == 1) { const int row = h % MALL, c = (h >> 16) % KVRANK; z = Z + (size_t)row * INO_PAD; float ss = 0.f; for (int i = 0; i < KVRANK; ++i) ss += bff(z[QRANK + i]) * bff(z[QRANK + i]);
            report(C.dbg, 10, bff(KVN[(size_t)row * KVRANK + c]), bff(z[QRANK + c]) / sqrtf(ss / KVRANK + EPS) * CK_IN(I_GKV)[c], 0.01f, 0.01f); }
        else { const int row = h % MALL, dd = (h >> 16) % ROPE; z = Z + (size_t)row * INO_PAD + QRANK + KVRANK; int b, key; float ref;
            if (row < NLAT) { b = row >> 12; const int t = row & (SEQ - 1); key = CTXL + t; const int a = dd >> 5, p = (dd >> 4) & 1, f = dd & 15; ref = rope_ref(bff(z[a * 32 + f]), bff(z[a * 32 + 16 + f]), p, a, f, t); }
            else { const int rc = row - NLAT; b = rc >> 8; key = rc & (CTXL - 1); ref = bff(z[dd]); }
            report(C.dbg, 10, f8f(KPE[((size_t)b * SKV + key) * ROPE + dd]), ref, 0.07f, 0.01f); } }
}
__device__ __forceinline__ void c_qkv(Frame& F, const Ctx& C, const bf16* QN, const bf16* KVN, const unsigned char* Q, const unsigned char* KN, const bf16* V) {
    CHK_LOOP(3072) { const unsigned h = hsh(s_ + 777u), h2 = hsh(s_ + 778u); const int kind = s_ % 3, b = h % NB, hd = (h >> 8) % NHEAD;
        if (kind == 0) { const int t = (h >> 16) % SEQ, d = h2 % QKD, row = b * SEQ + t; const bf16* a = QN + (size_t)row * QRANK; float ref;
            if (d < 128) ref = dot_w(a, CK_IN(I_WUQ), QRANK, 1536, hd * QKD + d);
            else { const int dd = d - 128, aa = dd >> 5, p = (dd >> 4) & 1, f = dd & 15;
                ref = rope_ref(dot_w(a, CK_IN(I_WUQ), QRANK, 1536, hd * QKD + 128 + aa * 32 + f), dot_w(a, CK_IN(I_WUQ), QRANK, 1536, hd * QKD + 128 + aa * 32 + 16 + f), p, aa, f, t); }
            report(C.dbg, 11, f8f(Q[((size_t)(b * NHEAD + hd) * SEQ + t) * QKD + d]), ref, 0.07f, 0.02f); }
        else { const int key = (h >> 16) % SKV, d = h2 % VHD, row = key < CTXL ? NLAT + b * CTXL + key : b * SEQ + key - CTXL; const bf16* a = KVN + (size_t)row * KVRANK;
            const float ref = dot_w(a, CK_IN(I_WUKV), KVRANK, 2048, hd * 256 + (kind == 1 ? 0 : 128) + d); const size_t oi = ((size_t)(b * NHEAD + hd) * SKV + key) * VHD + d;
            report(C.dbg, 11, kind == 1 ? f8f(KN[oi]) : bff(V[oi]), ref, kind == 1 ? 0.07f : 0.02f, 0.02f); } }
}
__device__ __forceinline__ void c_attn(Frame& F, const Ctx& C, const unsigned char* Q, const unsigned char* KN, const unsigned char* KPE, const bf16* V, const bf16* ATT) {
    CHK_LOOP(256) { const unsigned h = hsh(s_ + 888u), h2 = hsh(s_ + 889u); const int b = h % NB, hd = (h >> 8) % NHEAD, t = (h >> 16) % SEQ, d = h2 % VHD;
        const unsigned char* q = Q + ((size_t)(b * NHEAD + hd) * SEQ + t) * QKD; float m = -1e30f, l = 0.f, o = 0.f;
        for (int k = 0; k < SKV; ++k) { const unsigned char* kn = KN + ((size_t)(b * NHEAD + hd) * SKV + k) * VHD; const unsigned char* kp = KPE + ((size_t)b * SKV + k) * ROPE; float sc = 0.f;
            for (int i = 0; i < 128; ++i) sc += f8f(q[i]) * f8f(kn[i]);
            for (int i = 0; i < 64; ++i) sc += f8f(q[128 + i]) * f8f(kp[i]);
            sc *= ATTN_SCALE; const float mn = fmaxf(m, sc), al = __expf(m - mn), p = __expf(sc - mn); l = l * al + p; o = o * al + p * bff(V[((size_t)(b * NHEAD + hd) * SKV + k) * VHD + d]); m = mn; }
        report(C.dbg, 12, bff(ATT[((size_t)b * SEQ + t) * DM + hd * VHD + d]), o / l, 0.03f, 0.01f); }
}
__device__ __forceinline__ void c_route(Frame& F, const Ctx& C, const float* modl, const unsigned char* H4) {
    CHK_LOOP(128) { const unsigned h = hsh(s_ + 999u); const int row = h % NLAT, col = (h >> 16) % DM, bi = row >> 12; const float* x = C.A->out + (size_t)row * DM; const float* g = CK_IN(I_NORMG) + 3 * DM;
        float ss = 0.f; for (int i = 0; i < DM; ++i) ss += x[i] * x[i]; const float r = 1.0f / sqrtf(ss / DM + EPS); float lg[NEXP]; float ycol = 0.f;
#pragma unroll
        for (int e = 0; e < NEXP; ++e) lg[e] = 0.f;
        for (int i = 0; i < DM; ++i) { const float y = x[i] * r * g[i] * (1.0f + modl[bi * MODW + 4 * DM + i]) + modl[bi * MODW + 3 * DM + i]; if (i == col) ycol = y;
#pragma unroll
            for (int e = 0; e < NEXP; ++e) lg[e] += y * CK_IN(I_ROUTER)[i * NEXP + e]; }
        report(C.dbg, 14, f8f(H4[(size_t)row * DM + col]), ycol, 0.07f, 0.01f);
        int i0 = 0; float v0 = lg[0];
#pragma unroll
        for (int e = 1; e < NEXP; ++e) if (lg[e] > v0) { v0 = lg[e]; i0 = e; }
        int i1 = 0; float v1 = -3.0e38f;
#pragma unroll
        for (int e = 0; e < NEXP; ++e) if (e != i0 && lg[e] > v1) { v1 = lg[e]; i1 = e; }
        float v2 = -3.0e38f;
#pragma unroll
        for (int e = 0; e < NEXP; ++e) if (e != i0 && e != i1 && lg[e] > v2) v2 = lg[e];
        if (v1 - v2 > 1e-3f && v0 - v1 > 1e-3f) {
            const float ex = __expf(v1 - v0), g0 = 1.0f / (1.0f + ex); const f32x2 tg = *(const f32x2*)(C.ws + WS_TOKG + (size_t)row * 8);
            report(C.dbg, 14, tg[0], g0, 0.01f, 0.002f); report(C.dbg, 14, tg[1], 1.0f - g0, 0.01f, 0.002f);
            const int tl = row; const unsigned* list = (const unsigned*)(C.ws + WS_LIST);
            const int c0 = (int)((const unsigned*)(C.ws + WS_CTL))[CW_CNT + 64 * i0], c1 = (int)((const unsigned*)(C.ws + WS_CTL))[CW_CNT + 64 * i1];
            float f0 = 0.f, f1 = 0.f; for (int i = 0; i < c0; ++i) if (list[i0 * LIST_CAP + i] == (unsigned)tl * 2u) f0 += 1.f; for (int i = 0; i < c1; ++i) if (list[i1 * LIST_CAP + i] == (unsigned)tl * 2u + 1u) f1 += 1.f;
            report(C.dbg, 14, f0, 1.0f, 0.f, 0.01f); report(C.dbg, 14, f1, 1.0f, 0.f, 0.01f); } }
}
__device__ __forceinline__ void c_moe_up(Frame& F, const Ctx& C, const LAS int* tab, const unsigned char* H4, const unsigned char* ACTE) {
    const unsigned* list = (const unsigned*)(C.ws + WS_LIST);
    CHK_LOOP(2048) { const unsigned h = hsh(s_ + 1111u), h2 = hsh(s_ + 1112u); const int e = h % NEXP, cnt = tab[16 + e]; if (cnt == 0) continue; const int slot = (h >> 8) % cnt, j = h2 % DEXP;
        const int tok = (int)(list[e * LIST_CAP + slot] >> 1); const unsigned char* a = H4 + (size_t)tok * DM;
        const float p = dot_w8(a, CK_IN(I_XW1) + (size_t)e * DM * DEXP, DM, DEXP, j, 32.f), q = dot_w8(a, CK_IN(I_XW3) + (size_t)e * DM * DEXP, DM, DEXP, j, 32.f);
        report(C.dbg, 15, f8f(ACTE[((size_t)tab[e] * 256 + slot) * DEXP + j]), p * sigm(p) * q, 0.08f, 0.02f); }
}
__device__ __forceinline__ void c_moe_down(Frame& F, const Ctx& C, const LAS int* tab, const unsigned char* ACTE, const bf16* Y) {
    const unsigned* list = (const unsigned*)(C.ws + WS_LIST);
    CHK_LOOP(2048) { const unsigned h = hsh(s_ + 2222u), h2 = hsh(s_ + 2223u); const int e = h % NEXP, cnt = tab[16 + e]; if (cnt == 0) continue; const int slot = (h >> 8) % cnt, col = h2 % DM;
        const unsigned ent = list[e * LIST_CAP + slot];
        report(C.dbg, 16, bff(Y[(size_t)ent * DM + col]), dot_w8(ACTE + ((size_t)tab[e] * 256 + slot) * DEXP, CK_IN(I_XW2) + (size_t)e * DEXP * DM, DEXP, DM, col, 64.f), 0.02f, 0.02f); }
}
__device__ __forceinline__ void c_cap_rows(Frame& F, const Ctx& C) {
    float* cap = (float*)(C.ws + WS_CAP + 65536);
    for (int i = (int)(blockIdx.x * 512 + F.tid); i < 64 * DM; i += (int)(gridDim.x * 512)) { const int r = i >> 10, c = i & (DM - 1), tl = hsh(r + 3333u) % NLAT; cap[i] = C.A->out[(size_t)tl * DM + c]; }
}
__device__ __forceinline__ void c_combine(Frame& F, const Ctx& C, const float* mod1, const bf16* Y) {
    const float* cap = (const float*)(C.ws + WS_CAP + 65536);
    CHK_LOOP(64 * 16) { const int r = s_ >> 4, tl = hsh(r + 3333u) % NLAT, row = tl, bi = row >> 12, col = hsh(s_ + 4444u) % DM; const f32x2 tg = *(const f32x2*)(C.ws + WS_TOKG + (size_t)row * 8);
        float ss = 0.f, vc = 0.f; for (int i = 0; i < DM; ++i) { const float v = cap[r * DM + i] + mod1[bi * MODW + 5 * DM + i] * (tg[0] * bff(Y[(size_t)(2 * tl) * DM + i]) + tg[1] * bff(Y[(size_t)(2 * tl + 1) * DM + i])); ss += v * v; if (i == col) vc = v; }
        report(C.dbg, 17, C.A->out[(size_t)row * DM + col], vc / sqrtf(ss / DM + EPS) * CK_IN(I_FINALG)[col], 0.005f, 0.005f); }
}
}
#endif
namespace att {
using bf16x8 = __attribute__((ext_vector_type(8))) short;
using s16x4  = __attribute__((ext_vector_type(4))) short;
using f32x16 = __attribute__((ext_vector_type(16))) float;
using u32x4  = __attribute__((ext_vector_type(4))) unsigned;
using i32x4  = __attribute__((ext_vector_type(4))) int;
using i32x8  = __attribute__((ext_vector_type(8))) int;
constexpr int D = 128, NW = 8, QBLK = 32, KVBLK = 64;
constexpr float THR = 8.f, SCALE = ATTN_SCALE;
constexpr int SHM_V = KVBLK * D * 2, SHM_K = KVBLK * 128, SHM_P = KVBLK * ROPE, SHM_ATTN = 2 * SHM_V + 2 * SHM_K + 2 * SHM_P + NW * 64 * 4;
static_assert(SHM_ATTN <= RING_BYTES, "attention LDS");
#define K8SWZ(row, colB) ((row) * 128 + ((colB) ^ ((((row) >> 1) & 7) << 4)))
#define P8SWZ(row, colB) ((row) * 64 + ((colB) ^ ((((row) >> 2) & 3) << 4)))
#define SBAR() __builtin_amdgcn_sched_barrier(0)
__device__ __forceinline__ int crow(int r, int hi) { return (r & 3) + 8 * (r >> 2) + 4 * hi; }
__device__ __forceinline__ unsigned cvtpk(float lo, float hi) { unsigned r; asm volatile("v_cvt_pk_bf16_f32 %0, %1, %2" : "=v"(r) : "v"(lo), "v"(hi)); return r; }
__device__ __forceinline__ void swap32(unsigned& a, unsigned& b) { asm volatile("s_nop 1\n\tv_permlane32_swap_b32 %0, %1\n\ts_nop 0" : "+v"(a), "+v"(b)); }
__device__ __forceinline__ void partialSM(f32x16& p0, f32x16& p1, float& m_reg, float& mn, float& alpha) {
  constexpr float C = SCALE * 1.4426950408889634f;
  float pmax = p0[0]; for (int r = 1; r < 16; ++r) pmax = fmaxf(pmax, p0[r]); for (int r = 0; r < 16; ++r) pmax = fmaxf(pmax, p1[r]);
  { unsigned a_ = __float_as_uint(pmax), b_ = a_; swap32(a_, b_); pmax = fmaxf(__uint_as_float(a_), __uint_as_float(b_)); }
  if (__builtin_expect(__all(pmax - m_reg <= THR / SCALE), 1)) { mn = m_reg; alpha = 1.f; }
  else { mn = fmaxf(m_reg, pmax); alpha = __builtin_amdgcn_exp2f((m_reg - mn) * C); m_reg = mn; }
  float mnC = -mn * C;
  for (int r = 0; r < 16; ++r) p0[r] = fmaf(p0[r], C, mnC); for (int r = 0; r < 16; ++r) p1[r] = fmaf(p1[r], C, mnC);
  for (int r = 0; r < 16; ++r) p0[r] = __builtin_amdgcn_exp2f(p0[r]);
}
__device__ __forceinline__ void finishSM(f32x16& p0, f32x16& p1, float alpha, float& l_reg, bf16x8& pa0, bf16x8& pa1, bf16x8& pa2, bf16x8& pa3) {
  for (int r = 0; r < 16; ++r) p1[r] = __builtin_amdgcn_exp2f(p1[r]);
  float ps = 0; for (int r = 0; r < 16; ++r) ps += p0[r]; for (int r = 0; r < 16; ++r) ps += p1[r];
  { unsigned a_ = __float_as_uint(ps), b_ = a_; swap32(a_, b_); ps = __uint_as_float(a_) + __uint_as_float(b_); }
  l_reg = l_reg * alpha + ps;
#define PK4(P, BASE, OUT) do { unsigned a0 = cvtpk(P[BASE + 0], P[BASE + 1]), a1 = cvtpk(P[BASE + 2], P[BASE + 3]);   \
    unsigned b0 = cvtpk(P[BASE + 4], P[BASE + 5]), b1 = cvtpk(P[BASE + 6], P[BASE + 7]);                              \
    auto r0 = __builtin_amdgcn_permlane32_swap(a0, b0, false, false); auto r1 = __builtin_amdgcn_permlane32_swap(a1, b1, false, false); \
    u32x4 w = {r0[0], r1[0], r0[1], r1[1]}; OUT = *reinterpret_cast<bf16x8*>(&w); } while (0)
  PK4(p0, 0, pa0); PK4(p0, 8, pa1); PK4(p1, 0, pa2); PK4(p1, 8, pa3);
#undef PK4
}
#define CAT8(x0, x1) __builtin_shufflevector(x0, x1, 0, 1, 2, 3, 4, 5, 6, 7)
#define MFMA8(a, b, c) __builtin_amdgcn_mfma_scale_f32_32x32x64_f8f6f4(a, b, c, 0, 0, 0, 0x7f7f7f7f, 0, 0x7f7f7f7f)
__device__ __forceinline__ void qkt(f32x16& p0, f32x16& p1, const char* Ks, const char* Ps, const i32x8* q8, int r32, int hi) {
  p0 = f32x16{}; p1 = f32x16{};
#pragma unroll
  for (int s = 0; s < 2; ++s) { const int cb = 64 * s + 32 * hi;
    const i32x8 b0 = CAT8(*reinterpret_cast<const i32x4*>(Ks + K8SWZ(r32, cb)), *reinterpret_cast<const i32x4*>(Ks + K8SWZ(r32, cb + 16)));
    const i32x8 b1 = CAT8(*reinterpret_cast<const i32x4*>(Ks + K8SWZ(32 + r32, cb)), *reinterpret_cast<const i32x4*>(Ks + K8SWZ(32 + r32, cb + 16)));
    p0 = MFMA8(b0, q8[s], p0); p1 = MFMA8(b1, q8[s], p1); }
  { const int cb = 32 * hi;
    const i32x8 b0 = CAT8(*reinterpret_cast<const i32x4*>(Ps + P8SWZ(r32, cb)), *reinterpret_cast<const i32x4*>(Ps + P8SWZ(r32, cb + 16)));
    const i32x8 b1 = CAT8(*reinterpret_cast<const i32x4*>(Ps + P8SWZ(32 + r32, cb)), *reinterpret_cast<const i32x4*>(Ps + P8SWZ(32 + r32, cb + 16)));
    p0 = MFMA8(b0, q8[2], p0); p1 = MFMA8(b1, q8[2], p1); }
}
__device__ __forceinline__ int v_st(int k, int c) { const int kk = (k & ~0xC) | ((k & 4) << 1) | ((k & 8) >> 1); return ((kk >> 3) * 4 + (c >> 5)) * 512 + ((kk & 7) * 32 + (c & 31)) * 2; }
__device__ __forceinline__ int v_rd_base(int lane) { return ((lane & 3) << 3) | (((lane >> 2) & 3) << 6) | (((lane >> 4) & 1) << 5) | (((lane >> 5) & 1) << 8); }
constexpr int v_rd_off(int d0, int ks, int half) { return d0 * 512 + ks * 4096 + half * 2048; }
template <int OFF> __device__ __forceinline__ s16x4 tr_read(int vb) {
  s16x4 r; asm volatile("ds_read_b64_tr_b16 %0, %1 offset:%2" : "=&v"(r) : "v"(vb), "i"(OFF) : "memory"); return r;
}
template <int D0> __device__ __forceinline__ void pv_one(f32x16& od, int vb, bf16x8 pa0, bf16x8 pa1, bf16x8 pa2, bf16x8 pa3) {
  const s16x4 l0 = tr_read<v_rd_off(D0, 0, 0)>(vb), h0 = tr_read<v_rd_off(D0, 0, 1)>(vb), l1 = tr_read<v_rd_off(D0, 1, 0)>(vb), h1 = tr_read<v_rd_off(D0, 1, 1)>(vb);
  const s16x4 l2 = tr_read<v_rd_off(D0, 2, 0)>(vb), h2 = tr_read<v_rd_off(D0, 2, 1)>(vb), l3 = tr_read<v_rd_off(D0, 3, 0)>(vb), h3 = tr_read<v_rd_off(D0, 3, 1)>(vb);
  asm volatile("s_waitcnt lgkmcnt(0)" ::: "memory"); SBAR();
#define PK(L, H) (bf16x8){L[0], L[1], L[2], L[3], H[0], H[1], H[2], H[3]}
  od = __builtin_amdgcn_mfma_f32_32x32x16_bf16(pa0, PK(l0, h0), od, 0, 0, 0);
  od = __builtin_amdgcn_mfma_f32_32x32x16_bf16(pa1, PK(l1, h1), od, 0, 0, 0);
  od = __builtin_amdgcn_mfma_f32_32x32x16_bf16(pa2, PK(l2, h2), od, 0, 0, 0);
  od = __builtin_amdgcn_mfma_f32_32x32x16_bf16(pa3, PK(l3, h3), od, 0, 0, 0);
#undef PK
}
__device__ __forceinline__ void pv_d0(f32x16* o, int vb, bf16x8 pa0, bf16x8 pa1, bf16x8 pa2, bf16x8 pa3) {
  pv_one<0>(o[0], vb, pa0, pa1, pa2, pa3); pv_one<1>(o[1], vb, pa0, pa1, pa2, pa3); pv_one<2>(o[2], vb, pa0, pa1, pa2, pa3); pv_one<3>(o[3], vb, pa0, pa1, pa2, pa3);
}
__device__ __forceinline__ void attn_unit(const unsigned char* __restrict__ Qb, const unsigned char* __restrict__ Kh, const unsigned char* __restrict__ Ph, const bf16* __restrict__ Vh, bf16* __restrict__ Ob, int seq, char* lds, int wave_id) {
  const int wid = __builtin_amdgcn_readfirstlane(wave_id), lane = fresh_lane(), tid = wid * 64 + lane, r32 = lane & 31, hi = lane >> 5;
  char* V_lds = lds; char* K_lds = lds + 2 * SHM_V; char* P_lds = lds + 2 * SHM_V + 2 * SHM_K;
  float* ws = (float*)(lds + 2 * SHM_V + 2 * SHM_K + 2 * SHM_P) + wid * 64; float* li_l = ws; float* al_l = ws + 32;
  float m_reg = -1e30f, l_reg = 0; f32x16 o[4] = {}; i32x8 q8[3];
  const char* Qw = (const char*)Qb + (size_t)wid * (QBLK * QKD); const int qoff = r32 * QKD + hi * 32;
#pragma unroll
  for (int s = 0; s < 3; ++s) q8[s] = CAT8(*reinterpret_cast<const i32x4*>(Qw + qoff + 64 * s), *reinterpret_cast<const i32x4*>(Qw + qoff + 64 * s + 16));
  const int sr = tid >> 4, sc = (tid & 15) * 8, vst0 = v_st(sr, sc), vst1 = v_st(32 + sr, sc);
  const int kr = tid >> 3, kc = (tid & 7) * 16, pr = (tid >> 2) & 63, pc = (tid & 3) * 16;
  const bool do_p = wid < 4;
  const int vb0 = (int)(uintptr_t)V_lds + v_rd_base(lane);
  struct { bf16x8 vs0, vs1; i32x4 ks, ps; } sr_[1];
  const int voff = (sr * D + sc) * 2, koff = kr * 128 + kc, poff = pr * ROPE + pc;
#define SLOAD(i, k0) do { const char* vt_ = (const char*)Vh + (size_t)(k0) * (D * 2); const char* kt_ = (const char*)Kh + (size_t)(k0) * 128; const char* pt_ = (const char*)Ph + (size_t)(k0) * ROPE; \
    sr_[i].vs0 = *(const bf16x8*)(vt_ + voff); sr_[i].vs1 = *(const bf16x8*)(vt_ + voff + 32 * D * 2); sr_[i].ks = *(const i32x4*)(kt_ + koff); \
    if (do_p) sr_[i].ps = *(const i32x4*)(pt_ + poff); } while (0)
#define SWRITE(b, i) do { *(bf16x8*)(V_lds + (b) * SHM_V + vst0) = sr_[i].vs0; *(bf16x8*)(V_lds + (b) * SHM_V + vst1) = sr_[i].vs1; \
    *(i32x4*)(K_lds + (b) * SHM_K + K8SWZ(kr, kc)) = sr_[i].ks; if (do_p) *(i32x4*)(P_lds + (b) * SHM_P + P8SWZ(pr, pc)) = sr_[i].ps; } while (0)
#define SWAIT() asm volatile("s_waitcnt vmcnt(0)" ::: "memory")
#define RESC(a) do { if (__any((a) < 1.f)) { if (hi == 0) al_l[r32] = (a); asm volatile("s_waitcnt lgkmcnt(0)" ::: "memory"); \
    for (int d = 0; d < 4; ++d) for (int r = 0; r < 16; ++r) o[d][r] *= al_l[crow(r, hi)]; } } while (0)
  f32x16 pA0, pA1, pB0, pB1; float mnA, mnB, alA, alB; bf16x8 pa0, pa1, pa2, pa3; const int NT = seq / KVBLK;
  SLOAD(0, 0); asm volatile("s_waitcnt vmcnt(0)" ::: "memory"); SWRITE(0, 0); __syncthreads();
  qkt(pA0, pA1, K_lds, P_lds, q8, r32, hi); partialSM(pA0, pA1, m_reg, mnA, alA);
  SLOAD(0, KVBLK);
  SWAIT(); SWRITE(1, 0); __syncthreads();
  for (int j = 1; j + 1 < NT; j += 2) {
    SBAR(); qkt(pB0, pB1, K_lds + SHM_K, P_lds + SHM_P, q8, r32, hi);
    finishSM(pA0, pA1, alA, l_reg, pa0, pa1, pa2, pa3); SBAR();
    SLOAD(0, (j + 1) * KVBLK); SBAR();
    pv_d0(o, vb0, pa0, pa1, pa2, pa3); partialSM(pB0, pB1, m_reg, mnB, alB);
    __syncthreads(); SWAIT(); SWRITE(0, 0);
    RESC(alB); __syncthreads();
    SBAR(); qkt(pA0, pA1, K_lds, P_lds, q8, r32, hi);
    finishSM(pB0, pB1, alB, l_reg, pa0, pa1, pa2, pa3); SBAR();
    SLOAD(0, (j + 2) * KVBLK); SBAR();
    pv_d0(o, vb0 + (int)SHM_V, pa0, pa1, pa2, pa3); partialSM(pA0, pA1, m_reg, mnA, alA);
    __syncthreads(); SWAIT(); SWRITE(1, 0);
    RESC(alA); __syncthreads();
  }
  SBAR(); qkt(pB0, pB1, K_lds + SHM_K, P_lds + SHM_P, q8, r32, hi);
  finishSM(pA0, pA1, alA, l_reg, pa0, pa1, pa2, pa3); SBAR();
  pv_d0(o, vb0, pa0, pa1, pa2, pa3); partialSM(pB0, pB1, m_reg, mnB, alB);
  __syncthreads(); RESC(alB);
  finishSM(pB0, pB1, alB, l_reg, pa0, pa1, pa2, pa3); SBAR();
  pv_d0(o, vb0 + (int)SHM_V, pa0, pa1, pa2, pa3);
  if (hi == 0) li_l[r32] = l_reg; asm volatile("s_waitcnt lgkmcnt(0)" ::: "memory");
  float rli[16];
#pragma unroll
  for (int r = 0; r < 16; ++r) rli[r] = __builtin_amdgcn_rcpf(li_l[crow(r, hi)]);
  constexpr int OB = ATT_FP8 ? 1 : 2;
  char* Ow = (char*)Ob + (size_t)wid * (QBLK * DM * OB); const int ooff = (4 * hi * DM + r32) * OB;
#pragma unroll
  for (int r = 0; r < 16; ++r) { const int orow = (r & 3) + 8 * (r >> 2);
#pragma unroll
    for (int d0 = 0; d0 < 4; ++d0) { const float v = o[d0][r] * rli[r];
      if constexpr (ATT_FP8) { const int w = __builtin_amdgcn_cvt_pk_fp8_f32(v, 0.f, 0, false); *(unsigned char*)(Ow + ooff + (orow * DM + d0 * 32)) = (unsigned char)(w & 0xff); }
      else { const unsigned w = cvtpk(v, 0.f); *(bf16*)(Ow + ooff + (orow * DM + d0 * 32) * 2) = (bf16)(w & 0xffffu); } } }
  __syncthreads();
#undef SLOAD
#undef SWRITE
#undef SWAIT
#undef RESC
}
#undef K8SWZ
#undef P8SWZ
#undef SBAR
#undef CAT8
#undef MFMA8
}

__global__ void __launch_bounds__(NWAVES * 64, 2) fwd_kernel(Args args) {
    extern __shared__ __attribute__((aligned(16))) unsigned char lds[];
    Frame F;
    F.lds = (LAS unsigned char*)lds;
    F.MISC = (volatile LAS unsigned*)(F.lds + MISC_OFF);
    F.tid = threadIdx.x; F.lane = F.tid & 63; F.wave = __builtin_amdgcn_readfirstlane(F.tid >> 6);
    F.G = gridDim.x; { const int bx = blockIdx.x; F.vcu = (F.G % 8 == 0) ? (bx % 8) * (F.G / 8) + bx / 8 : bx; }
    unsigned char* ws = args.ws;
    F.ctl = (gu32*)(ws + WS_CTL);
    for (int u = F.tid; u < (LDS_BYTES - LDSCTL_OFF) / 4; u += NWAVES * 64) ((LAS unsigned*)(F.lds + LDSCTL_OFF))[u] = 0u;
    __syncthreads();
    XcdBarrier bar = xcd_barrier_post((unsigned*)(F.ctl + CW_BAR), F.MISC + 8);
#define GRID_BAR() xcd_barrier(bar, F.wave)
    static_assert(!FUSE_NORM || FFN_FP8 == 2, "the fused pre-norm path is wired for FFN_FP8 == 2");
#ifndef DROPMASK
#define DROPMASK 0
#endif
#ifndef PHMASK
#define PHMASK 0xffffffffu
#endif
#ifndef DUPMASK
#define DUPMASK 0u
#endif
#define PH(k) FRESH(); if constexpr (((PHMASK) >> (k)) & 1u) for (int rep_ = 0; rep_ < ((((DUPMASK) >> (k)) & 1u) ? 2 : 1); ++rep_)
#define FRESH() do { F.lane = fresh_lane(); F.tid = F.wave * 64 + F.lane; } while (0)
    unsigned char* ar = ws + WS_ARENA;
    float* const mod = (float*)(ws + WS_MOD); const float* const mod0 = mod; const float* const mod1 = mod + 9 * MODW;
    const float* const rope = (const float*)(ws + WS_ROPE);
    bf16* const XCb = nullptr; (void)XCb;
    float* const XC = (float*)(ar + AR_XC * MiB);
    bf16* const H = (bf16*)(ar + AR_H * MiB);
    PG8_LAS unsigned char* const ring = (PG8_LAS unsigned char*)(F.lds + RING_OFF);
    const int G = F.G, cid = (int)blockIdx.x;
#if SELFCHECK
    chk::Ctx CK{&args, ws, ar, (unsigned*)(ws + WS_CTL) + CW_DBG, mod, XC};
#define CHK(stmt) do { FRESH(); stmt; GRID_BAR(); } while (0)
#else
#define CHK(stmt) do { } while (0)
#endif

#ifndef XW_LATE
#define XW_LATE 1
#endif
    PH(0) { p0_prologue<0>(F, args); if (!XW_LATE) p0_prologue<1>(F, args); }
    GRID_BAR();
    CHK(chk::c_mod(F, CK));
    PH(1) { norm_phase<false>(F, args, args.in[I_X], args.in[I_CTX], MALL, args.in[I_NORMG] + 0 * DM, mod0, 0, H); if (FUSE_NORM) fuse_prep(F, args, mod0, mod1); }
    GRID_BAR();
    CHK(chk::c_norm(F, CK, 1, args.in[I_X], args.in[I_CTX], MALL, args.in[I_NORMG], mod0, 0, H));
    PH(2) { pg8::Gemm g{H, (const bf16*)(ws + WS_WIN), MALL, 2048, DM}; pg8::StaticOrder S; S.init(MALL, 2048, G, cid);
      epi::EpiMixIn E{(bf16*)(ar + AR_AG * MiB), (bf16*)(ar + AR_UG * MiB), (bf16*)(ar + AR_VG * MiB)};
      pg8::gemm_phase<epi::EpiMixIn, pg8::StaticOrder, true>(ring, g, S, E, F.wave); }
    GRID_BAR();
    CHK(chk::c_mixin(F, CK, H, (const bf16*)(ar + AR_AG * MiB), (const bf16*)(ar + AR_UG * MiB), (const bf16*)(ar + AR_VG * MiB)));
    PH(3) mixmid_phase(F, args, (const bf16*)(ar + AR_AG * MiB), (const bf16*)(ar + AR_UG * MiB), (const bf16*)(ar + AR_VG * MiB), (const bf16*)(ws + WS_WSB), H);
    GRID_BAR();
    CHK(chk::c_mixmid(F, CK, (const bf16*)(ar + AR_AG * MiB), (const bf16*)(ar + AR_UG * MiB), (const bf16*)(ar + AR_VG * MiB), H));
    PH(4) { pg8::Gemm g{H, (const bf16*)(ws + WS_WOUT), MALL, DM, DM}; pg8::StaticOrder S; S.init(MALL, DM, G, cid);
      epi::EpiResid E{args.in[I_X], args.in[I_CTX], args.out, XC, mod0 + 2 * DM, (DROPMASK & 1) ? 0.f : 1.f, FUSE_NORM ? (bf16*)(ar + AR_A0 * MiB) : nullptr, (const float*)(ws + WS_GV), (float*)(ar + AR_SS * MiB)};
      pg8::gemm_phase<epi::EpiResid, pg8::StaticOrder, true>(ring, g, S, E, F.wave); }
    GRID_BAR();
    CHK(chk::c_resid(F, CK, 4, MALL, H, DM, args.in[I_EWOUT], mod0 + 2 * DM, args.in[I_X], args.in[I_CTX], false));
#if !FUSE_NORM
    PH(5) norm_phase<false, FFN_FP8 == 1 || FFN_FP8 == 3>(F, args, args.out, XC, MALL, args.in[I_NORMG] + 1 * DM, mod0, 3, H);
    GRID_BAR();
#if !FFN_FP8
    CHK(chk::c_norm(F, CK, 5, args.out, XC, MALL, args.in[I_NORMG] + DM, mod0, 3, H));
#endif
#endif
#if FFN_FP8 == 3
    PH(6) { pg8::Gemm g{H, (const bf16*)(ws + WS_W13), MALL, 2 * DFF, DM / 2, 0x7f7f7f7f, SC_W13 * 0x01010101}; pg8::StaticOrder S; S.init(MALL, 2 * DFF, G, cid);
      epi::EpiSwiGlu E{(bf16*)(ar + AR_ACT * MiB), DFF, 2 * DFF / 256};
      pg8::gemm_phase<epi::EpiSwiGlu, pg8::StaticOrder, true, false, true>(ring, g, S, E, F.wave); }
    GRID_BAR();
    PH(7) { pg8::Gemm g{(const bf16*)(ar + AR_ACT * MiB), (const bf16*)(ws + WS_W2), MALL, DM, DFF}; pg8::StaticOrder S; S.init(MALL, DM, G, cid);
      epi::EpiResid E{args.out, XC, args.out, XC, mod0 + 5 * DM, ((DROPMASK & 2) || rep_) ? 0.f : 1.f, nullptr, nullptr, nullptr};
      pg8::gemm_phase<epi::EpiResid, pg8::StaticOrder, true>(ring, g, S, E, F.wave); }
    GRID_BAR();
#elif FFN_FP8
#if FFN_FP8 == 1
    PH(6) { pg8::Gemm g{H, (const bf16*)(ws + WS_W13), MALL, 2 * DFF, DM / 2, 0x7f7f7f7f, SC_W13 * 0x01010101}; pg8::StaticOrder S; S.init(MALL, 2 * DFF, G, cid);
      epi::EpiSwiGluF8 E{ar + AR_ACT * MiB, DFF, 2 * DFF / 256, nullptr, nullptr};
      pg8::gemm_phase<epi::EpiSwiGluF8, pg8::StaticOrder, true, false, true>(ring, g, S, E, F.wave); }
#else
    PH(6) { pg8::Gemm g{FUSE_NORM ? (const bf16*)(ar + AR_A0 * MiB) : H, (const bf16*)(ws + WS_W13), MALL, 2 * DFF, DM}; pg8::StaticOrder S; S.init(MALL, 2 * DFF, G, cid);
      epi::EpiSwiGluF8 E{ar + AR_ACT * MiB, DFF, 2 * DFF / 256, FUSE_NORM ? (const float*)(ar + AR_SS * MiB) : nullptr, (const float*)(ws + WS_B13)};
      pg8::gemm_phase<epi::EpiSwiGluF8, pg8::StaticOrder, true>(ring, g, S, E, F.wave); }
#endif
    GRID_BAR();
    PH(7) { pg8::Gemm g{(const bf16*)(ar + AR_ACT * MiB), (const bf16*)(ws + WS_W2), MALL, DM, DFF / 2, 0x7f7f7f7f, SC_W2 * 0x01010101}; pg8::StaticOrder S; S.init(MALL, DM, G, cid);
      epi::EpiResid E{args.out, XC, args.out, XC, mod0 + 5 * DM, ((DROPMASK & 2) || rep_) ? 0.f : 1.f, FUSE_NORM ? H : nullptr, (const float*)(ws + WS_GV) + 9 * DM, (float*)(ar + AR_SS * MiB) + (size_t)MALL * 16};
      pg8::gemm_phase<epi::EpiResid, pg8::StaticOrder, true, false, true>(ring, g, S, E, F.wave); }
    GRID_BAR();
#else
    PH(6) { pg8::Gemm g{H, (const bf16*)(ws + WS_W13), MALL, 2 * DFF, DM}; pg8::StaticOrder S; S.init(MALL, 2 * DFF, G, cid);
      epi::EpiSwiGlu E{(bf16*)(ar + AR_ACT * MiB), DFF, 2 * DFF / 256};
      pg8::gemm_phase<epi::EpiSwiGlu, pg8::StaticOrder, true>(ring, g, S, E, F.wave); }
    GRID_BAR();
    CHK(chk::c_swiglu(F, CK, H, (const bf16*)(ar + AR_ACT * MiB)));
    CHK(chk::c_capture(F, CK, 7, MALL));
    PH(7) { pg8::Gemm g{(const bf16*)(ar + AR_ACT * MiB), (const bf16*)(ws + WS_W2), MALL, DM, DFF}; pg8::StaticOrder S; S.init(MALL, DM, G, cid);
      epi::EpiResid E{args.out, XC, args.out, XC, mod0 + 5 * DM, ((DROPMASK & 2) || rep_) ? 0.f : 1.f, FUSE_NORM ? H : nullptr, (const float*)(ws + WS_GV) + 9 * DM, (float*)(ar + AR_SS * MiB) + (size_t)MALL * 16};
      pg8::gemm_phase<epi::EpiResid, pg8::StaticOrder, true>(ring, g, S, E, F.wave); }
    GRID_BAR();
    CHK(chk::c_resid(F, CK, 7, MALL, (const bf16*)(ar + AR_ACT * MiB), DFF, args.in[I_FW2], mod0 + 5 * DM, nullptr, nullptr, true));
#endif
#if !FUSE_NORM
    PH(8) norm_phase<false, ATT_FP8 != 0>(F, args, args.out, XC, MALL, args.in[I_NORMG] + 2 * DM, mod1, 0, H);
    GRID_BAR();
#if !ATT_FP8
    CHK(chk::c_norm(F, CK, 8, args.out, XC, MALL, args.in[I_NORMG] + 2 * DM, mod1, 0, H));
#endif
#endif
    PH(9) { pg8::Gemm g{H, (const bf16*)(ws + WS_WINO), MALL, INO_PAD, ATT_FP8 ? DM / 2 : DM, 0x7f7f7f7f, (127 - 5) * 0x01010101}; pg8::StaticOrder S; S.init(MALL, INO_PAD, G, cid);
      epi::EpiPlain E{(bf16*)(ar + AR_Z * MiB), INO_PAD, FUSE_NORM ? (const float*)(ar + AR_SS * MiB) + (size_t)MALL * 16 : nullptr, (const float*)(ws + WS_BZ)};
      pg8::gemm_phase<epi::EpiPlain, pg8::StaticOrder, true, false, ATT_FP8 != 0>(ring, g, S, E, F.wave); }
    GRID_BAR();
#if !FUSE_NORM && !ATT_FP8
    CHK(chk::c_z(F, CK, H, (const bf16*)(ar + AR_Z * MiB)));
#endif
    PH(10) zsplit_phase(F, args, (const bf16*)(ar + AR_Z * MiB), (bf16*)(ar + AR_QN * MiB), (bf16*)(ar + AR_KVN * MiB), ar + AR_KPE * MiB, rope);
    GRID_BAR();
    CHK(chk::c_zsplit(F, CK, (const bf16*)(ar + AR_Z * MiB), (const bf16*)(ar + AR_QN * MiB), (const bf16*)(ar + AR_KVN * MiB), ar + AR_KPE * MiB));
    PH(11) { pg8::Gemm g{(const bf16*)(ar + AR_QN * MiB), (const bf16*)(ws + WS_WUQ), NLAT, 1536, QRANK}; pg8::StaticOrder S; S.init(NLAT, 1536, G, cid);
      epi::EpiQ E{ar + AR_Q * MiB, rope};
      pg8::gemm_phase<epi::EpiQ, pg8::StaticOrder, true>(ring, g, S, E, F.wave); }
    PH(12) { pg8::Gemm g{(const bf16*)(ar + AR_KVN * MiB), (const bf16*)(ws + WS_WUKV), MALL, 2048, KVRANK}; pg8::StaticOrder S; S.init(MALL, 2048, G, cid);
      epi::EpiKV E{ar + AR_KN * MiB, (bf16*)(ar + AR_V * MiB)};
      pg8::gemm_phase<epi::EpiKV, pg8::StaticOrder, true>(ring, g, S, E, F.wave); }
    GRID_BAR();
    CHK(chk::c_qkv(F, CK, (const bf16*)(ar + AR_QN * MiB), (const bf16*)(ar + AR_KVN * MiB), ar + AR_Q * MiB, ar + AR_KN * MiB, (const bf16*)(ar + AR_V * MiB)));
    PH(13) { const unsigned char* Qg = ar + AR_Q * MiB; const unsigned char* Kg = ar + AR_KN * MiB; const unsigned char* Pg = ar + AR_KPE * MiB; const bf16* Vg = (const bf16*)(ar + AR_V * MiB);
      bf16* Og = (bf16*)(ar + AR_ATT * MiB);
      constexpr int NQB = SEQ / 256, NU = NB * NHEAD * NQB;
      for (int u = F.vcu; u < NU; u += G) { const int bh = u / NQB, qb = u - bh * NQB, b = bh / NHEAD, h = bh - b * NHEAD;
          att::attn_unit(Qg + ((size_t)bh * SEQ + qb * 256) * QKD, Kg + (size_t)bh * SKV * 128, Pg + (size_t)b * SKV * ROPE, Vg + (size_t)bh * SKV * VHD,
                         (bf16*)((char*)Og + (((size_t)b * SEQ + qb * 256) * DM + h * VHD) * (ATT_FP8 ? 1 : 2)), SKV, (char*)lds + RING_OFF, F.wave); } }
    GRID_BAR();
#if !ATT_FP8
    CHK(chk::c_attn(F, CK, ar + AR_Q * MiB, ar + AR_KN * MiB, ar + AR_KPE * MiB, (const bf16*)(ar + AR_V * MiB), (const bf16*)(ar + AR_ATT * MiB)));
#endif
    CHK(chk::c_capture(F, CK, 13, NLAT));
    PH(14) { pg8::Gemm g{(const bf16*)(ar + AR_ATT * MiB), (const bf16*)(ws + WS_WO), NLAT, DM, ATT_FP8 ? DM / 2 : DM, 0x7f7f7f7f, (127 - 5) * 0x01010101}; pg8::StaticOrder S; S.init(NLAT, DM, G, cid);
      epi::EpiResid E{args.out, XC, args.out, XC, mod1 + 2 * DM, ((DROPMASK & 4) || rep_) ? 0.f : 1.f, nullptr, nullptr, nullptr};
      pg8::gemm_phase<epi::EpiResid, pg8::StaticOrder, true, false, ATT_FP8 != 0>(ring, g, S, E, F.wave); }
    GRID_BAR();
#if !ATT_FP8
    CHK(chk::c_resid(F, CK, 13, NLAT, (const bf16*)(ar + AR_ATT * MiB), DM, args.in[I_WO], mod1 + 2 * DM, nullptr, nullptr, true));
#endif
    PH(15) norm_phase<true>(F, args, args.out, XC, NLAT, args.in[I_NORMG] + 3 * DM, mod1, 3, (bf16*)(ar + AR_H4 * MiB));
    GRID_BAR();
    CHK(chk::c_route(F, CK, mod1, ar + AR_H4 * MiB));
    if (XW_LATE) { PH(19) p0_prologue<1>(F, args); GRID_BAR(); }
    LAS int* const tab = (LAS int*)(F.lds + MOET_OFF);
    { FRESH();
      if (F.tid == 0) { int base = 0;
          for (int e = 0; e < NEXP; ++e) { const int c = (int)__hip_atomic_load((unsigned*)F.ctl + CW_CNT + 64 * e, RLX_AGENT); tab[e] = base; tab[16 + e] = c; base += (c + 255) >> 8; }
          tab[8] = base; }
      __syncthreads(); }
    const int TT = tab[8];
    const unsigned* const list = (const unsigned*)(ws + WS_LIST);
    PH(16) { pg8::Gemm g{(const bf16*)(ar + AR_H4 * MiB), (const bf16*)(ws + WS_EW13), TT * 256, 2 * DEXP, DM / 2, 0x7f7f7f7f, SC_W13 * 0x01010101};
      MoeOrder S; S.so.init(TT * 256, 2 * DEXP, G, cid); S.nN = 2 * DEXP / 256; S.tab = tab; S.list = list; S.tok0 = 0;
      epi::EpiSwiGluF8 E{ar + AR_ACTE * MiB, DEXP, 2 * DEXP / 256};
      pg8::gemm_phase<epi::EpiSwiGluF8, MoeOrder, true, true, true>(ring, g, S, E, F.wave); }
    GRID_BAR();
    CHK(chk::c_moe_up(F, CK, tab, ar + AR_H4 * MiB, ar + AR_ACTE * MiB));
    PH(17) { pg8::Gemm g{(const bf16*)(ar + AR_ACTE * MiB), (const bf16*)(ws + WS_EW2), TT * 256, DM, DEXP / 2, 0x7f7f7f7f, SC_W2 * 0x01010101};
      MoeOrder S; S.so.init(TT * 256, DM, G, cid); S.nN = DM / 256; S.tab = tab; S.list = list; S.tok0 = 0;
      epi::EpiMoeDown E{(bf16*)(ar + AR_Y * MiB), list, tab};
      pg8::gemm_phase<epi::EpiMoeDown, MoeOrder, true, false, true>(ring, g, S, E, F.wave); }
    GRID_BAR();
    CHK(chk::c_moe_down(F, CK, tab, ar + AR_ACTE * MiB, (const bf16*)(ar + AR_Y * MiB)));
    CHK(chk::c_cap_rows(F, CK));
    PH(18) combine_phase(F, args, (const bf16*)(ar + AR_Y * MiB), mod1, (DROPMASK & 8) ? 0.f : 1.f);
#if SELFCHECK
    GRID_BAR(); CHK(chk::c_combine(F, CK, mod1, (const bf16*)(ar + AR_Y * MiB)));
    { FRESH(); int code = -1;
      for (int k = 39; k >= 0; --k) { const unsigned f = __hip_atomic_load(CK.dbg + 64 * k, RLX_AGENT), n = __hip_atomic_load(CK.dbg + 64 * k + 1, RLX_AGENT); if (f * 50u > n) code = k; }
      if (code >= 0) { const float v = sqrtf((float)(code + 1)); for (size_t i = (size_t)blockIdx.x * 512 + F.tid; i < (size_t)NLAT * DM; i += (size_t)gridDim.x * 512) args.out[i] = v; } }
#endif
#undef GRID_BAR
}

extern "C" void kernel_launch(void* const* d_in, const int* in_sizes, int n_in, void* d_out, int out_size, void* d_ws, size_t ws_size, hipStream_t stream) {
    static int grid = 0;
    if (grid == 0) {
        if (n_in != 31 || in_sizes[0] != NLAT * DM || out_size != NLAT * DM || ws_size < WS_END) {
            fprintf(stderr, "kernel_launch: shape mismatch: n_in %d in0 %d out %d ws %zu (need %zu); nothing launched\n", n_in, n_in > 0 ? in_sizes[0] : -1, out_size, ws_size, (size_t)WS_END); grid = -1; return; }
        int dev = 0, cus = 0, per_cu = 0;
        if (hipGetDevice(&dev) != hipSuccess || hipDeviceGetAttribute(&cus, hipDeviceAttributeMultiprocessorCount, dev) != hipSuccess) { fprintf(stderr, "kernel_launch: device query failed\n"); grid = -1; return; }
        if (hipFuncSetAttribute((const void*)fwd_kernel, hipFuncAttributeMaxDynamicSharedMemorySize, LDS_BYTES) != hipSuccess) { fprintf(stderr, "kernel_launch: hipFuncSetAttribute failed\n"); grid = -1; return; }
        if (hipOccupancyMaxActiveBlocksPerMultiprocessor(&per_cu, (const void*)fwd_kernel, NWAVES * 64, LDS_BYTES) != hipSuccess || per_cu < 1) {
            fprintf(stderr, "kernel_launch: occupancy query reports %d workgroups per CU; nothing launched\n", per_cu); (void)hipGetLastError(); grid = -1; return; }
        grid = cus;
    }
    if (grid < 0) return;
    if (hipMemsetAsync((char*)d_ws + WS_CTL, 0, CTL_ZERO_BYTES, stream) != hipSuccess) { fprintf(stderr, "kernel_launch: memset failed\n"); return; }
    Args a{};
    for (int i = 0; i < 31; ++i) a.in[i] = (const float*)d_in[i];
    a.out = (float*)d_out; a.ws = (unsigned char*)d_ws;
    hipLaunchKernelGGL(fwd_kernel, dim3(grid), dim3(NWAVES * 64), LDS_BYTES, stream, a);
    const hipError_t le = hipPeekAtLastError();
    if (le != hipSuccess) fprintf(stderr, "kernel_launch: launch failed: %s\n", hipGetErrorName(le));
}
```
